# Optimizing an MI355X kernel written in HIP

```python
import math
import jax, jax.numpy as jnp
from jax import lax
import numpy as np

D_MODEL = 1024
BATCH = 4
SEQ = 4096
DEPTH = 4

GRID_W = 64
CTX_LEN = 256
HEAD_DIM = 64
LRU_WIDTH = 256
LRU_BLOCKS = 4
LRU_BLOCK = LRU_WIDTH // LRU_BLOCKS
CONV_W = 4
LRU_C = 8.0
SWA_Q_HEADS = 8
SWA_KV_HEADS = 2
SWA_GROUP = SWA_Q_HEADS // SWA_KV_HEADS
SWA_WIDTH = SWA_Q_HEADS * HEAD_DIM
WINDOW = 128
BLOCK = 128
DIFF_HEADS = 4
DIFF_QK = HEAD_DIM // 2
DIFF_WIDTH = DIFF_HEADS * HEAD_DIM
MIX_WIDTH = LRU_WIDTH + SWA_WIDTH + DIFF_WIDTH
IN_SPLIT = (LRU_WIDTH, LRU_WIDTH, SWA_Q_HEADS * HEAD_DIM, SWA_KV_HEADS * HEAD_DIM, SWA_KV_HEADS * HEAD_DIM,
            DIFF_HEADS * 2 * DIFF_QK, DIFF_HEADS * 2 * DIFF_QK, DIFF_HEADS * HEAD_DIM)
IN_COLS = sum(IN_SPLIT)
D_FF = 2816
N_EXPERTS = 8
TOP_K = 2
EXPERT_FF = 2816
N_DENSE = (DEPTH + 1) // 2
N_MOE = DEPTH // 2
ROPE_BASE = 10000.0
LN_EPS = 1e-5
NEG_INF = -1e30
DEEPNORM_ALPHA = (2.0 * DEPTH) ** 0.25
DEEPNORM_BETA = (8.0 * DEPTH) ** -0.25

kernel_name = "hymba_style_hybrid_diffusion_trunk"

F32 = jnp.float32


def layer_norm(x, g, b):
    xf = x.astype(F32)
    mu = jnp.mean(xf, -1, keepdims=True)
    var = jnp.mean(jnp.square(xf - mu), -1, keepdims=True)
    return ((xf - mu) * lax.rsqrt(var + LN_EPS)).astype(x.dtype) * g + b


def axial_rope(rows, rot_dim):
    n_freq = rot_dim // 4
    inv = ROPE_BASE ** (-jnp.arange(n_freq, dtype=F32) / n_freq)
    row = jnp.repeat(jnp.arange(rows, dtype=F32), GRID_W)
    col = jnp.tile(jnp.arange(GRID_W, dtype=F32), rows)
    ang = jnp.concatenate([row[:, None] * inv, col[:, None] * inv], -1)
    return jnp.cos(ang), jnp.sin(ang)


def apply_rope(t, cos, sin):
    shp = (cos.shape[0],) + (1,) * (t.ndim - 3) + (cos.shape[1],)
    cos = cos.reshape(shp).astype(t.dtype)
    sin = sin.reshape(shp).astype(t.dtype)
    half = t.shape[-1] // 2
    t1, t2 = t[..., :half], t[..., half:]
    return jnp.concatenate([t1 * cos - t2 * sin, t2 * cos + t1 * sin], -1)


def split_cols(p):
    outs, o = [], 0
    for n in IN_SPLIT:
        outs.append(p[..., o:o + n])
        o += n
    return outs


def centred_dwconv(u, w, b):
    pad_l = (CONV_W - 1) // 2
    pad_r = CONV_W - 1 - pad_l
    out = lax.conv_general_dilated(u, w[:, None, :], window_strides=(1,), padding=[(pad_l, pad_r)],
                                   dimension_numbers=('NWC', 'WIO', 'NWC'), feature_group_count=u.shape[-1])
    return out + b


def block_diag_linear(u, w, b):
    ub = u.reshape(u.shape[:-1] + (LRU_BLOCKS, LRU_BLOCK))
    return jnp.einsum('bnki,kio->bnko', ub, w.astype(F32)).reshape(u.shape) + b.astype(F32)


def rglru_coeffs(u, w_a, b_a, w_x, b_x, lam):
    r = jax.nn.sigmoid(block_diag_linear(u, w_a, b_a))
    i = jax.nn.sigmoid(block_diag_linear(u, w_x, b_x))
    log_a = -LRU_C * r * jax.nn.softplus(-lam.astype(F32))
    a = jnp.exp(log_a)
    mult = jnp.sqrt(-jnp.expm1(2.0 * log_a))
    return a, mult * (i * u)


def linear_scan(a, bx, h0, reverse):
    def comb(l, r):
        return r[0] * l[0], r[0] * l[1] + r[1]
    a_cum, b_cum = lax.associative_scan(comb, (a, bx), axis=1, reverse=reverse)
    return a_cum * h0[:, None, :] + b_cum


def rglru_group(x_ctx, x_lat, conv_w, conv_b, gate_w, gate_b, lam):
    uc = centred_dwconv(x_ctx, conv_w, conv_b).astype(F32)
    ul = centred_dwconv(x_lat, conv_w, conv_b).astype(F32)
    ys_c, ys_l = [], []
    for d, rev in enumerate((False, True)):
        a_c, b_c = rglru_coeffs(uc, gate_w[d, 0], gate_b[d, 0], gate_w[d, 1], gate_b[d, 1], lam[d])
        h_c = linear_scan(a_c, b_c, jnp.zeros_like(uc[:, 0]), rev)
        h_fin = h_c[:, 0] if rev else h_c[:, -1]
        a_l, b_l = rglru_coeffs(ul, gate_w[d, 0], gate_b[d, 0], gate_w[d, 1], gate_b[d, 1], lam[d])
        h_l = linear_scan(a_l, b_l, h_fin, rev)
        ys_c.append(h_c)
        ys_l.append(h_l)
    return (ys_c[0] + ys_c[1]).astype(x_ctx.dtype), (ys_l[0] + ys_l[1]).astype(x_lat.dtype)


def windowed_attention(q, k, v, k_ctx, v_ctx, sink_hg):
    B, S, Hk, G, d = q.shape
    nb = S // BLOCK
    L = k_ctx.shape[1]
    scale = d ** -0.5
    qb = q.reshape(B, nb, BLOCK, Hk, G, d)

    def band(t):
        tb = t.reshape(B, nb, BLOCK, Hk, d)
        tp = jnp.pad(tb, ((0, 0), (1, 1), (0, 0), (0, 0), (0, 0)))
        return jnp.concatenate([tp[:, :-2], tp[:, 1:-1], tp[:, 2:]], axis=2)

    kb, vb = band(k), band(v)
    s_band = jnp.einsum('bnqhgd,bnkhd->bnhgqk', qb, kb, preferred_element_type=F32) * scale
    q_abs = jnp.arange(nb)[:, None, None] * BLOCK + jnp.arange(BLOCK)[None, :, None]
    k_abs = jnp.arange(nb)[:, None, None] * BLOCK - BLOCK + jnp.arange(3 * BLOCK)[None, None, :]
    valid = (jnp.abs(k_abs - q_abs) <= WINDOW) & (k_abs >= 0) & (k_abs < S)
    s_band = jnp.where(valid[None, :, None, None], s_band, NEG_INF)
    s_ctx = jnp.einsum('bnqhgd,bkhd->bnhgqk', qb, k_ctx, preferred_element_type=F32) * scale
    s_sink = jnp.broadcast_to(sink_hg.astype(F32)[None, None, :, :, None, None], s_ctx.shape[:-1] + (1,))
    p = jax.nn.softmax(jnp.concatenate([s_ctx, s_band, s_sink], -1), axis=-1)
    o = (jnp.einsum('bnhgqk,bkhd->bnqhgd', p[..., :L], v_ctx.astype(F32))
         + jnp.einsum('bnhgqk,bnkhd->bnqhgd', p[..., L:-1], vb.astype(F32)))
    return o.reshape(B, S, Hk * G * d).astype(v.dtype)


def context_sink_attention(q, k, v, sink_hg):
    B, L, Hk, G, d = q.shape
    s = jnp.einsum('bqhgd,bkhd->bhgqk', q, k, preferred_element_type=F32) * (d ** -0.5)
    s_sink = jnp.broadcast_to(sink_hg.astype(F32)[None, :, :, None, None], s.shape[:-1] + (1,))
    p = jax.nn.softmax(jnp.concatenate([s, s_sink], -1), axis=-1)[..., :-1]
    o = jnp.einsum('bhgqk,bkhd->bqhgd', p, v.astype(F32))
    return o.reshape(B, L, Hk * G * d).astype(v.dtype)


def diff_attention(q, k, v, lam):
    s = jnp.einsum('bqhmd,bkhmd->bhmqk', q, k, preferred_element_type=F32) * (DIFF_QK ** -0.5)
    p = jax.nn.softmax(s, axis=-1)
    w = p[:, :, 0] - lam * p[:, :, 1]
    return jnp.einsum('bhqk,bkhd->bqhd', w, v.astype(F32)).astype(v.dtype)


def diff_latent(q, k_all, v_all, lam):
    B, S = q.shape[:2]
    nb = S // BLOCK
    qb = jnp.moveaxis(q.reshape((B, nb, BLOCK) + q.shape[2:]), 1, 0)
    ob = lax.map(lambda qblk: diff_attention(qblk, k_all, v_all, lam), qb)
    return jnp.moveaxis(ob, 0, 1).reshape((B, S) + ob.shape[3:])


def diff_head_norm(o, g, lam_init):
    of = o.astype(F32)
    of = of * lax.rsqrt(jnp.mean(jnp.square(of), -1, keepdims=True) + LN_EPS)
    return (of * (1.0 - lam_init)).astype(o.dtype) * g


def token_mix(u_ctx, u_lat, w_in, w_out, conv_w, conv_b, gate_w, gate_b, lru_lam, sink, lam_vec, norm_g,
              lam_init, rope64, rope32, need_ctx):
    B, S, _ = u_lat.shape
    L = u_ctx.shape[1]
    pc = split_cols(u_ctx @ w_in)
    pl = split_cols(u_lat @ w_in)

    lru_c, lru_l = rglru_group(pc[0], pl[0], conv_w, conv_b, gate_w, gate_b, lru_lam)
    lru_c = lru_c * jax.nn.gelu(pc[1])
    lru_l = lru_l * jax.nn.gelu(pl[1])

    sink_hg = sink.reshape(SWA_KV_HEADS, SWA_GROUP)
    qs_l = apply_rope(pl[2].reshape(B, S, SWA_Q_HEADS, HEAD_DIM), *rope64).reshape(B, S, SWA_KV_HEADS, SWA_GROUP, HEAD_DIM)
    ks_l = apply_rope(pl[3].reshape(B, S, SWA_KV_HEADS, HEAD_DIM), *rope64)
    vs_l = pl[4].reshape(B, S, SWA_KV_HEADS, HEAD_DIM)
    ks_c = pc[3].reshape(B, L, SWA_KV_HEADS, HEAD_DIM)
    vs_c = pc[4].reshape(B, L, SWA_KV_HEADS, HEAD_DIM)
    swa_l = windowed_attention(qs_l, ks_l, vs_l, ks_c, vs_c, sink_hg)

    lam_f = lam_vec.astype(F32)
    lam = jnp.exp(jnp.sum(lam_f[0] * lam_f[1])) - jnp.exp(jnp.sum(lam_f[2] * lam_f[3])) + lam_init
    qd_l = apply_rope(pl[5].reshape(B, S, DIFF_HEADS, 2, DIFF_QK), *rope32)
    kd_l = apply_rope(pl[6].reshape(B, S, DIFF_HEADS, 2, DIFF_QK), *rope32)
    vd_l = pl[7].reshape(B, S, DIFF_HEADS, HEAD_DIM)
    kd_c = pc[6].reshape(B, L, DIFF_HEADS, 2, DIFF_QK)
    vd_c = pc[7].reshape(B, L, DIFF_HEADS, HEAD_DIM)
    k_all = jnp.concatenate([kd_c, kd_l], axis=1)
    v_all = jnp.concatenate([vd_c, vd_l], axis=1)
    diff_l = diff_head_norm(diff_latent(qd_l, k_all, v_all, lam), norm_g, lam_init).reshape(B, S, DIFF_WIDTH)

    out_l = jnp.concatenate([lru_l, swa_l, diff_l], axis=-1) @ w_out
    if not need_ctx:
        return None, out_l
    qs_c = pc[2].reshape(B, L, SWA_KV_HEADS, SWA_GROUP, HEAD_DIM)
    swa_c = context_sink_attention(qs_c, ks_c, vs_c, sink_hg)
    qd_c = pc[5].reshape(B, L, DIFF_HEADS, 2, DIFF_QK)
    diff_c = diff_head_norm(diff_attention(qd_c, kd_c, vd_c, lam), norm_g, lam_init).reshape(B, L, DIFF_WIDTH)
    out_c = jnp.concatenate([lru_c, swa_c, diff_c], axis=-1) @ w_out
    return out_c, out_l


def swiglu(u, w1, w3, w2):
    return (jax.nn.silu(u @ w1) * (u @ w3)) @ w2


def moe_swiglu(u, router_w, router_b, w1, w3, w2):
    logits = (u @ router_w + router_b).astype(F32)
    top_v, top_i = lax.top_k(logits, TOP_K)
    gates = jax.nn.softmax(top_v, axis=-1)
    combine = jnp.sum(jax.nn.one_hot(top_i, N_EXPERTS, dtype=F32) * gates[..., None], axis=-2)
    out = jnp.zeros_like(u)
    for e in range(N_EXPERTS):
        out = out + combine[..., e:e + 1].astype(u.dtype) * swiglu(u, w1[e], w3[e], w2[e])
    return out


def setup_inputs(seed: int = 0) -> dict:
    key = jax.random.key(seed)
    ks = jax.random.split(key, 32)
    nrm = jax.random.normal
    D = D_MODEL
    a0 = jax.random.uniform(ks[10], (DEPTH, 2, LRU_WIDTH), minval=0.9, maxval=0.999)
    root = a0 ** (1.0 / LRU_C)
    return {
        "x": nrm(ks[0], (BATCH, SEQ, D), F32),
        "c": nrm(ks[1], (BATCH, D), F32),
        "ctx": nrm(ks[2], (BATCH, CTX_LEN, D), F32),
        "c_ctx": nrm(ks[3], (D,), F32),
        "ada_w": nrm(ks[4], (DEPTH, D, 6 * D), F32) * (0.5 * D ** -0.5),
        "ada_b": nrm(ks[5], (DEPTH, 6 * D), F32) * 0.02,
        "w_in": nrm(ks[6], (DEPTH, D, IN_COLS), F32) * D ** -0.5,
        "w_out": nrm(ks[7], (DEPTH, MIX_WIDTH, D), F32) * (MIX_WIDTH ** -0.5 * DEEPNORM_BETA),
        "lru_conv_w": nrm(ks[8], (DEPTH, CONV_W, LRU_WIDTH), F32) * CONV_W ** -0.5,
        "lru_conv_b": nrm(ks[9], (DEPTH, LRU_WIDTH), F32) * 0.02,
        "lru_gate_w": nrm(ks[11], (DEPTH, 2, 2, LRU_BLOCKS, LRU_BLOCK, LRU_BLOCK), F32) * LRU_BLOCK ** -0.5,
        "lru_gate_b": nrm(ks[12], (DEPTH, 2, 2, LRU_WIDTH), F32) * 0.02,
        "lru_lam": jnp.log(root) - jnp.log1p(-root),
        "swa_sink": nrm(ks[13], (DEPTH, SWA_Q_HEADS), F32) * 0.5,
        "diff_lam": nrm(ks[14], (DEPTH, 4, DIFF_QK), F32) * 0.1,
        "diff_norm_g": 1.0 + 0.02 * nrm(ks[15], (DEPTH, HEAD_DIM), F32),
        "ln_g": 1.0 + 0.02 * nrm(ks[16], (DEPTH, 2, D), F32),
        "ln_b": 0.02 * nrm(ks[17], (DEPTH, 2, D), F32),
        "ffn_w1": nrm(ks[18], (N_DENSE, D, D_FF), F32) * D ** -0.5,
        "ffn_w3": nrm(ks[19], (N_DENSE, D, D_FF), F32) * D ** -0.5,
        "ffn_w2": nrm(ks[20], (N_DENSE, D_FF, D), F32) * (D_FF ** -0.5 * DEEPNORM_BETA),
        "moe_router_w": nrm(ks[21], (N_MOE, D, N_EXPERTS), F32) * D ** -0.5,
        "moe_router_b": nrm(ks[22], (N_MOE, N_EXPERTS), F32) * 0.01,
        "moe_w1": nrm(ks[23], (N_MOE, N_EXPERTS, D, EXPERT_FF), F32) * D ** -0.5,
        "moe_w3": nrm(ks[24], (N_MOE, N_EXPERTS, D, EXPERT_FF), F32) * D ** -0.5,
        "moe_w2": nrm(ks[25], (N_MOE, N_EXPERTS, EXPERT_FF, D), F32) * (EXPERT_FF ** -0.5 * DEEPNORM_BETA),
    }


def reference(x, c, ctx, c_ctx, ada_w, ada_b, w_in, w_out, lru_conv_w, lru_conv_b, lru_gate_w, lru_gate_b,
              lru_lam, swa_sink, diff_lam, diff_norm_g, ln_g, ln_b, ffn_w1, ffn_w3, ffn_w2,
              moe_router_w, moe_router_b, moe_w1, moe_w3, moe_w2):
    S = x.shape[1]
    rows = S // GRID_W
    rope64 = axial_rope(rows, HEAD_DIM)
    rope32 = axial_rope(rows, DIFF_QK)
    silu_c = jax.nn.silu(c)
    silu_cc = jax.nn.silu(c_ctx)
    h_lat, h_ctx = x, ctx
    for layer in range(DEPTH):
        need_ctx = layer < DEPTH - 1
        lam_init = 0.8 - 0.6 * math.exp(-0.3 * layer)
        mod_l = jnp.split((silu_c @ ada_w[layer] + ada_b[layer])[:, None, :], 6, axis=-1)
        mod_c = jnp.split(silu_cc @ ada_w[layer] + ada_b[layer], 6, axis=-1)

        u_lat = h_lat * (1.0 + mod_l[1]) + mod_l[0]
        u_ctx = h_ctx * (1.0 + mod_c[1]) + mod_c[0]
        m_ctx, m_lat = token_mix(u_ctx, u_lat, w_in[layer], w_out[layer], lru_conv_w[layer], lru_conv_b[layer],
                                 lru_gate_w[layer], lru_gate_b[layer], lru_lam[layer], swa_sink[layer],
                                 diff_lam[layer], diff_norm_g[layer], lam_init, rope64, rope32, need_ctx)
        h_lat = layer_norm(DEEPNORM_ALPHA * h_lat + mod_l[2] * m_lat, ln_g[layer, 0], ln_b[layer, 0])
        if need_ctx:
            h_ctx = layer_norm(DEEPNORM_ALPHA * h_ctx + mod_c[2] * m_ctx, ln_g[layer, 0], ln_b[layer, 0])

        u_lat = h_lat * (1.0 + mod_l[4]) + mod_l[3]
        u_ctx = h_ctx * (1.0 + mod_c[4]) + mod_c[3]
        j = layer // 2
        if layer % 2 == 0:
            f_lat = swiglu(u_lat, ffn_w1[j], ffn_w3[j], ffn_w2[j])
            f_ctx = swiglu(u_ctx, ffn_w1[j], ffn_w3[j], ffn_w2[j]) if need_ctx else None
        else:
            f_lat = moe_swiglu(u_lat, moe_router_w[j], moe_router_b[j], moe_w1[j], moe_w3[j], moe_w2[j])
            f_ctx = moe_swiglu(u_ctx, moe_router_w[j], moe_router_b[j], moe_w1[j], moe_w3[j], moe_w2[j]) if need_ctx else None
        h_lat = layer_norm(DEEPNORM_ALPHA * h_lat + mod_l[5] * f_lat, ln_g[layer, 1], ln_b[layer, 1])
        if need_ctx:
            h_ctx = layer_norm(DEEPNORM_ALPHA * h_ctx + mod_c[5] * f_ctx, ln_g[layer, 1], ln_b[layer, 1])
    return h_lat
```

```cpp
#include <hip/hip_runtime.h>
#include <cstdio>
#include <cstdint>

#ifndef MK_N_LAUNCHES
#define MK_N_LAUNCHES 1
#endif

#define LAS __attribute__((address_space(3)))
#define GAS __attribute__((address_space(1)))
typedef unsigned short bf16_t;
typedef short bf16x8 __attribute__((ext_vector_type(8)));
typedef float f32x2 __attribute__((ext_vector_type(2)));
typedef float f32x4 __attribute__((ext_vector_type(4)));
typedef float f32x16 __attribute__((ext_vector_type(16)));
typedef unsigned u32x2 __attribute__((ext_vector_type(2)));
typedef unsigned u32x4 __attribute__((ext_vector_type(4)));
typedef short s16x4 __attribute__((ext_vector_type(4)));
typedef __bf16 bf16x2_t __attribute__((ext_vector_type(2)));

constexpr int D = 1024, NB = 4, SEQ = 4096, CTX = 256, TL = NB * SEQ, TC = NB * CTX, T = TL + TC, KEYS = CTX + SEQ;
constexpr int DEPTH = 4, INC = 2048, FF = 2816, NE = 8, NCB = 5;
constexpr int LRU_CH = 256, LRU_CHUNK = 32, LRU_NCH = KEYS / LRU_CHUNK;
constexpr float ALPHA = 1.6817928305074290f;
constexpr float LN_EPS = 1e-5f;
constexpr float LOG2E = 1.4426950408889634f;
constexpr int MOE_ROWS = 36864;

constexpr size_t MiB = 1u << 20;
constexpr size_t WS_CTL = 0, CTL_ZERO_BYTES = 64 * 1024;
constexpr size_t WS_MOD = 1 * MiB;
constexpr size_t WS_COS64 = WS_MOD + 512 * 1024, WS_SIN64 = WS_COS64 + 512 * 1024;
constexpr size_t WS_COS32 = WS_SIN64 + 512 * 1024, WS_SIN32 = WS_COS32 + 256 * 1024;
constexpr size_t WS_GWT = 3 * MiB;
constexpr size_t WS_CM = WS_GWT + 512 * 1024;
constexpr size_t WS_CARRY = WS_CM + 2304 * 1024;
constexpr size_t WS_KMAX = WS_MOD + 500 * 1024;
constexpr size_t WS_TOKE = 7 * MiB, WS_TOKG = WS_TOKE + 144 * 1024, WS_TOKR = WS_TOKG + 144 * 1024, WS_TOKS = WS_TOKR + 144 * 1024;
constexpr size_t WS_WIN = 8 * MiB;
constexpr size_t WS_WOUT = 24 * MiB;
constexpr size_t WS_F13 = 32 * MiB;
constexpr size_t WS_F2 = 54 * MiB;
constexpr size_t WS_M13 = 65 * MiB;
constexpr size_t WS_M2 = 241 * MiB;
constexpr size_t WS_H = 329 * MiB;
constexpr size_t WS_U = 397 * MiB;
constexpr size_t WS_X = 431 * MiB;
constexpr size_t WS_LRUX = WS_X;
constexpr size_t WS_GATE = WS_LRUX + (size_t)T * 256 * 2;
constexpr size_t WS_QS = WS_GATE + (size_t)T * 256 * 2;
constexpr size_t WS_KS = WS_QS + (size_t)T * 512 * 2;
constexpr size_t WS_VS = WS_KS + (size_t)NB * 2 * KEYS * 64 * 2;
constexpr size_t WS_QD = WS_VS + (size_t)NB * 2 * KEYS * 64 * 2;
constexpr size_t WS_KD = WS_QD + (size_t)T * 256 * 2;
constexpr size_t WS_VD = WS_KD + (size_t)NB * 4 * KEYS * 64 * 2;
constexpr size_t WS_MIX = WS_VD + (size_t)NB * 4 * KEYS * 64 * 2;
constexpr size_t WS_MB = WS_MIX + (size_t)T * 1024 * 2;
constexpr size_t WS_YB = WS_X;
constexpr size_t WS_HID = WS_YB + (size_t)MOE_ROWS * 1024 * 2;
constexpr size_t WS_END = WS_HID + (size_t)MOE_ROWS * FF * 2;
constexpr size_t WS_AB = WS_MB + (size_t)T * 1024 * 2;
static_assert(WS_AB + (size_t)NB * LRU_NCH * 2 * 16384 * 4 <= WS_END, "AB");
constexpr size_t WS_PART2 = WS_X;
constexpr size_t WS_PART4 = 600 * MiB;
static_assert(WS_PART2 + 8 * 4 * MiB <= WS_MIX && WS_PART4 >= WS_HID + (size_t)T * FF * 2 && WS_PART4 + 11 * 4 * MiB <= WS_END, "partial buffers");
static_assert(WS_MB + (size_t)T * 1024 * 2 <= WS_END && WS_CM + (size_t)NB * LRU_NCH * 1024 * 4 <= WS_CARRY && WS_CARRY + (size_t)NB * LRU_NCH * 512 * 4 <= WS_TOKE && (size_t)T * 8 <= 144 * 1024 && WS_TOKS + 144 * 1024 <= WS_WIN, "ws map");
static_assert(WS_HID >= WS_MIX, "HID must not overlay buffers live during the up GEMM inputs");
constexpr int CW_BAR = 4096;
constexpr int CW_CNT = 1024;
constexpr int CW_HO = 2048;
constexpr int CW_HOP = 3072;
static_assert((CW_BAR + 3456) * 4 <= (int)CTL_ZERO_BYTES, "control words inside the memset region");

constexpr int RING_BYTES = 131072;
constexpr int LDSCTL_OFF = RING_BYTES, MISC_OFF = LDSCTL_OFF + 320;
constexpr int LDS_BYTES = 147456;

__device__ __forceinline__ int lane_id() { return (int)__builtin_amdgcn_mbcnt_hi(~0u, __builtin_amdgcn_mbcnt_lo(~0u, 0u)); }
__device__ __forceinline__ int opaque_tid(int wv) { int t = wv * 64 + lane_id(); asm volatile("" : "+v"(t)); return t; }
#ifndef WT_STORES
#define WT_STORES 0
#endif
__device__ __forceinline__ void st16(void* p, u32x4 v) {
#if WT_STORES
    asm volatile("global_store_dwordx4 %0, %1, off sc1\n\ts_nop 1" :: "v"(p), "v"(v) : "memory");
#else
    *(u32x4*)p = v;
#endif
}
__device__ __forceinline__ void st16f(void* p, f32x4 v) { st16(p, __builtin_bit_cast(u32x4, v)); }
__device__ __forceinline__ float clamp_f8(float v) { return __builtin_amdgcn_fmed3f(v, -416.f, 416.f); }
__device__ __forceinline__ unsigned cvt4_fp8(float a, float b, float c, float d) {
    int w = 0; w = __builtin_amdgcn_cvt_pk_fp8_f32(clamp_f8(a), clamp_f8(b), w, false); w = __builtin_amdgcn_cvt_pk_fp8_f32(clamp_f8(c), clamp_f8(d), w, true); return (unsigned)w;
}
constexpr float F8_SU = 4.f, F8_SW13 = 512.f, F8_SH = 2.f, F8_SW2 = 4096.f;
__device__ __forceinline__ unsigned cvtpk(float lo, float hi) { f32x2 v = {lo, hi}; bf16x2_t b = __builtin_convertvector(v, bf16x2_t); return __builtin_bit_cast(unsigned, b); }
__device__ __forceinline__ float bf2f(unsigned short x) { return __uint_as_float(((unsigned)x) << 16); }
__device__ __forceinline__ float bflo(unsigned w) { return __uint_as_float(w << 16); }
__device__ __forceinline__ float bfhi(unsigned w) { return __uint_as_float(w & 0xffff0000u); }
__device__ __forceinline__ float wave_sum(float v) {
#pragma unroll
    for (int o = 1; o < 64; o <<= 1) v += __shfl_xor(v, o);
    return v;
}
__device__ __forceinline__ float fast_exp2(float x) { return __builtin_amdgcn_exp2f(x); }
__device__ __forceinline__ float fast_rcp(float x) { return __builtin_amdgcn_rcpf(x); }
__device__ __forceinline__ float sigmoid_f(float x) { return fast_rcp(1.f + fast_exp2(-LOG2E * x)); }
__device__ __forceinline__ float silu_f(float x) { return x * sigmoid_f(x); }
__device__ __forceinline__ float gelu_tanh_f(float x) {
    const float z = 0.7978845608028654f * (x + 0.044715f * x * x * x);
    return x * sigmoid_f(2.f * z);
}

#define RLX_AGENT __ATOMIC_RELAXED, __HIP_MEMORY_SCOPE_AGENT
__device__ __forceinline__ void ho_signal(unsigned* cnt, int wv) {
    asm volatile("s_waitcnt vmcnt(0)" ::: "memory"); __syncthreads();
    if (wv == 0 && lane_id() == 0) __hip_atomic_fetch_add(cnt, 1u, RLX_AGENT);
}
__device__ __forceinline__ void ho_wait(unsigned* cnt, unsigned target, int wv) {
    if (wv == 0) { unsigned sp = 0u; while (__hip_atomic_load(cnt, RLX_AGENT) < target) { __builtin_amdgcn_s_sleep(4); if (++sp > (1u << 22)) break; } }
    __syncthreads();
}
__device__ __forceinline__ void st_sc1(float* p, float v) { __hip_atomic_store((unsigned*)p, __float_as_uint(v), RLX_AGENT); }
__device__ __forceinline__ float ld_sc1(const float* p) { return __uint_as_float(__hip_atomic_load((const unsigned*)p, RLX_AGENT)); }

namespace pg8 {
#define PG8_LAS __attribute__((address_space(3)))
constexpr int BM = 256, BK = 64, HALF = 128, HTB = HALF * BK * 2  , STAGE_BYTES = 8 * HTB, NXCD = 8, WGM = 8;
__host__ __device__ __forceinline__ int lds_byte(int r, int c) { const int st = (r >> 4) * 2 + (c >> 5), rr = r & 15, cc = c & 31, ob = rr * 64 + cc * 2; return st * 1024 + (ob ^ (((ob >> 9) & 1) << 5)); }
__host__ __device__ __forceinline__ void stage_rc(int b, int& R, int& C) { const int st = b / 1024, sb = b % 1024, swz = sb ^ (((sb >> 9) & 1) << 5); R = (st >> 1) * 16 + swz / 64; C = (st & 1) * 32 + (swz % 64) / 2; }
__host__ __device__ __forceinline__ int perm32(int rho) { const int n = rho >> 4, i = rho & 15; return 8 * (i >> 2) + 4 * n + (i & 3); }

struct Unit { int pm, pn, pb, sp, nk, kofs, hf; };
struct Gemm { const void* A; const void* Bt; int ld; };

constexpr int UNIT_LIST_OFF = RING_BYTES + 1024, UNIT_LIST_MAX = 64;
struct TileSched {
    PG8_LAS unsigned* ul; int nk_full, nk_piece;
    __device__ __forceinline__ void build(PG8_LAS unsigned char* lds, int wv, int nM, int nN, int G, int c, int nNb, const int (&ts)[9], int nkf, int nMs = 0, int nsplit = 1, int nkp = 0, bool halves = false) {
        ul = (PG8_LAS unsigned*)(lds + UNIT_LIST_OFF); nk_full = nkf; nk_piece = nkp;
        const int t = opaque_tid(wv);
        if (t < 2 * UNIT_LIST_MAX) {
            const int i = t & (UNIT_LIST_MAX - 1); const bool listB = t >= UNIT_LIST_MAX;
            const int nwg = nM * nN; int nfullU = nwg; if (halves) { const int f = (nwg / G) * G; if (2 * (nwg - f) <= G) nfullU = f; }
            long L = (long)i * G + c; unsigned w = 0xffffffffu; unsigned hf = 0u; bool whole = false;
            if (!listB) { whole = L < nfullU; }
            else { if (L < 2 * (long)(nwg - nfullU)) { hf = (unsigned)(L & 1); L = nfullU + (L >> 1); whole = true; } }
            if (whole) {
                int wgid = (int)L; { const int q = nwg / NXCD, r = nwg % NXCD, xcd = wgid % NXCD, off = wgid / NXCD; wgid = (xcd < r ? xcd * (q + 1) : r * (q + 1) + (xcd - r) * q) + off; }
                const int nig = WGM * nN, gid = wgid / nig, fm = gid * WGM, gsz = (nM - fm) < WGM ? (nM - fm) : WGM;
                const int pm = fm + ((wgid % nig) % gsz), pn = (wgid % nig) / gsz;
                int e = 0;
#pragma unroll
                for (int k = 1; k < 8; ++k) e += (pm >= ts[k]) ? 1 : 0;
                w = (unsigned)pm | ((unsigned)pn << 10) | ((unsigned)(e * nNb + pn) << 16) | (hf << 29);
            } else if (!listB && L >= nwg && L - nwg < (long)nMs * nN * nsplit) {
                const int Ls = (int)(L - nwg), per = nN * nsplit, pm = nM + Ls / per, rem = Ls % per, pn = rem / nsplit, sp = rem % nsplit + 1;
                w = (unsigned)pm | ((unsigned)pn << 10) | ((unsigned)pn << 16) | ((unsigned)sp << 24);
            }
            ul[t] = w;
        }
        __syncthreads();
    }
    __device__ __forceinline__ TileSched listB() const { TileSched s = *this; s.ul = ul + UNIT_LIST_MAX; return s; }
    __device__ __forceinline__ bool next(int i, Unit& u) const {
        if (i >= UNIT_LIST_MAX) return false;
        const unsigned w = (unsigned)__builtin_amdgcn_readfirstlane((int)ul[i]);
        if (w == 0xffffffffu) return false;
        u.pm = (int)(w & 1023u); u.pn = (int)((w >> 10) & 63u); u.pb = (int)((w >> 16) & 255u); u.sp = (int)((w >> 24) & 31u); u.hf = (int)((w >> 29) & 1u);
        u.nk = u.sp ? nk_piece : nk_full; u.kofs = u.sp ? (u.sp - 1) * nk_piece * 128 : 0; return true;
    }
    __device__ __forceinline__ void a_ready(const Unit&) const {}
    __device__ __forceinline__ void done(const Unit&) const {}
};

struct EpiPlain {
    static constexpr bool PERM = true, AFTER_DRAIN = false;
    bf16_t* O; int ldc; float* PART; int prow0; float scale;
    template <bool HN> __device__ __forceinline__ void run(const f32x4 (&acc)[2][2][4][2], const Unit& u, int wr, int wc, int fr_, int fq_) const {
        int ln_ = lane_id(); asm volatile("" : "+v"(ln_)); const int fr = ln_ & 15, fq = ln_ >> 4; (void)fr_; (void)fq_;
        int lrow = wr * 64 + fr, lcol = wc * 32 + 8 * fq; asm volatile("" : "+v"(lrow), "+v"(lcol));
        const int row0 = u.pm * BM + lrow, col0 = u.pn * BM + lcol + (HN ? u.hf * HALF : 0);
        if (!HN && u.sp) {
            float* P = PART + ((size_t)(u.sp - 1) * 1024 + (row0 - prow0)) * ldc + col0;
#pragma unroll
            for (int ai = 0; ai < 2; ++ai)
#pragma unroll
                for (int m = 0; m < 4; ++m) { float* rowp = P + (size_t)(ai * HALF + m * 16) * ldc;
#pragma unroll
                    for (int bj = 0; bj < 2; ++bj) { st16f(rowp + bj * HALF, acc[ai][bj][m][0] * scale); st16f(rowp + bj * HALF + 4, acc[ai][bj][m][1] * scale); } }
            return;
        }
#pragma unroll
        for (int ai = 0; ai < 2; ++ai)
#pragma unroll
            for (int m = 0; m < 4; ++m) { bf16_t* rowp = O + (size_t)(row0 + ai * HALF + m * 16) * ldc + col0;
#pragma unroll
                for (int bj = 0; bj < (HN ? 1 : 2); ++bj) { const f32x4 v0 = acc[ai][bj][m][0] * scale, v1 = acc[ai][bj][m][1] * scale;
                    u32x4 w; w.x = cvtpk(v0[0], v0[1]); w.y = cvtpk(v0[2], v0[3]); w.z = cvtpk(v1[0], v1[1]); w.w = cvtpk(v1[2], v1[3]);
                    st16(rowp + bj * HALF, w); } }
    }
};
struct EpiSwiGLU {
    static constexpr bool PERM = true, AFTER_DRAIN = false;
    bf16_t* O; int ldc;
    template <bool HN> __device__ __forceinline__ void run(const f32x4 (&acc)[2][2][4][2], const Unit& u, int wr, int wc, int fr_, int fq_) const {
        int ln_ = lane_id(); asm volatile("" : "+v"(ln_)); const int fr = ln_ & 15, fq = ln_ >> 4; (void)fr_; (void)fq_;
        static_assert(!HN, "SwiGLU tiles pair the two column halves");
        int lrow = wr * 64 + fr, lcol = wc * 32 + 8 * fq; asm volatile("" : "+v"(lrow), "+v"(lcol));
        const int row0 = u.pm * BM + lrow, col0 = u.pn * HALF + lcol;
#pragma unroll
        for (int ai = 0; ai < 2; ++ai)
#pragma unroll
            for (int m = 0; m < 4; ++m) { bf16_t* rowp = O + (size_t)(row0 + ai * HALF + m * 16) * ldc + col0;
                float h[8];
#pragma unroll
                for (int n = 0; n < 2; ++n)
#pragma unroll
                    for (int j = 0; j < 4; ++j) h[4 * n + j] = silu_f(acc[ai][0][m][n][j]) * acc[ai][1][m][n][j];
                u32x4 w; w.x = cvtpk(h[0], h[1]); w.y = cvtpk(h[2], h[3]); w.z = cvtpk(h[4], h[5]); w.w = cvtpk(h[6], h[7]);
                st16(rowp, w); }
    }
};
struct EpiSwiGLU8 {
    static constexpr bool PERM = true, AFTER_DRAIN = false;
    unsigned char* O8; int ldc;
    template <bool HN> __device__ __forceinline__ void run(const f32x4 (&acc)[2][2][4][2], const Unit& u, int wr, int wc, int fr_, int fq_) const {
        int ln_ = lane_id(); asm volatile("" : "+v"(ln_)); const int fr = ln_ & 15, fq = ln_ >> 4; (void)fr_; (void)fq_;
        static_assert(!HN, "SwiGLU tiles pair the two column halves");
        int lrow = wr * 64 + fr, lcol = wc * 32 + 8 * fq; asm volatile("" : "+v"(lrow), "+v"(lcol));
        const int row0 = u.pm * BM + lrow, col0 = u.pn * HALF + lcol;
        constexpr float si = 1.f / (F8_SU * F8_SW13);
#pragma unroll
        for (int ai = 0; ai < 2; ++ai)
#pragma unroll
            for (int m = 0; m < 4; ++m) { unsigned char* rowp = O8 + (size_t)(row0 + ai * HALF + m * 16) * ldc + col0;
                float h[8];
#pragma unroll
                for (int n = 0; n < 2; ++n)
#pragma unroll
                    for (int j = 0; j < 4; ++j) h[4 * n + j] = silu_f(acc[ai][0][m][n][j] * si) * (acc[ai][1][m][n][j] * (si * F8_SH));
                u32x2 w; w.x = cvt4_fp8(h[0], h[1], h[2], h[3]); w.y = cvt4_fp8(h[4], h[5], h[6], h[7]);
                *(u32x2*)rowp = w; }
    }
};
struct EpiIn {
    static constexpr bool PERM = true, AFTER_DRAIN = false;
    bf16_t *LRUX, *GATE, *QS, *KS, *VS, *QD, *KD, *VD; const float *c64, *s64, *c32, *s32;
    template <bool HN> __device__ __forceinline__ void run(const f32x4 (&acc)[2][2][4][2], const Unit& u, int wr, int wc, int fr_, int fq_) const {
        int ln_ = lane_id(); asm volatile("" : "+v"(ln_)); const int fr = ln_ & 15, fq = ln_ >> 4; (void)fr_; (void)fq_;
        const int pm = u.pm, pn = u.pn;
        const bool lat = pm < 64;
        const int b = lat ? (pm >> 4) : (pm - 64);
        const int kr0 = lat ? CTX + (pm & 15) * 256 : 0;
        const int s0 = (pm & 15) * 256;
        const int lr0 = wr * 64 + fr;
        int cw = wc * 32 + 8 * fq;
        asm volatile("" : "+v"(cw));
#pragma unroll
        for (int bjl = 0; bjl < (HN ? 1 : 2); ++bjl) {
            const int bj = HN ? u.hf : bjl;
            const int ct = bj * HALF + cw;
            bf16_t* base; int stride; int mode = 0; float scale = 1.f; int pidx = 0; bool gel = false;
            if (pn == 0) { base = LRUX + (size_t)pm * 256 * 256 + ct; stride = 256; }
            else if (pn == 1) { base = GATE + (size_t)pm * 256 * 256 + ct; stride = 256; gel = true; }
            else if (pn == 2 || pn == 3) { const int col = (pn - 2) * 256 + ct; base = QS + (size_t)pm * 256 * 512 + col; stride = 512; mode = 1; pidx = (col & 63) >> 1; scale = 0.125f * LOG2E; }
            else if (pn == 4) { const int hk = (ct & 127) >> 6; bf16_t* kv = bj == 0 ? KS : VS; base = kv + ((size_t)(b * 2 + hk) * KEYS + kr0) * 64 + (ct & 63); stride = 64; mode = bj == 0 ? 1 : 0; pidx = (ct & 63) >> 1; }
            else if (pn == 5) { base = QD + (size_t)pm * 256 * 256 + ct; stride = 256; mode = 2; pidx = (ct & 31) >> 1; scale = 0.17677669529663687f * LOG2E; }
            else { const int h = ct >> 6; bf16_t* kv = pn == 6 ? KD : VD; base = kv + ((size_t)(b * 4 + h) * KEYS + kr0) * 64 + (ct & 63); stride = 64; mode = pn == 6 ? 2 : 0; pidx = (ct & 31) >> 1; }
            if (!lat) mode = 0;
            const bool colb = mode == 1 ? (pidx >= 16) : (pidx >= 8);
            f32x4 ce[4], se[4];
            if (mode != 0) {
#pragma unroll
                for (int k = 0; k < 4; ++k) { const int sk = s0 + lr0 + (colb ? 16 * k : 128 * (k & 1));
                    const float* ct_ = mode == 1 ? c64 + (size_t)sk * 32 + pidx : c32 + (size_t)sk * 16 + pidx;
                    const float* st_ = mode == 1 ? s64 + (size_t)sk * 32 + pidx : s32 + (size_t)sk * 16 + pidx;
                    ce[k] = *(const f32x4*)ct_; se[k] = *(const f32x4*)st_; }
            }
#pragma unroll
            for (int ai = 0; ai < 2; ++ai)
#pragma unroll
                for (int m = 0; m < 4; ++m) {
                    const int lr = lr0 + ai * HALF + m * 16;
                    f32x4 v0 = acc[ai][bjl][m][0], v1 = acc[ai][bjl][m][1];
                    if (mode != 0) {
                        f32x4 cs, sn;
#pragma unroll
                        for (int j = 0; j < 4; ++j) { cs[j] = colb ? ce[m][j] : ce[ai][j]; sn[j] = colb ? se[m][j] : se[ai][j]; }
                        f32x4 r0, r1;
                        r0[0] = v0[0] * cs[0] - v0[1] * sn[0]; r0[1] = v0[1] * cs[0] + v0[0] * sn[0];
                        r0[2] = v0[2] * cs[1] - v0[3] * sn[1]; r0[3] = v0[3] * cs[1] + v0[2] * sn[1];
                        r1[0] = v1[0] * cs[2] - v1[1] * sn[2]; r1[1] = v1[1] * cs[2] + v1[0] * sn[2];
                        r1[2] = v1[2] * cs[3] - v1[3] * sn[3]; r1[3] = v1[3] * cs[3] + v1[2] * sn[3];
                        v0 = r0; v1 = r1;
                    }
                    if (gel) {
#pragma unroll
                        for (int j = 0; j < 4; ++j) { v0[j] = gelu_tanh_f(v0[j]); v1[j] = gelu_tanh_f(v1[j]); }
                    }
                    v0 = v0 * scale; v1 = v1 * scale;
                    u32x4 w; w.x = cvtpk(v0[0], v0[1]); w.y = cvtpk(v0[2], v0[3]); w.z = cvtpk(v1[0], v1[1]); w.w = cvtpk(v1[2], v1[3]);
                    st16(base + (size_t)lr * stride, w);
                }
            asm volatile("" ::: "memory");
        }
    }
};

template <class Epi, class Sched, bool ALIGN_EPI = false, bool SP2 = false, bool HN = false, bool F8 = false>
__device__ __forceinline__ void gemm_phase(PG8_LAS unsigned char* lds, const int wv, const Gemm g, const Sched& S, const Epi& E) {
    const int tid = opaque_tid(wv), wid = __builtin_amdgcn_readfirstlane(tid >> 6), lane = tid & 63, wr = wid >> 2, wc = wid & 3, fr = lane & 15, fq = lane >> 4;
    constexpr int ESZ = F8 ? 1 : 2;
    const int K = g.ld;
    unsigned voffA[2], voffB[2];
#pragma unroll
    for (int i = 0; i < 2; ++i) { int R, C; stage_rc(tid * 16 + i * 8192, R, C); const int Rb = Epi::PERM ? ((R & ~31) + perm32(R & 31)) : R;
        voffA[i] = (unsigned)(R * K * ESZ + C * 2); voffB[i] = (unsigned)(Rb * K * ESZ + C * 2); }
    const size_t kstep = (size_t)(BK * 2);
    const size_t hstep = (size_t)HALF * K * ESZ;
    const size_t tstep = 2 * hstep;
    const unsigned ldsbase = (unsigned)(uintptr_t)lds + (unsigned)wid * 1024u;
    const unsigned ldsw = (unsigned)wid * 1024u;
    const int aoff = lds_byte(wr * 64 + fr, fq * 8), boff = lds_byte(wc * 32 + fr, fq * 8);
#define PG8_SA(b, h) (((b) * 2 + (h)) * HTB)
#define PG8_SB(b, h) ((4 + (b) * 2 + (h)) * HTB)
#define PG8_STAGE(bufoff, gbase, voff) do { _Pragma("unroll") for (int _i = 0; _i < 2; ++_i) { unsigned keep_; \
        asm volatile("s_mov_b32 %0, m0\n\ts_mov_b32 m0, %3\n\ts_nop 0\n\tglobal_load_lds_dwordx4 %1, %2\n\ts_mov_b32 m0, %0" \
                     : "=&s"(keep_) : "v"((voff)[_i]), "s"((const char*)(gbase)), "s"(ldsbase + (unsigned)((bufoff) + _i * 8192)) : "memory"); } } while (0)
#define PG8_LDA(dst, b, h) do { _Pragma("unroll") for (int m = 0; m < 4; ++m) { if constexpr (F8) { dst##8[m].lo = *(const PG8_LAS v4i_t*)(lds + PG8_SA(b, h) + aoff + m * 2048); dst##8[m].hi = *(const PG8_LAS v4i_t*)(lds + PG8_SA(b, h) + aoff + m * 2048 + 1024); } \
        else { _Pragma("unroll") for (int k = 0; k < 2; ++k) dst[m][k] = *(const PG8_LAS bf16x8*)(lds + PG8_SA(b, h) + aoff + m * 2048 + k * 1024); } } } while (0)
#define PG8_LDB(dst, b, h) do { _Pragma("unroll") for (int n = 0; n < 2; ++n) { if constexpr (F8) { dst##8[n].lo = *(const PG8_LAS v4i_t*)(lds + PG8_SB(b, h) + boff + n * 2048); dst##8[n].hi = *(const PG8_LAS v4i_t*)(lds + PG8_SB(b, h) + boff + n * 2048 + 1024); } \
        else { _Pragma("unroll") for (int k = 0; k < 2; ++k) dst[n][k] = *(const PG8_LAS bf16x8*)(lds + PG8_SB(b, h) + boff + n * 2048 + k * 1024); } } } while (0)
#define PG8_MMA(ai, bj, At, Bt) do { __builtin_amdgcn_s_setprio(1); _Pragma("unroll") for (int m = 0; m < 4; ++m) _Pragma("unroll") for (int n = 0; n < 2; ++n) { \
        if constexpr (F8) acc[ai][bj][m][n] = __builtin_amdgcn_mfma_scale_f32_16x16x128_f8f6f4(Bt##8[n], At##8[m], acc[ai][bj][m][n], 0, 0, 0, f8one, 0, f8one); \
        else { _Pragma("unroll") for (int k = 0; k < 2; ++k) acc[ai][bj][m][n] = __builtin_amdgcn_mfma_f32_16x16x32_bf16(Bt[n][k], At[m][k], acc[ai][bj][m][n], 0, 0, 0); } } \
        __builtin_amdgcn_s_setprio(0); } while (0)
#define PG8_WAIT_V(n) asm volatile("s_waitcnt vmcnt(" #n ")" ::: "memory")
#define PG8_WAIT_L(n) asm volatile("s_waitcnt lgkmcnt(" #n ")" ::: "memory")
#define PG8_BAR __builtin_amdgcn_s_barrier()
#define PG8_SCHED __builtin_amdgcn_sched_barrier(0)
    Unit cur, nxt; int ui = 0;
    if (!S.next(0, cur)) return;
    f32x4 acc[2][2][4][2];
#pragma unroll
    for (int a = 0; a < 2; ++a)
#pragma unroll
        for (int b = 0; b < 2; ++b)
#pragma unroll
            for (int m = 0; m < 4; ++m)
#pragma unroll
                for (int n = 0; n < 2; ++n) acc[a][b][m][n] = (f32x4){0.f, 0.f, 0.f, 0.f};
    int f8one; asm volatile("s_mov_b32 %0, 0x7f7f7f7f" : "=s"(f8one));
    typedef int v4i_t __attribute__((ext_vector_type(4))); typedef int v8i_t __attribute__((ext_vector_type(8)));
    bf16x8 At[4][2], B0[2][2], B1[2][2]; v8i_t At8[4], B08[2], B18[2];
    const char* cA = (const char*)g.A + (size_t)cur.pm * tstep + (size_t)cur.kofs; const char* cB = (const char*)g.Bt + (size_t)cur.pb * tstep + (size_t)cur.hf * hstep + (size_t)cur.kofs;
    int nt = cur.nk;
    S.a_ready(cur);
    if constexpr (SP2 && HN) {
        static_assert(!HN || SP2, "HN needs SP2");
        PG8_STAGE(PG8_SB(0, 0), cB, voffB); PG8_STAGE(PG8_SA(0, 0), cA, voffA); PG8_STAGE(PG8_SA(0, 1), cA + hstep, voffA);
        if (wr == 1) PG8_BAR;
        PG8_WAIT_V(2); PG8_BAR;
        PG8_STAGE(PG8_SB(1, 0), cB + kstep, voffB); PG8_STAGE(PG8_SA(1, 0), cA + kstep, voffA);
        PG8_WAIT_V(4); PG8_BAR;
    } else if constexpr (SP2) {
        PG8_STAGE(PG8_SB(0, 0), cB, voffB); PG8_STAGE(PG8_SB(0, 1), cB + hstep, voffB); PG8_STAGE(PG8_SA(0, 0), cA, voffA); PG8_STAGE(PG8_SA(0, 1), cA + hstep, voffA);
        if (wr == 1) PG8_BAR;
        PG8_WAIT_V(2); PG8_BAR;
        PG8_STAGE(PG8_SB(1, 0), cB + kstep, voffB); PG8_STAGE(PG8_SA(1, 0), cA + kstep, voffA); PG8_STAGE(PG8_SB(1, 1), cB + hstep + kstep, voffB);
        PG8_WAIT_V(6); PG8_BAR;
    } else {
        PG8_STAGE(PG8_SB(0, 0), cB, voffB); PG8_STAGE(PG8_SA(0, 0), cA, voffA); PG8_STAGE(PG8_SB(0, 1), cB + hstep, voffB); PG8_STAGE(PG8_SA(0, 1), cA + hstep, voffA);
        if (wr == 1) PG8_BAR;
        PG8_WAIT_V(4); PG8_BAR;
        PG8_STAGE(PG8_SB(1, 0), cB + kstep, voffB); PG8_STAGE(PG8_SA(1, 0), cA + kstep, voffA); PG8_STAGE(PG8_SB(1, 1), cB + hstep + kstep, voffB);
        PG8_WAIT_V(6); PG8_BAR;
    }
    for (;;) {
        const bool has_next = S.next(ui + 1, nxt);
        const char* nA = has_next ? (const char*)g.A + (size_t)nxt.pm * tstep + (size_t)nxt.kofs : cA; const char* nB = has_next ? (const char*)g.Bt + (size_t)nxt.pb * tstep + (size_t)nxt.hf * hstep + (size_t)nxt.kofs : cB;
        for (int t = 0; t < nt; t += 2) {
            const bool last = (t == nt - 2);
            const char* a1 = cA + (size_t)(t + 1) * kstep;
            const char* a2 = last ? nA : cA + (size_t)(t + 2) * kstep; const char* b2 = last ? nB : cB + (size_t)(t + 2) * kstep;
            const char* a3 = a2 + kstep; const char* b3 = b2 + kstep;
            if (last && has_next) S.a_ready(nxt);
            if constexpr (SP2 && HN) {
            PG8_LDB(B0, 0, 0); PG8_SCHED; PG8_LDA(At, 0, 0); PG8_STAGE(PG8_SA(1, 1), a1 + hstep, voffA);
            PG8_WAIT_V(6); PG8_WAIT_L(0); PG8_BAR; PG8_MMA(0, 0, At, B0); PG8_BAR; PG8_SCHED;
            PG8_LDA(At, 0, 1); PG8_STAGE(PG8_SB(0, 0), b2, voffB); PG8_STAGE(PG8_SA(0, 0), a2, voffA);
            PG8_WAIT_V(6); PG8_WAIT_L(0); PG8_BAR; PG8_MMA(1, 0, At, B0); PG8_BAR; PG8_SCHED;
            PG8_LDB(B0, 1, 0); PG8_SCHED; PG8_LDA(At, 1, 0); PG8_STAGE(PG8_SA(0, 1), a2 + hstep, voffA);
            PG8_WAIT_V(6); PG8_WAIT_L(0); PG8_BAR; PG8_MMA(0, 0, At, B0); PG8_BAR; PG8_SCHED;
            PG8_LDA(At, 1, 1); PG8_STAGE(PG8_SB(1, 0), b3, voffB); PG8_STAGE(PG8_SA(1, 0), a3, voffA);
            PG8_WAIT_V(6); PG8_WAIT_L(0); PG8_BAR; PG8_MMA(1, 0, At, B0); PG8_BAR; PG8_SCHED;
            } else if constexpr (SP2) {
            PG8_LDB(B0, 0, 0); PG8_LDB(B1, 0, 1); PG8_SCHED; PG8_LDA(At, 0, 0); PG8_STAGE(PG8_SA(1, 1), a1 + hstep, voffA);
            PG8_WAIT_V(8); PG8_WAIT_L(0); PG8_BAR; PG8_MMA(0, 0, At, B0); PG8_MMA(0, 1, At, B1); PG8_BAR; PG8_SCHED;
            PG8_LDA(At, 0, 1); PG8_STAGE(PG8_SB(0, 0), b2, voffB); PG8_STAGE(PG8_SB(0, 1), b2 + hstep, voffB); PG8_STAGE(PG8_SA(0, 0), a2, voffA);
            PG8_WAIT_V(8); PG8_WAIT_L(0); PG8_BAR; PG8_MMA(1, 0, At, B0); PG8_MMA(1, 1, At, B1); PG8_BAR; PG8_SCHED;
            PG8_LDB(B0, 1, 0); PG8_LDB(B1, 1, 1); PG8_SCHED; PG8_LDA(At, 1, 0); PG8_STAGE(PG8_SA(0, 1), a2 + hstep, voffA);
            PG8_WAIT_V(8); PG8_WAIT_L(0); PG8_BAR; PG8_MMA(0, 0, At, B0); PG8_MMA(0, 1, At, B1); PG8_BAR; PG8_SCHED;
            PG8_LDA(At, 1, 1); PG8_STAGE(PG8_SB(1, 0), b3, voffB); PG8_STAGE(PG8_SB(1, 1), b3 + hstep, voffB); PG8_STAGE(PG8_SA(1, 0), a3, voffA);
            PG8_WAIT_V(8); PG8_WAIT_L(0); PG8_BAR; PG8_MMA(1, 0, At, B0); PG8_MMA(1, 1, At, B1); PG8_BAR; PG8_SCHED;
            } else {
            PG8_LDB(B0, 0, 0); PG8_SCHED; PG8_LDA(At, 0, 0); PG8_STAGE(PG8_SA(1, 1), a1 + hstep, voffA);
            PG8_WAIT_L(8); PG8_BAR; PG8_WAIT_L(0); PG8_MMA(0, 0, At, B0); PG8_BAR; PG8_SCHED;
            PG8_LDB(B1, 0, 1); PG8_STAGE(PG8_SB(0, 0), b2, voffB);
            PG8_BAR; PG8_WAIT_L(0); PG8_MMA(0, 1, At, B1); PG8_BAR;
            PG8_LDA(At, 0, 1); PG8_STAGE(PG8_SA(0, 0), a2, voffA);
            PG8_BAR; PG8_WAIT_L(0); PG8_MMA(1, 0, At, B0); PG8_BAR; PG8_SCHED;
            PG8_STAGE(PG8_SB(0, 1), b2 + hstep, voffB);
            PG8_WAIT_V(6); PG8_BAR; PG8_MMA(1, 1, At, B1); PG8_BAR;
            PG8_LDB(B0, 1, 0); PG8_SCHED; PG8_LDA(At, 1, 0); PG8_STAGE(PG8_SA(0, 1), a2 + hstep, voffA);
            PG8_WAIT_L(8); PG8_BAR; PG8_WAIT_L(0); PG8_MMA(0, 0, At, B0); PG8_BAR; PG8_SCHED;
            PG8_LDB(B1, 1, 1); PG8_STAGE(PG8_SB(1, 0), b3, voffB);
            PG8_BAR; PG8_WAIT_L(0); PG8_MMA(0, 1, At, B1); PG8_BAR;
            PG8_LDA(At, 1, 1); PG8_STAGE(PG8_SA(1, 0), a3, voffA);
            PG8_BAR; PG8_WAIT_L(0); PG8_MMA(1, 0, At, B0); PG8_BAR; PG8_SCHED;
            PG8_STAGE(PG8_SB(1, 1), b3 + hstep, voffB);
            PG8_WAIT_V(6); PG8_BAR; PG8_MMA(1, 1, At, B1); PG8_BAR;
            }
        }
        if constexpr (ALIGN_EPI) { if (wr == 0) PG8_BAR; }
        if constexpr (!Epi::AFTER_DRAIN) { E.template run<HN>(acc, cur, wr, wc, fr, fq); S.done(cur); }
        if (!has_next) break;
#pragma unroll
        for (int a = 0; a < 2; ++a)
#pragma unroll
            for (int b = 0; b < 2; ++b)
#pragma unroll
                for (int m = 0; m < 4; ++m)
#pragma unroll
                    for (int n = 0; n < 2; ++n) acc[a][b][m][n] = (f32x4){0.f, 0.f, 0.f, 0.f};
        cur = nxt; cA = nA; cB = nB; ++ui; nt = cur.nk;
        if constexpr (ALIGN_EPI) { if (wr == 1) PG8_BAR; }
    }
    PG8_WAIT_V(0);
    if constexpr (!ALIGN_EPI) { if (wr == 0) PG8_BAR; }
    PG8_BAR;
    if constexpr (Epi::AFTER_DRAIN) { E.fused(acc, cur, wr, wc, fr, fq, lds, wid, lane); S.done(cur); }
#undef PG8_SA
#undef PG8_SB
#undef PG8_STAGE
#undef PG8_LDA
#undef PG8_LDB
#undef PG8_MMA
#undef PG8_WAIT_V
#undef PG8_WAIT_L
#undef PG8_BAR
#undef PG8_SCHED
}
}

#define XB_TMO      128
#define XB_XCNT(j)  (256  + 64 * (j))
#define XB_XSUB(j)  (1280 + 64 * (j))
#define XB_XGEN(j)  (2304 + 64 * (j))
#define XB_TOP      3328
#define XB_TOPGEN   3392
#define XCD_BAR_WORDS 3456
#define XB_SPIN_CAP (1u << 18)

__device__ __forceinline__ unsigned xb_ld(unsigned* p)              { return __hip_atomic_load(p, __ATOMIC_RELAXED, __HIP_MEMORY_SCOPE_AGENT); }
__device__ __forceinline__ unsigned xb_add(unsigned* p, unsigned v) { return __hip_atomic_fetch_add(p, v, __ATOMIC_RELAXED, __HIP_MEMORY_SCOPE_AGENT); }
__device__ __forceinline__ unsigned xb_xcc_id() { return (unsigned)__builtin_amdgcn_s_getreg((3 << 11) | 20) & 0xFu; }
#define XB_SPIN(cond, bar) do { unsigned _sp = 0; while (cond) { __builtin_amdgcn_s_sleep(1); \
    if ((++_sp & 255u) == 0u) { if (xb_ld(&(bar)[XB_TMO])) break; if (_sp > XB_SPIN_CAP) { atomicAdd(&(bar)[XB_TMO], 1u); break; } } } } while (0)

struct XcdBarrier {
    unsigned* bar; unsigned x; int wv;
    volatile LAS unsigned* st;
};

__device__ __forceinline__ XcdBarrier xcd_barrier_post(unsigned* bar, volatile LAS unsigned* st, int wv) {
    XcdBarrier b; b.bar = bar; b.x = xb_xcc_id(); b.st = st; b.wv = wv;
    if (wv == 0 && lane_id() == 0) (void)xb_add(&bar[XB_XCNT(b.x)], 1u);
    return b;
}
__device__ __forceinline__ void xcd_barrier_complete(unsigned* bar, unsigned x, unsigned& nloc, unsigned& nx) {
    const unsigned G = gridDim.x * gridDim.y * gridDim.z;
    unsigned sum, cnt, mine, sp = 0u;
    for (;;) {
        sum = 0u; cnt = 0u; mine = 0u;
#pragma unroll
        for (unsigned j = 0; j < 16; ++j) { const unsigned c = xb_ld(&bar[XB_XCNT(j)]); sum += c; cnt += (c > 0u) ? 1u : 0u; mine = (j == x) ? c : mine; }
        if (sum == G) break;
        __builtin_amdgcn_s_sleep(1);
        if ((++sp & 255u) == 0u) { if (xb_ld(&bar[XB_TMO])) break; if (sp > XB_SPIN_CAP) { atomicAdd(&bar[XB_TMO], 1u); break; } }
    }
    nloc = mine > 0u ? mine : 1u; nx = cnt > 0u ? cnt : 1u;
}

__device__ __forceinline__ void xcd_barrier(const XcdBarrier& b) {
    asm volatile("s_waitcnt vmcnt(0)" ::: "memory");
    __syncthreads();
    if (b.wv == 0 && lane_id() == 0) {
        unsigned* bar = b.bar;
        __builtin_amdgcn_s_waitcnt(0);
        unsigned nloc = b.st[0], nx = b.st[1];
        if (nloc == 0u) { xcd_barrier_complete(bar, b.x, nloc, nx); b.st[0] = nloc; b.st[1] = nx; }
        const unsigned old = xb_add(&bar[XB_XSUB(b.x)], 1u);
        const unsigned gen = old / nloc;
        if (old + 1u == (gen + 1u) * nloc) {
            __builtin_amdgcn_fence(__ATOMIC_RELEASE, "agent");
            asm volatile("s_waitcnt vmcnt(0)" ::: "memory");
            const unsigned og = xb_add(&bar[XB_TOP], 1u);
            const unsigned tg = og / nx;
            if (og + 1u == (tg + 1u) * nx) xb_add(&bar[XB_TOPGEN], 1u);
            else XB_SPIN(xb_ld(&bar[XB_TOPGEN]) == tg, bar);
            __builtin_amdgcn_fence(__ATOMIC_ACQUIRE, "agent");
            xb_add(&bar[XB_XGEN(b.x)], 1u);
            asm volatile("s_waitcnt vmcnt(0)" ::: "memory");
        } else {
            XB_SPIN(xb_ld(&bar[XB_XGEN(b.x)]) == gen, bar);
            __builtin_amdgcn_fence(__ATOMIC_ACQUIRE, "agent");
            asm volatile("s_waitcnt vmcnt(0)" ::: "memory");
        }
    }
    __syncthreads();
}

#ifndef DIFF_STAG
#define DIFF_STAG 1
#endif
__device__ __forceinline__ int crow(int e, int h) { return (e & 3) + 8 * (e >> 2) + 4 * h; }
__device__ __forceinline__ float xhalf_max(float m) { auto rr = __builtin_amdgcn_permlane32_swap(__float_as_uint(m), __float_as_uint(m), false, false); return fmaxf(__uint_as_float(rr[0]), __uint_as_float(rr[1])); }
__device__ __forceinline__ float xhalf_sum(float m) { auto rr = __builtin_amdgcn_permlane32_swap(__float_as_uint(m), __float_as_uint(m), false, false); return __uint_as_float(rr[0]) + __uint_as_float(rr[1]); }
typedef short v4i16_t __attribute__((ext_vector_type(4)));
__device__ __forceinline__ void glds16(const void* gsrc, unsigned lds_dst) { unsigned keep;
    asm volatile("s_mov_b32 %0, m0\n\ts_mov_b32 m0, %2\n\ts_nop 0\n\tglobal_load_lds_dwordx4 %1, off\n\ts_mov_b32 m0, %0" : "=&s"(keep) : "v"(gsrc), "s"(lds_dst) : "memory"); }
__device__ __forceinline__ s16x4 vtr(LAS unsigned char* p) { return __builtin_bit_cast(s16x4, __builtin_amdgcn_ds_read_tr16_b64_v4i16((LAS v4i16_t*)p)); }

__device__ __forceinline__ f32x16 mfma_from_c(bf16x8 a, bf16x8 b, const f32x16& c) {
    f32x16 d; asm("s_nop 1\n\tv_mfma_f32_32x32x16_bf16 %0, %1, %2, %3" : "=&v"(d) : "v"(a), "v"(b), "v"(c)); return d;
}
template <int NCOMP, int KSTEPS, bool MASK, bool FIXM>
__device__ __forceinline__ void flash_unit(LAS unsigned char* lds, const int wv, const bf16_t* qrow, const bf16_t* Kb, const bf16_t* Vb, int ntiles, int kb0, int qabs,
                                           float m0, float l0, const float* kmax, f32x16 (&o)[NCOMP][2], float (&lsum)[NCOMP]) {
    const int tid = opaque_tid(wv), lane = tid & 63, r = lane & 31, h = lane >> 5;
    bf16x8 q[NCOMP][KSTEPS];
#pragma unroll
    for (int m = 0; m < NCOMP; ++m)
#pragma unroll
        for (int s = 0; s < KSTEPS; ++s) q[m][s] = *(const bf16x8*)(qrow + m * 32 + 16 * s + 8 * h);
    float mrun[NCOMP], lrun[NCOMP];
    f32x16 negm;
    if (FIXM) {
        float bmax = 0.f;
#pragma unroll
        for (int m = 0; m < NCOMP; ++m) { float qq = 0.f;
#pragma unroll
            for (int s = 0; s < KSTEPS; ++s)
#pragma unroll
                for (int j = 0; j < 8; ++j) { const float x = bf2f((unsigned short)q[m][s][j]); qq += x * x; }
            qq = xhalf_sum(qq);
            bmax = fmaxf(bmax, __builtin_amdgcn_sqrtf(qq) * kmax[m]); }
        const float ref = fmaxf(bmax * 1.001f + 1e-3f, m0);
        l0 = l0 * fast_exp2(m0 - ref);
#pragma unroll
        for (int e = 0; e < 16; ++e) negm[e] = -ref;
    }
#pragma unroll
    for (int m = 0; m < NCOMP; ++m) { mrun[m] = m0; lrun[m] = (h == 0) ? l0 : 0.f; o[m][0] = f32x16{}; o[m][1] = f32x16{}; }
    bf16x8 onesA; f32x4 lacc[NCOMP];
    { const int g_ = lane >> 4, mr_ = lane & 15; const short v_ = ((mr_ == 0 && !(g_ & 1)) || (mr_ == 1 && (g_ & 1))) ? (short)0x3F80 : (short)0;
      onesA = (bf16x8){v_, v_, v_, v_, v_, v_, v_, v_}; }
#pragma unroll
    for (int m = 0; m < NCOMP; ++m) lacc[m] = f32x4{0.f, 0.f, 0.f, 0.f};
    const int wid_u = __builtin_amdgcn_readfirstlane(tid >> 6);
    const int srow = tid >> 3, scl = tid & 7;
    const size_t ksoff = (size_t)srow * 64 + ((scl ^ ((srow >> 1) & 7)) << 3);
    const size_t vsoff = (size_t)srow * 64 + ((scl ^ (((srow >> 1) & 1) << 2)) << 3);
    const unsigned lds0 = (unsigned)(uintptr_t)lds + (unsigned)wid_u * 1024u;
#define FA_STAGE(bufsel, krow_) do { const size_t g0_ = (size_t)(krow_) * 64; const unsigned d_ = (unsigned)__builtin_amdgcn_readfirstlane((int)(lds0 + (unsigned)(bufsel) * 16384u)); \
        glds16(Kb + g0_ + ksoff, d_); glds16(Vb + g0_ + vsoff, d_ + 8192u); } while (0)
    const int kswz = (r >> 1) & 7, kro = r * 128;
    const int q4 = (lane & 15) >> 2, p4 = lane & 3, grp = (lane >> 4) & 1;
    const int vro = 8192 + (4 * h + q4) * 128, vcol = grp * 32 + p4 * 8, vswz = ((q4 >> 1) & 1) << 6;
    FA_STAGE(0, 0);
    asm volatile("s_waitcnt vmcnt(0)" ::: "memory"); __syncthreads();
#pragma nounroll
    for (int it = 0; it < ntiles; ++it) {
        LAS unsigned char* buf = lds + (it & 1) * 16384;
        const bool more = it + 1 < ntiles;
        if (more) { const int kn = (it + 1 < 4) ? 64 * (it + 1) : kb0 + 64 * (it + 1 - 4); FA_STAGE((it + 1) & 1, kn); }
        const int ktile = (it < 4) ? 64 * it : kb0 + 64 * (it - 4);
        bf16x8 pk[NCOMP][4];
        bf16x8 ka[NCOMP][KSTEPS][2];
#pragma unroll
        for (int m = 0; m < NCOMP; ++m)
#pragma unroll
            for (int s = 0; s < KSTEPS; ++s) { const int c = m * 4 + 2 * s + h;
                ka[m][s][0] = *(LAS bf16x8*)(buf + kro + ((c ^ kswz) << 4)); ka[m][s][1] = *(LAS bf16x8*)(buf + 4096 + kro + ((c ^ kswz) << 4)); }
        f32x16 sc[NCOMP][2];
#pragma unroll
        for (int m = 0; m < NCOMP; ++m) {
            if (FIXM) { sc[m][0] = mfma_from_c(ka[m][0][0], q[m][0], negm); sc[m][1] = mfma_from_c(ka[m][0][1], q[m][0], negm); }
            else { sc[m][0] = __builtin_amdgcn_mfma_f32_32x32x16_bf16(ka[m][0][0], q[m][0], f32x16{}, 0, 0, 0); sc[m][1] = __builtin_amdgcn_mfma_f32_32x32x16_bf16(ka[m][0][1], q[m][0], f32x16{}, 0, 0, 0); }
#pragma unroll
            for (int s = 1; s < KSTEPS; ++s) {
                sc[m][0] = __builtin_amdgcn_mfma_f32_32x32x16_bf16(ka[m][s][0], q[m][s], sc[m][0], 0, 0, 0);
                sc[m][1] = __builtin_amdgcn_mfma_f32_32x32x16_bf16(ka[m][s][1], q[m][s], sc[m][1], 0, 0, 0);
            }
        }
        bf16x8 vf[2][4];
#pragma unroll
        for (int db = 0; db < 2; ++db)
#pragma unroll
            for (int ks = 0; ks < 4; ++ks) { LAS unsigned char* vp = buf + vro + ks * 2048 + ((db * 64 + vcol) ^ vswz);
                const s16x4 lo = vtr(vp), hi = vtr(vp + 1024);
                vf[db][ks] = (bf16x8){lo[0], lo[1], lo[2], lo[3], hi[0], hi[1], hi[2], hi[3]}; }
#pragma unroll
        for (int m = 0; m < NCOMP; ++m) {
            f32x16 s0 = sc[m][0], s1 = sc[m][1];
            if (MASK && it >= 4) {
                const int kt0 = ktile - CTX - qabs + 4 * h;
#pragma unroll
                for (int e = 0; e < 16; ++e) { const int d0 = kt0 + (e & 3) + 8 * (e >> 2), d1 = d0 + 32;
                    if (d0 > 128 || d0 < -128) s0[e] = -1e30f;
                    if (d1 > 128 || d1 < -128) s1[e] = -1e30f; }
            }
            if (FIXM) {
#pragma unroll
                for (int e = 0; e < 16; ++e) { s0[e] = fast_exp2(s0[e]); s1[e] = fast_exp2(s1[e]); }
            } else {
            float mx = fmaxf(s0[0], s1[0]);
#pragma unroll
            for (int e = 1; e < 16; ++e) mx = fmaxf(mx, fmaxf(s0[e], s1[e]));
            mx = xhalf_max(mx);
            const float mn = fmaxf(mrun[m], mx), alpha = fast_exp2(mrun[m] - mn); mrun[m] = mn;
            float ps = 0.f;
#pragma unroll
            for (int e = 0; e < 16; ++e) { s0[e] = fast_exp2(s0[e] - mn); s1[e] = fast_exp2(s1[e] - mn); ps += s0[e] + s1[e]; }
            lrun[m] = lrun[m] * alpha + ps;
            if (__any(alpha != 1.f)) { o[m][0] = o[m][0] * alpha; o[m][1] = o[m][1] * alpha; }
            }
            u32x4 w;
            w.x = cvtpk(s0[0], s0[1]); w.y = cvtpk(s0[2], s0[3]); w.z = cvtpk(s0[4], s0[5]); w.w = cvtpk(s0[6], s0[7]); pk[m][0] = __builtin_bit_cast(bf16x8, w);
            w.x = cvtpk(s0[8], s0[9]); w.y = cvtpk(s0[10], s0[11]); w.z = cvtpk(s0[12], s0[13]); w.w = cvtpk(s0[14], s0[15]); pk[m][1] = __builtin_bit_cast(bf16x8, w);
            w.x = cvtpk(s1[0], s1[1]); w.y = cvtpk(s1[2], s1[3]); w.z = cvtpk(s1[4], s1[5]); w.w = cvtpk(s1[6], s1[7]); pk[m][2] = __builtin_bit_cast(bf16x8, w);
            w.x = cvtpk(s1[8], s1[9]); w.y = cvtpk(s1[10], s1[11]); w.z = cvtpk(s1[12], s1[13]); w.w = cvtpk(s1[14], s1[15]); pk[m][3] = __builtin_bit_cast(bf16x8, w);
#pragma unroll
            for (int db = 0; db < 2; ++db)
#pragma unroll
                for (int ks = 0; ks < 4; ++ks) o[m][db] = __builtin_amdgcn_mfma_f32_32x32x16_bf16(vf[db][ks], pk[m][ks], o[m][db], 0, 0, 0);
            if (FIXM) {
#pragma unroll
                for (int ks = 0; ks < 4; ++ks) lacc[m] = __builtin_amdgcn_mfma_f32_16x16x32_bf16(onesA, pk[m][ks], lacc[m], 0, 0, 0);
            }
        }
        asm volatile("s_waitcnt vmcnt(0)" ::: "memory"); __syncthreads();
    }
#pragma unroll
    for (int m = 0; m < NCOMP; ++m) {
        if (FIXM) { const float a0 = __shfl(lacc[m][0], r & 15), a1 = __shfl(lacc[m][1], r & 15); lsum[m] = ((r >> 4) ? a1 : a0) + l0; }
        else lsum[m] = xhalf_sum(lrun[m]);
    }
#undef FA_STAGE
}

#define FD_SB() __builtin_amdgcn_sched_barrier(0)
template <bool GRPB>
__device__ __forceinline__ void flash_diff(LAS unsigned char* lds, const int wv, const bf16_t* qrow, const bf16_t* Kb, const bf16_t* Vb, int ntiles, int kb0, const float* kmax,
                                           f32x16 (&o)[2][2], float (&lsum)[2]) {
    const int tid = opaque_tid(wv), lane = tid & 63, r = lane & 31, h = lane >> 5;
    bf16x8 q[2][2];
#pragma unroll
    for (int m = 0; m < 2; ++m)
#pragma unroll
        for (int s = 0; s < 2; ++s) q[m][s] = *(const bf16x8*)(qrow + m * 32 + 16 * s + 8 * h);
    f32x16 negm;
    { float bmax = 0.f;
#pragma unroll
      for (int m = 0; m < 2; ++m) { float qq = 0.f;
#pragma unroll
          for (int s = 0; s < 2; ++s)
#pragma unroll
              for (int j = 0; j < 8; ++j) { const float x = bf2f((unsigned short)q[m][s][j]); qq += x * x; }
          qq = xhalf_sum(qq);
          bmax = fmaxf(bmax, __builtin_amdgcn_sqrtf(qq) * kmax[m]); }
      const float ref = bmax * 1.001f + 1e-3f;
#pragma unroll
      for (int e = 0; e < 16; ++e) negm[e] = -ref; }
    bf16x8 onesA; f32x4 lacc[2];
    { const int g_ = lane >> 4, mr_ = lane & 15; const short v_ = ((mr_ == 0 && !(g_ & 1)) || (mr_ == 1 && (g_ & 1))) ? (short)0x3F80 : (short)0;
      onesA = (bf16x8){v_, v_, v_, v_, v_, v_, v_, v_}; }
#pragma unroll
    for (int m = 0; m < 2; ++m) { lacc[m] = f32x4{0.f, 0.f, 0.f, 0.f}; o[m][0] = f32x16{}; o[m][1] = f32x16{}; }
    const int wid_u = __builtin_amdgcn_readfirstlane(tid >> 6);
    const int srow = tid >> 3, scl = tid & 7;
    const size_t ksoff = (size_t)srow * 64 + ((scl ^ ((srow >> 1) & 7)) << 3);
    const size_t vsoff = (size_t)srow * 64 + ((scl ^ (((srow >> 1) & 1) << 2)) << 3);
    const unsigned lds0 = (unsigned)(uintptr_t)lds + (unsigned)wid_u * 1024u;
#define FD_STAGE(bufsel, krow_) do { const size_t g0_ = (size_t)(krow_) * 64; const unsigned d_ = (unsigned)__builtin_amdgcn_readfirstlane((int)(lds0 + (unsigned)(bufsel) * 16384u)); \
        glds16(Kb + g0_ + ksoff, d_); glds16(Vb + g0_ + vsoff, d_ + 8192u); } while (0)
#define FD_KROW(t_) (((t_) < 4) ? 64 * (t_) : kb0 + 64 * ((t_) - 4))
#define FD_SYNC(it_) do { asm volatile("s_waitcnt vmcnt(0)" ::: "memory"); __syncthreads(); const int tn_ = ((it_) + 2 < ntiles) ? (it_) + 2 : ntiles - 1; FD_STAGE((it_) & 1, FD_KROW(tn_)); } while (0)
#define FD_EXP4(v_, e0_) do { _Pragma("unroll") for (int e_ = (e0_); e_ < (e0_) + 4; ++e_) v_[e_] = fast_exp2(v_[e_]); } while (0)
#define FD_PACK(dst_, v_, e0_) do { u32x4 w_; w_.x = cvtpk(v_[(e0_)], v_[(e0_) + 1]); w_.y = cvtpk(v_[(e0_) + 2], v_[(e0_) + 3]); w_.z = cvtpk(v_[(e0_) + 4], v_[(e0_) + 5]); w_.w = cvtpk(v_[(e0_) + 6], v_[(e0_) + 7]); \
        dst_ = __builtin_bit_cast(bf16x8, w_); } while (0)
#define FD_MFMA(a_, b_, c_) __builtin_amdgcn_mfma_f32_32x32x16_bf16(a_, b_, c_, 0, 0, 0)
#define FD_SUM(m_, b_) lacc[m_] = __builtin_amdgcn_mfma_f32_16x16x32_bf16(onesA, b_, lacc[m_], 0, 0, 0)
    const int kswz = (r >> 1) & 7, kro = r * 128;
    const int q4 = (lane & 15) >> 2, p4 = lane & 3, grp = (lane >> 4) & 1;
    const int vro = 8192 + (4 * h + q4) * 128, vcol = grp * 32 + p4 * 8, vswz = ((q4 >> 1) & 1) << 6;
    FD_STAGE(0, 0);
    asm volatile("s_waitcnt vmcnt(0)" ::: "memory"); __syncthreads();
    FD_STAGE(1, FD_KROW(1));
#pragma nounroll
    for (int it = 0; it < ntiles; ++it) {
        LAS unsigned char* buf = lds + (it & 1) * 16384;
        bf16x8 ka[2][2][2];
#pragma unroll
        for (int m = 0; m < 2; ++m)
#pragma unroll
            for (int s = 0; s < 2; ++s) { const int c = m * 4 + 2 * s + h;
                ka[m][s][0] = *(LAS bf16x8*)(buf + kro + ((c ^ kswz) << 4)); ka[m][s][1] = *(LAS bf16x8*)(buf + 4096 + kro + ((c ^ kswz) << 4)); }
        f32x16 s00 = mfma_from_c(ka[0][0][0], q[0][0], negm), s01 = mfma_from_c(ka[0][0][1], q[0][0], negm);
        s00 = FD_MFMA(ka[0][1][0], q[0][1], s00); s01 = FD_MFMA(ka[0][1][1], q[0][1], s01);
        bf16x8 vf[2][4];
#pragma unroll
        for (int db = 0; db < 2; ++db)
#pragma unroll
            for (int ks = 0; ks < 4; ++ks) { LAS unsigned char* vp = buf + vro + ks * 2048 + ((db * 64 + vcol) ^ vswz);
                const s16x4 lo = vtr(vp), hi = vtr(vp + 1024);
                vf[db][ks] = (bf16x8){lo[0], lo[1], lo[2], lo[3], hi[0], hi[1], hi[2], hi[3]}; }
        FD_SB();
        f32x16 s10 = mfma_from_c(ka[1][0][0], q[1][0], negm); FD_EXP4(s00, 0); FD_SB();
        f32x16 s11 = mfma_from_c(ka[1][0][1], q[1][0], negm); FD_EXP4(s00, 4); FD_SB();
        s10 = FD_MFMA(ka[1][1][0], q[1][1], s10); FD_EXP4(s00, 8); FD_SB();
        s11 = FD_MFMA(ka[1][1][1], q[1][1], s11); FD_EXP4(s00, 12); FD_SB();
        bf16x8 pk0[4], pk1[4];
        FD_PACK(pk0[0], s00, 0); FD_PACK(pk0[1], s00, 8);
        FD_EXP4(s01, 0); FD_EXP4(s01, 4); FD_EXP4(s01, 8); FD_EXP4(s01, 12);
        FD_PACK(pk0[2], s01, 0); FD_PACK(pk0[3], s01, 8);
        FD_SB();
        if (GRPB) { FD_SYNC(it); FD_SB(); }
        o[0][0] = FD_MFMA(vf[0][0], pk0[0], o[0][0]); FD_EXP4(s10, 0); FD_SB();
        o[0][1] = FD_MFMA(vf[1][0], pk0[0], o[0][1]); FD_EXP4(s10, 4); FD_SB();
        o[0][0] = FD_MFMA(vf[0][1], pk0[1], o[0][0]); FD_EXP4(s10, 8); FD_PACK(pk1[0], s10, 0); FD_SB();
        o[0][1] = FD_MFMA(vf[1][1], pk0[1], o[0][1]); FD_EXP4(s10, 12); FD_SUM(0, pk0[0]); FD_SB();
        o[0][0] = FD_MFMA(vf[0][2], pk0[2], o[0][0]); FD_EXP4(s11, 0); FD_PACK(pk1[1], s10, 8); FD_SB();
        o[0][1] = FD_MFMA(vf[1][2], pk0[2], o[0][1]); FD_EXP4(s11, 4); FD_SUM(0, pk0[1]); FD_SB();
        o[0][0] = FD_MFMA(vf[0][3], pk0[3], o[0][0]); FD_EXP4(s11, 8); FD_PACK(pk1[2], s11, 0); FD_SUM(0, pk0[2]); FD_SB();
        o[0][1] = FD_MFMA(vf[1][3], pk0[3], o[0][1]); FD_EXP4(s11, 12); FD_PACK(pk1[3], s11, 8); FD_SUM(0, pk0[3]); FD_SB();
#pragma unroll
        for (int ks = 0; ks < 4; ++ks) { o[1][0] = FD_MFMA(vf[0][ks], pk1[ks], o[1][0]); o[1][1] = FD_MFMA(vf[1][ks], pk1[ks], o[1][1]); FD_SUM(1, pk1[ks]); }
        FD_SB();
        if (!GRPB) FD_SYNC(it);
    }
    asm volatile("s_waitcnt vmcnt(0)" ::: "memory"); __syncthreads();
#pragma unroll
    for (int m = 0; m < 2; ++m) { const float a0 = __shfl(lacc[m][0], r & 15), a1 = __shfl(lacc[m][1], r & 15); lsum[m] = (r >> 4) ? a1 : a0; }
#undef FD_STAGE
#undef FD_KROW
#undef FD_SYNC
#undef FD_EXP4
#undef FD_PACK
#undef FD_MFMA
#undef FD_SUM
}

__device__ __forceinline__ void store_ot(bf16_t* dst, const f32x16 (&v)[2], int h) {
#pragma unroll
    for (int db = 0; db < 2; ++db)
#pragma unroll
        for (int e4 = 0; e4 < 4; ++e4) { u32x2 w; w.x = cvtpk(v[db][4 * e4], v[db][4 * e4 + 1]); w.y = cvtpk(v[db][4 * e4 + 2], v[db][4 * e4 + 3]);
            *(u32x2*)(dst + 32 * db + 8 * e4 + 4 * h) = w; }
}

struct AttnArgs { const bf16_t *QS, *KS, *VS, *QD, *KD, *VD; bf16_t* MIX; const float *sink, *dlam, *dng; float lam_init; const float* kmax; };

__device__ __forceinline__ void swa_unit(LAS unsigned char* lds, const int wv, const AttnArgs& A, int b, int hk, int jq, bool ctxq) {
    const int tid = opaque_tid(wv), lane = tid & 63, wid = tid >> 6, r = lane & 31, h = lane >> 5;
    const int head = hk * 4 + (wid >> 1), qpos = 64 * jq + 32 * (wid & 1) + r;
    const int row = ctxq ? TL + b * CTX + qpos : b * SEQ + qpos;
    const bf16_t* qrow = A.QS + (size_t)row * 512 + head * 64;
    const bf16_t* Kb = A.KS + (size_t)(b * 2 + hk) * KEYS * 64; const bf16_t* Vb = A.VS + (size_t)(b * 2 + hk) * KEYS * 64;
    int ntiles = 4, kb0 = CTX;
    if (!ctxq) { const int q0 = 64 * jq; int lo = q0 - 128; if (lo < 0) lo = 0; int hi = q0 + 64 + 128; if (hi > SEQ) hi = SEQ; kb0 = CTX + lo; ntiles = 4 + (hi - lo) / 64; }
    f32x16 o[1][2]; float ls[1];
    const float m0 = A.sink[head] * LOG2E;
    float km[1];
    km[0] = 0.f;
    if (ctxq) flash_unit<1, 4, false, false>(lds, wv, qrow, Kb, Vb, ntiles, kb0, 0, m0, 1.f, km, o, ls);
    else flash_unit<1, 4, true, false>(lds, wv, qrow, Kb, Vb, ntiles, kb0, qpos, m0, 1.f, km, o, ls);
    const float inv = 1.f / ls[0];
    o[0][0] = o[0][0] * inv; o[0][1] = o[0][1] * inv;
    store_ot(A.MIX + (size_t)row * 1024 + 256 + head * 64, o[0], h);
}

__device__ __forceinline__ void kmax_unit(LAS unsigned char* lds, const int wv, const bf16_t* KD, float* KMAXP, int b, int hd, int qt) {
    const int tid = opaque_tid(wv), lane = tid & 63, wid = tid >> 6;
    const bf16_t* Kb = KD + (size_t)(b * 4 + hd) * KEYS * 64;
    float m1 = 0.f, m2 = 0.f;
    for (int key = qt * (KEYS / 4) + tid; key < (qt + 1) * (KEYS / 4); key += 512) {
        float n1 = 0.f, n2 = 0.f;
#pragma unroll
        for (int c = 0; c < 8; ++c) { const u32x4 w = *(const u32x4*)(Kb + (size_t)key * 64 + c * 8);
            const float s = bflo(w.x) * bflo(w.x) + bfhi(w.x) * bfhi(w.x) + bflo(w.y) * bflo(w.y) + bfhi(w.y) * bfhi(w.y) + bflo(w.z) * bflo(w.z) + bfhi(w.z) * bfhi(w.z) + bflo(w.w) * bflo(w.w) + bfhi(w.w) * bfhi(w.w);
            if (c < 4) n1 += s; else n2 += s; }
        m1 = fmaxf(m1, n1); m2 = fmaxf(m2, n2);
    }
#pragma unroll
    for (int o = 1; o < 64; o <<= 1) { m1 = fmaxf(m1, __shfl_xor(m1, o)); m2 = fmaxf(m2, __shfl_xor(m2, o)); }
    LAS float* R = (LAS float*)lds;
    if (lane == 0) { R[wid * 2] = m1; R[wid * 2 + 1] = m2; }
    __syncthreads();
    if (tid < 2) { float m = 0.f;
#pragma unroll
        for (int w = 0; w < 8; ++w) m = fmaxf(m, R[w * 2 + tid]);
        st_sc1(KMAXP + ((b * 4 + hd) * 4 + qt) * 2 + tid, m); }
    __syncthreads();
}

__device__ __forceinline__ void diff_unit(LAS unsigned char* lds, const int wv, const AttnArgs& A, int b, int hd, int jq, bool ctxq, float lam) {
    const int tid = opaque_tid(wv), lane = tid & 63, wid = tid >> 6, r = lane & 31, h = lane >> 5;
    const int qpos = 256 * jq + 32 * wid + r;
    const int row = ctxq ? TL + b * CTX + qpos : b * SEQ + qpos;
    const bf16_t* qrow = A.QD + (size_t)row * 256 + hd * 64;
    const bf16_t* Kb = A.KD + (size_t)(b * 4 + hd) * KEYS * 64; const bf16_t* Vb = A.VD + (size_t)(b * 4 + hd) * KEYS * 64;
    const int ntiles = ctxq ? 4 : KEYS / 64;
    f32x16 o[2][2]; float ls[2];
    float km[2];
    { const float* kp = A.kmax + (size_t)(b * 4 + hd) * 8; km[0] = sqrtf(fmaxf(fmaxf(ld_sc1(kp + 0), ld_sc1(kp + 2)), fmaxf(ld_sc1(kp + 4), ld_sc1(kp + 6)))); km[1] = sqrtf(fmaxf(fmaxf(ld_sc1(kp + 1), ld_sc1(kp + 3)), fmaxf(ld_sc1(kp + 5), ld_sc1(kp + 7)))); }
#if DIFF_STAG
    if (__builtin_amdgcn_readfirstlane(wid) >= 4) flash_diff<true>(lds, wv, qrow, Kb, Vb, ntiles, CTX, km, o, ls);
    else flash_diff<false>(lds, wv, qrow, Kb, Vb, ntiles, CTX, km, o, ls);
#else
    flash_unit<2, 2, false, true>(lds, wv, qrow, Kb, Vb, ntiles, CTX, 0, -1e30f, 0.f, km, o, ls);
#endif
    const float i1 = 1.f / ls[0], i2 = lam / ls[1];
    f32x16 v[2]; float ss = 0.f;
#pragma unroll
    for (int db = 0; db < 2; ++db)
#pragma unroll
        for (int e = 0; e < 16; ++e) { const float x = o[0][db][e] * i1 - o[1][db][e] * i2; v[db][e] = x; ss += x * x; }
    ss = xhalf_sum(ss);
    const float rn = rsqrtf(ss * (1.f / 64.f) + LN_EPS) * (1.f - A.lam_init);
#pragma unroll
    for (int db = 0; db < 2; ++db)
#pragma unroll
        for (int e4 = 0; e4 < 4; ++e4) { const f32x4 g = *(const f32x4*)(A.dng + 32 * db + 8 * e4 + 4 * h);
#pragma unroll
            for (int j = 0; j < 4; ++j) v[db][4 * e4 + j] *= rn * g[j]; }
    store_ot(A.MIX + (size_t)row * 1024 + 768 + hd * 64, v, h);
}

struct LruArgs { const bf16_t* LRUX; const bf16_t* GATE; bf16_t* MIX; const bf16_t* GWT; const float *conv_w, *conv_b, *gate_b, *lam; float* CM; float* CARRY; float* AB; };
constexpr int LRU_AA = 0, LRU_BX = 32768, LRU_UF = 65536, LRU_UB = 81920, LRU_UBP = 272, LRU_C8 = LRU_UB + 32 * LRU_UBP, LRU_CAR = LRU_C8 + 1024, LRU_END = LRU_CAR + 1024;
static_assert(LRU_END <= RING_BYTES, "LRU LDS map");

template <int PASS>
__device__ __forceinline__ void lru_phase(LAS unsigned char* lds, const int wv, const LruArgs& A, int bx, int G, int reps) {
    const int tid = opaque_tid(wv), lane = tid & 63, wid = __builtin_amdgcn_readfirstlane(tid >> 6), r = lane & 31, h = lane >> 5;
    LAS float* AA = (LAS float*)(lds + LRU_AA); LAS float* BX = (LAS float*)(lds + LRU_BX); LAS float* UF = (LAS float*)(lds + LRU_UF);
    LAS unsigned char* UB = lds + LRU_UB; LAS unsigned char* XS = lds + LRU_AA;
    LAS float* C8 = (LAS float*)(lds + LRU_C8); LAS float* CAR = (LAS float*)(lds + LRU_CAR);
    const int chh = bx & 1, ch0 = 128 * chh;
    const int k2 = wid & 1, nb = (wid >> 1) & 1, wd = wid >> 2;
    bf16x8 gw0[4], gw1[4];
    {   const bf16_t* g0 = A.GWT + ((size_t)((wd * 2 + 0) * 4 + 2 * chh + k2) * 64 + 32 * nb + r) * 64 + 8 * h;
        const bf16_t* g1 = A.GWT + ((size_t)((wd * 2 + 1) * 4 + 2 * chh + k2) * 64 + 32 * nb + r) * 64 + 8 * h;
#pragma unroll
        for (int s = 0; s < 4; ++s) { gw0[s] = *(const bf16x8*)(g0 + 16 * s); gw1[s] = *(const bf16x8*)(g1 + 16 * s); } }
    if (tid < 256) {
        const int d = tid >> 7, ch = ch0 + (tid & 127);
        {
            const float e = fast_exp2(-LOG2E * A.lam[d * 256 + ch]);
            const float sp = e < 0.0625f ? e * (1.f + e * (-0.5f + e * (0.33333334f + e * (-0.25f + e * 0.2f)))) : 0.6931471805599453f * __builtin_amdgcn_logf(1.f + e);
            C8[tid] = -8.f * sp; }
    }
    for (int rep_ = 0; rep_ < reps; ++rep_) {
    u32x4 xr0 = {0u, 0u, 0u, 0u}, xr1 = {0u, 0u, 0u, 0u}; float cnx = 0.f;
#define LRU_FETCH(P) do { const int pb_ = (P) / LRU_NCH, pc_ = (P) % LRU_NCH; const bool ic_ = pc_ < 8; \
        const int sg_ = ic_ ? TL + pb_ * CTX : pb_ * SEQ, sl_ = ic_ ? CTX : SEQ, tt_ = ic_ ? 32 * pc_ : 32 * (pc_ - 8); \
        { const int rr = tid >> 4, c16 = tid & 15, t = tt_ - 1 + rr; xr0 = (u32x4){0u, 0u, 0u, 0u}; if (t >= 0 && t < sl_) xr0 = *(const u32x4*)(A.LRUX + (size_t)(sg_ + t) * 256 + ch0 + c16 * 8); } \
        if (tid < 48) { const int rr = (tid + 512) >> 4, c16 = tid & 15, t = tt_ - 1 + rr; xr1 = (u32x4){0u, 0u, 0u, 0u}; if (t >= 0 && t < sl_) xr1 = *(const u32x4*)(A.LRUX + (size_t)(sg_ + t) * 256 + ch0 + c16 * 8); } \
        if (PASS == 2 && tid < 256) { const int d = tid >> 7, ch = ch0 + (tid & 127); cnx = ld_sc1(A.CARRY + ((size_t)(pb_ * LRU_NCH + pc_) * 2 + d) * 256 + ch); } } while (0)
    const bool active = bx < 2 * (G >> 1);
    if (active && (bx >> 1) < NB * LRU_NCH) LRU_FETCH(bx >> 1);
    for (int p = (bx >> 1); p < NB * LRU_NCH && active; p += (G >> 1)) {
    const int b = p / LRU_NCH, ci = p % LRU_NCH;
    const bool isctx = ci < 8;
    const int seg0 = isctx ? TL + b * CTX : b * SEQ, t0 = isctx ? 32 * ci : 32 * (ci - 8);
    if (PASS == 2 && tid < 256) CAR[tid] = cnx;
    *(LAS u32x4*)(XS + (tid >> 4) * 256 + (tid & 15) * 16) = xr0;
    if (tid < 48) *(LAS u32x4*)(XS + ((tid + 512) >> 4) * 256 + (tid & 15) * 16) = xr1;
    __syncthreads();
    if (p + (G >> 1) < NB * LRU_NCH) LRU_FETCH(p + (G >> 1));
    {
        const int cl = tid & 127, tq = tid >> 7, ch = ch0 + cl;
        const float w0 = A.conv_w[ch], w1 = A.conv_w[256 + ch], w2 = A.conv_w[512 + ch], w3 = A.conv_w[768 + ch], cb = A.conv_b[ch];
        const LAS unsigned short* xs = (const LAS unsigned short*)XS + (tq * 8) * 128 + cl;
        float x0 = bf2f(xs[0]), x1 = bf2f(xs[128]), x2 = bf2f(xs[256]);
#pragma unroll
        for (int t = 0; t < 8; ++t) { const float x3 = bf2f(xs[(t + 3) * 128]); const float u = cb + w0 * x0 + w1 * x1 + w2 * x2 + w3 * x3; x0 = x1; x1 = x2; x2 = x3;
            const int tok = tq * 8 + t; UF[tok * 128 + cl] = u; *(LAS unsigned short*)(UB + tok * LRU_UBP + cl * 2) = (unsigned short)(cvtpk(u, 0.f) & 0xffffu); }
    }
    __syncthreads();
    {
        f32x16 acc0 = f32x16{}, acc1 = f32x16{};
#pragma unroll
        for (int s = 0; s < 4; ++s) {
            const bf16x8 a = *(LAS bf16x8*)(UB + r * LRU_UBP + (64 * k2 + 16 * s + 8 * h) * 2);
            acc0 = __builtin_amdgcn_mfma_f32_32x32x16_bf16(a, gw0[s], acc0, 0, 0, 0);
            acc1 = __builtin_amdgcn_mfma_f32_32x32x16_bf16(a, gw1[s], acc1, 0, 0, 0);
        }
        const int cl = 64 * k2 + 32 * nb + r, ch = ch0 + cl;
        const float ba = A.gate_b[(wd * 2 + 0) * 256 + ch], bi = A.gate_b[(wd * 2 + 1) * 256 + ch], c8 = C8[wd * 128 + cl];
        LAS float* aa = AA + wd * 4096; LAS float* bx = BX + wd * 4096;
#pragma unroll
        for (int e = 0; e < 16; ++e) { const int tok = crow(e, h);
            const float rr = sigmoid_f(acc0[e] + ba), ii = sigmoid_f(acc1[e] + bi), la = c8 * rr;
            const float av = fast_exp2(LOG2E * la), x2 = 2.f * la;
            const float ser = -x2 * (1.f + x2 * (0.5f + x2 * (0.16666667f + x2 * (0.041666668f + x2 * 0.0083333338f))));
            const float om = x2 > -0.125f ? ser : 1.f - av * av;
            const float bxv = __builtin_amdgcn_sqrtf(om) * ii * UF[tok * 128 + cl];
            aa[tok * 128 + cl] = av; bx[tok * 128 + cl] = bxv;
            if (PASS == 1) { float* ab = A.AB + ((size_t)(b * LRU_NCH + ci) * 2 + chh) * 16384 + wd * 4096 + tok * 128 + cl; ab[0] = av; ab[8192] = bxv; } }
    }
    __syncthreads();
    if (tid < 256) {
        const int d = tid >> 7, cl = tid & 127;
        LAS float* aa = AA + d * 4096 + cl; LAS float* bx = BX + d * 4096 + cl;
        if (PASS == 1) {
            float ap = 1.f, hh = 0.f;
            if (d == 0) {
#pragma unroll
                for (int t = 0; t < 32; ++t) { const float av = aa[t * 128]; hh = av * hh + bx[t * 128]; ap *= av; }
            } else {
#pragma unroll
                for (int t = 31; t >= 0; --t) { const float av = aa[t * 128]; hh = av * hh + bx[t * 128]; ap *= av; }
            }
            float* cm = A.CM + ((size_t)(b * LRU_NCH + ci) * 2 + d) * 512 + ch0 + cl; st_sc1(cm, ap); st_sc1(cm + 256, hh);
        } else {
            float hh = CAR[tid];
            float av[32], bv[32];
#pragma unroll
            for (int t = 0; t < 32; ++t) { av[t] = aa[t * 128]; bv[t] = bx[t * 128]; }
            if (d == 0) {
#pragma unroll
                for (int t = 0; t < 32; ++t) { hh = av[t] * hh + bv[t]; bv[t] = hh; }
            } else {
#pragma unroll
                for (int t = 31; t >= 0; --t) { hh = av[t] * hh + bv[t]; bv[t] = hh; }
            }
#pragma unroll
            for (int t = 0; t < 32; ++t) bx[t * 128] = bv[t];
        }
    }
    if (PASS == 2) {
        __syncthreads();
        const int t = tid >> 4, cg = tid & 15;
        const size_t row = (size_t)(seg0 + t0 + t);
        const u32x4 gv = *(const u32x4*)(A.GATE + row * 256 + ch0 + cg * 8);
        const f32x4 f0 = *(LAS f32x4*)(BX + t * 128 + cg * 8), f1 = *(LAS f32x4*)(BX + t * 128 + cg * 8 + 4);
        const f32x4 r0 = *(LAS f32x4*)(BX + 4096 + t * 128 + cg * 8), r1 = *(LAS f32x4*)(BX + 4096 + t * 128 + cg * 8 + 4);
        u32x4 w;
        w.x = cvtpk((f0[0] + r0[0]) * bflo(gv.x), (f0[1] + r0[1]) * bfhi(gv.x)); w.y = cvtpk((f0[2] + r0[2]) * bflo(gv.y), (f0[3] + r0[3]) * bfhi(gv.y));
        w.z = cvtpk((f1[0] + r1[0]) * bflo(gv.z), (f1[1] + r1[1]) * bfhi(gv.z)); w.w = cvtpk((f1[2] + r1[2]) * bflo(gv.w), (f1[3] + r1[3]) * bfhi(gv.w));
        *(u32x4*)(A.MIX + row * 1024 + ch0 + cg * 8) = w;
    }
    __syncthreads();
    }
    }
#undef LRU_FETCH
}

__device__ __forceinline__ void lru_phase2c(LAS unsigned char* lds, const int wv, const LruArgs& A, int bx, int G) {
    const int tid = opaque_tid(wv);
    LAS float* BX = (LAS float*)(lds + LRU_BX);
    const int chh = bx & 1, ch0 = 128 * chh;
    const bool active = bx < 2 * (G >> 1);
    for (int p = (bx >> 1); p < NB * LRU_NCH && active; p += (G >> 1)) {
        const int b = p / LRU_NCH, ci = p % LRU_NCH;
        const bool isctx = ci < 8;
        const int seg0 = isctx ? TL + b * CTX : b * SEQ, t0 = isctx ? 32 * ci : 32 * (ci - 8);
        if (tid < 256) {
            const int d = tid >> 7, cl = tid & 127;
            const float* ab = A.AB + ((size_t)(b * LRU_NCH + ci) * 2 + chh) * 16384 + d * 4096 + cl;
            float hh = ld_sc1(A.CARRY + ((size_t)(b * LRU_NCH + ci) * 2 + d) * 256 + ch0 + cl);
            float av[32], bv[32];
#pragma unroll
            for (int t = 0; t < 32; ++t) { av[t] = ld_sc1(ab + t * 128); bv[t] = ld_sc1(ab + 8192 + t * 128); }
            LAS float* bxl = BX + d * 4096 + cl;
            if (d == 0) {
#pragma unroll
                for (int t = 0; t < 32; ++t) { hh = av[t] * hh + bv[t]; bxl[t * 128] = hh; }
            } else {
#pragma unroll
                for (int t = 31; t >= 0; --t) { hh = av[t] * hh + bv[t]; bxl[t * 128] = hh; }
            }
        }
        __syncthreads();
        {
            const int t = tid >> 4, cg = tid & 15;
            const size_t row = (size_t)(seg0 + t0 + t);
            const u32x4 gv = *(const u32x4*)(A.GATE + row * 256 + ch0 + cg * 8);
            const f32x4 f0 = *(LAS f32x4*)(BX + t * 128 + cg * 8), f1 = *(LAS f32x4*)(BX + t * 128 + cg * 8 + 4);
            const f32x4 r0 = *(LAS f32x4*)(BX + 4096 + t * 128 + cg * 8), r1 = *(LAS f32x4*)(BX + 4096 + t * 128 + cg * 8 + 4);
            u32x4 w;
            w.x = cvtpk((f0[0] + r0[0]) * bflo(gv.x), (f0[1] + r0[1]) * bfhi(gv.x)); w.y = cvtpk((f0[2] + r0[2]) * bflo(gv.y), (f0[3] + r0[3]) * bfhi(gv.y));
            w.z = cvtpk((f1[0] + r1[0]) * bflo(gv.z), (f1[1] + r1[1]) * bfhi(gv.z)); w.w = cvtpk((f1[2] + r1[2]) * bflo(gv.w), (f1[3] + r1[3]) * bfhi(gv.w));
            *(u32x4*)(A.MIX + row * 1024 + ch0 + cg * 8) = w;
        }
        __syncthreads();
    }
}

__device__ __forceinline__ void lru_scan_unit(LAS unsigned char* lds, const int wv, const float* CMp, float* CARRY, int b, int d, int cg) {
    const int tid = opaque_tid(wv), c = tid & 31, part = tid >> 5;
    LAS float* PT = (LAS float*)lds;
    float a[9], bb[9];
#pragma unroll
    for (int j = 0; j < 9; ++j) { const int p = part * 9 + j; const int ci = d == 0 ? p : (p < 8 ? 7 - p : 143 - p);
        if (p < LRU_NCH) { const float* cm = CMp + ((size_t)(b * LRU_NCH + ci) * 2 + d) * 512 + cg * 32 + c; a[j] = ld_sc1(cm); bb[j] = ld_sc1(cm + 256); } else { a[j] = 1.f; bb[j] = 0.f; } }
    float ap = 1.f, hp = 0.f;
#pragma unroll
    for (int j = 0; j < 9; ++j) { hp = a[j] * hp + bb[j]; ap *= a[j]; }
    PT[(part * 2 + 0) * 32 + c] = ap; PT[(part * 2 + 1) * 32 + c] = hp;
    __syncthreads();
    float h = 0.f;
    for (int q = 0; q < part; ++q) h = PT[(q * 2 + 0) * 32 + c] * h + PT[(q * 2 + 1) * 32 + c];
#pragma unroll
    for (int j = 0; j < 9; ++j) { const int p = part * 9 + j; const int ci = d == 0 ? p : (p < 8 ? 7 - p : 143 - p);
        if (p < LRU_NCH) st_sc1(CARRY + ((size_t)(b * LRU_NCH + ci) * 2 + d) * 256 + cg * 32 + c, h);
        h = a[j] * h + bb[j]; }
    __syncthreads();
}

struct LnArgs {
    const float *hl, *hc; float *ol, *oc;
    const bf16_t* BR; const int* slot; const float* gts;
    const float* mod; int gate_idx;
    const float* modn; int sh_idx, sc_idx;
    const float *lng, *lnb; bf16_t* U; int nrows;
    const float *rw, *rb; int* toke; float* tokg; int* tokr; unsigned* cnt;
    int u8;
    const float* part; int nsplit;
};
constexpr int ROWS_PER_WAVE = 9;
__device__ __forceinline__ int wave_row(int gw, int ri, int nrows) { return ri < 8 ? gw * 8 + ri : ((nrows > TL && gw < TC) ? TL + gw : -1); }

template <bool MOE_BR, bool ROUTER>
__device__ __forceinline__ void ln_pass(LAS unsigned char* lds, const int wv, const LnArgs& A, int gw) {
    const int tid = opaque_tid(wv), lane = tid & 63, wid = __builtin_amdgcn_readfirstlane(tid >> 6);
    LAS float* RWT = (LAS float*)lds;
    LAS int* WC = (LAS int*)(lds + 32768);
    if (ROUTER) { for (int i = tid; i < 8192; i += 512) { const int k = i >> 3, e = i & 7; RWT[e * 1024 + k] = A.rw[i]; } __syncthreads(); }
    f32x4 g4[4], b4[4];
#pragma unroll
    for (int j = 0; j < 4; ++j) { g4[j] = *(const f32x4*)(A.lng + 4 * lane + 256 * j); b4[j] = *(const f32x4*)(A.lnb + 4 * lane + 256 * j); }
    f32x4 gt[4], sc[4], sh[4]; int curcb = -1;
    int cw0 = 0, cw1 = 0, cw2 = 0, cw3 = 0, cw4 = 0, cw5 = 0, cw6 = 0, cw7 = 0; unsigned long long packed = 0ull;
    const int rbeg = gw * ROWS_PER_WAVE;
    f32x4 nh[4]; u32x2 nb0[4], nb1[4]; float nq0 = 0.f, nq1 = 0.f;
#define LN_LOADROW(R) do { const int r_ = (R); const float* hin_ = r_ < TL ? A.hl + (size_t)r_ * 1024 : A.hc + (size_t)(r_ - TL) * 1024; \
        _Pragma("unroll") for (int j = 0; j < 4; ++j) nh[j] = *(const f32x4*)(hin_ + 4 * lane + 256 * j); \
        if (MOE_BR) { const int s0_ = A.slot[r_ * 2], s1_ = A.slot[r_ * 2 + 1]; nq0 = A.gts[r_ * 2]; nq1 = A.gts[r_ * 2 + 1]; \
            _Pragma("unroll") for (int j = 0; j < 4; ++j) { nb0[j] = *(const u32x2*)(A.BR + (size_t)s0_ * 1024 + 4 * lane + 256 * j); nb1[j] = *(const u32x2*)(A.BR + (size_t)s1_ * 1024 + 4 * lane + 256 * j); } } \
        else { _Pragma("unroll") for (int j = 0; j < 4; ++j) nb0[j] = *(const u32x2*)(A.BR + (size_t)r_ * 1024 + 4 * lane + 256 * j); } } while (0)
    if (wave_row(gw, 0, A.nrows) >= 0 && wave_row(gw, 0, A.nrows) < A.nrows) LN_LOADROW(wave_row(gw, 0, A.nrows));
    for (int ri = 0; ri < ROWS_PER_WAVE; ++ri) {
        const int row = wave_row(gw, ri, A.nrows); if (row < 0 || row >= A.nrows) break;
        const bool lat = row < TL; const int cb = lat ? (row >> 12) : 4;
        if (cb != curcb) { curcb = cb;
#pragma unroll
            for (int j = 0; j < 4; ++j) { gt[j] = *(const f32x4*)(A.mod + (size_t)(cb * 6 + A.gate_idx) * 1024 + 4 * lane + 256 * j);
                if (A.modn) { sc[j] = *(const f32x4*)(A.modn + (size_t)(cb * 6 + A.sc_idx) * 1024 + 4 * lane + 256 * j); sh[j] = *(const f32x4*)(A.modn + (size_t)(cb * 6 + A.sh_idx) * 1024 + 4 * lane + 256 * j); } } }
        float* hout = lat ? A.ol + (size_t)row * 1024 : A.oc + (size_t)(row - TL) * 1024;
        f32x4 v[4];
        if (MOE_BR) {
#pragma unroll
            for (int j = 0; j < 4; ++j) { const u32x2 w0 = nb0[j], w1 = nb1[j]; const float q0 = nq0, q1 = nq1;
                f32x4 f; f[0] = q0 * bflo(w0.x) + q1 * bflo(w1.x); f[1] = q0 * bfhi(w0.x) + q1 * bfhi(w1.x); f[2] = q0 * bflo(w0.y) + q1 * bflo(w1.y); f[3] = q0 * bfhi(w0.y) + q1 * bfhi(w1.y);
                v[j] = nh[j] * ALPHA + gt[j] * f; }
        } else if (A.part != nullptr && !lat) {
#pragma unroll
            for (int j = 0; j < 4; ++j) { f32x4 pv[11];
#pragma unroll
                for (int s = 0; s < 11; ++s) pv[s] = s < A.nsplit ? *(const f32x4*)(A.part + ((size_t)s * 1024 + (row - TL)) * 1024 + 4 * lane + 256 * j) : (f32x4){0.f, 0.f, 0.f, 0.f};
                f32x4 f = pv[0];
#pragma unroll
                for (int s = 1; s < 11; ++s) f = f + pv[s];
                v[j] = nh[j] * ALPHA + gt[j] * f; }
        } else {
#pragma unroll
            for (int j = 0; j < 4; ++j) { const u32x2 w0 = nb0[j];
                f32x4 f; f[0] = bflo(w0.x); f[1] = bfhi(w0.x); f[2] = bflo(w0.y); f[3] = bfhi(w0.y);
                v[j] = nh[j] * ALPHA + gt[j] * f; }
        }
        { const int nr_ = ri + 1 < ROWS_PER_WAVE ? wave_row(gw, ri + 1, A.nrows) : -1; if (nr_ >= 0 && nr_ < A.nrows) LN_LOADROW(nr_); }
        float s = 0.f;
#pragma unroll
        for (int j = 0; j < 4; ++j) s += (v[j][0] + v[j][1]) + (v[j][2] + v[j][3]);
        const float mean = wave_sum(s) * (1.f / 1024.f); float s2 = 0.f;
#pragma unroll
        for (int j = 0; j < 4; ++j) { v[j] = v[j] - mean; s2 += (v[j][0] * v[j][0] + v[j][1] * v[j][1]) + (v[j][2] * v[j][2] + v[j][3] * v[j][3]); }
        const float rstd = rsqrtf(wave_sum(s2) * (1.f / 1024.f) + LN_EPS);
#pragma unroll
        for (int j = 0; j < 4; ++j) { v[j] = v[j] * rstd * g4[j] + b4[j]; st16f(hout + 4 * lane + 256 * j, v[j]); }
        if (A.modn) {
#pragma unroll
            for (int j = 0; j < 4; ++j) { v[j] = v[j] * (sc[j] + 1.f) + sh[j];
                if (A.u8) *(unsigned*)((unsigned char*)A.U + (size_t)row * 1024 + 4 * lane + 256 * j) = cvt4_fp8(v[j][0] * F8_SU, v[j][1] * F8_SU, v[j][2] * F8_SU, v[j][3] * F8_SU);
                else { u32x2 w; w.x = cvtpk(v[j][0], v[j][1]); w.y = cvtpk(v[j][2], v[j][3]); *(u32x2*)(A.U + (size_t)row * 1024 + 4 * lane + 256 * j) = w; } }
        }
        if (ROUTER) {
            float lg[8];
#pragma unroll
            for (int e = 0; e < 8; ++e) { float p = 0.f;
#pragma unroll
                for (int j = 0; j < 4; ++j) { const f32x4 w = *(LAS f32x4*)(RWT + e * 1024 + 4 * lane + 256 * j); p += (v[j][0] * w[0] + v[j][1] * w[1]) + (v[j][2] * w[2] + v[j][3] * w[3]); }
                lg[e] = wave_sum(p) + A.rb[e]; }
            float v1 = lg[0]; int i1 = 0;
#pragma unroll
            for (int e = 1; e < 8; ++e) if (lg[e] > v1) { v1 = lg[e]; i1 = e; }
            float v2 = -3.0e38f; int i2 = 0;
#pragma unroll
            for (int e = 0; e < 8; ++e) if (e != i1 && lg[e] > v2) { v2 = lg[e]; i2 = e; }
            const float q1 = fast_rcp(1.f + fast_exp2(LOG2E * (v2 - v1))), q2 = 1.f - q1;
            if (lane == 0) { A.toke[row * 2] = i1; A.toke[row * 2 + 1] = i2; A.tokg[row * 2] = q1; A.tokg[row * 2 + 1] = q2; }
            i1 = __builtin_amdgcn_readfirstlane(i1); i2 = __builtin_amdgcn_readfirstlane(i2);
            cw0 += (i1 == 0) + (i2 == 0); cw1 += (i1 == 1) + (i2 == 1); cw2 += (i1 == 2) + (i2 == 2); cw3 += (i1 == 3) + (i2 == 3);
            cw4 += (i1 == 4) + (i2 == 4); cw5 += (i1 == 5) + (i2 == 5); cw6 += (i1 == 6) + (i2 == 6); cw7 += (i1 == 7) + (i2 == 7);
            packed |= (unsigned long long)(i1 | (i2 << 3)) << (6 * ri);
        }
    }
    if (ROUTER) {
        if (lane < 8) { const int c = lane == 0 ? cw0 : lane == 1 ? cw1 : lane == 2 ? cw2 : lane == 3 ? cw3 : lane == 4 ? cw4 : lane == 5 ? cw5 : lane == 6 ? cw6 : cw7; WC[wid * 8 + lane] = c; }
        __syncthreads();
        if (tid < 8) { int tot = 0;
#pragma unroll
            for (int w = 0; w < 8; ++w) tot += WC[w * 8 + tid];
            WC[64 + tid] = tot ? (int)atomicAdd(A.cnt + tid, (unsigned)tot) : 0; }
        __syncthreads();
        int off[8];
#pragma unroll
        for (int e = 0; e < 8; ++e) { int o = WC[64 + e];
#pragma unroll
            for (int w = 0; w < 8; ++w) o += (w < wid) ? WC[w * 8 + e] : 0;
            off[e] = __builtin_amdgcn_readfirstlane(o); }
        for (int ri = 0; ri < ROWS_PER_WAVE; ++ri) {
            const int row = wave_row(gw, ri, A.nrows); if (row < 0 || row >= A.nrows) break;
            const int pr = (int)((packed >> (6 * ri)) & 63ull), i1 = pr & 7, i2 = pr >> 3; int r1 = 0, r2 = 0;
#pragma unroll
            for (int e = 0; e < 8; ++e) { if (i1 == e) { r1 = off[e]; off[e] += 1; } }
#pragma unroll
            for (int e = 0; e < 8; ++e) { if (i2 == e) { r2 = off[e]; off[e] += 1; } }
            if (lane == 0) { A.tokr[row * 2] = r1; A.tokr[row * 2 + 1] = r2; }
        }
    }
}

struct ExpTab { int ts[9]; };
__device__ __forceinline__ void exp_table(const unsigned* cnt, int (&ts)[9]) {
    int acc = 0;
#pragma unroll
    for (int e = 0; e < 8; ++e) { ts[e] = acc; const int c = __builtin_amdgcn_readfirstlane((int)__hip_atomic_load(cnt + e, __ATOMIC_RELAXED, __HIP_MEMORY_SCOPE_AGENT)); acc += (c + 255) >> 8; }
    ts[8] = acc;
}
__device__ __forceinline__ void route_gather(const int wv, const unsigned* cnt, const int* toke, const int* tokr, int* toks, const bf16_t* U, bf16_t* YB, int nrows, int gw) {
    const int lane = opaque_tid(wv) & 63;
    int ts[9]; exp_table(cnt, ts);
    const int rbeg = gw * ROWS_PER_WAVE;
#pragma unroll 3
    for (int ri = 0; ri < ROWS_PER_WAVE; ++ri) {
        const int row = wave_row(gw, ri, nrows); if (row < 0 || row >= nrows) break;
        const int e0 = toke[row * 2], e1 = toke[row * 2 + 1]; int b0 = 0, b1 = 0;
#pragma unroll
        for (int e = 0; e < 8; ++e) { if (e0 == e) b0 = ts[e]; if (e1 == e) b1 = ts[e]; }
        const int s0 = b0 * 256 + tokr[row * 2], s1 = b1 * 256 + tokr[row * 2 + 1];
        if (lane == 0) { toks[row * 2] = s0; toks[row * 2 + 1] = s1; }
        const u32x4 a = *(const u32x4*)(U + (size_t)row * 1024 + lane * 8), c = *(const u32x4*)(U + (size_t)row * 1024 + 512 + lane * 8);
        u32x2 a8, c8;
        a8.x = cvt4_fp8(bflo(a.x) * F8_SU, bfhi(a.x) * F8_SU, bflo(a.y) * F8_SU, bfhi(a.y) * F8_SU); a8.y = cvt4_fp8(bflo(a.z) * F8_SU, bfhi(a.z) * F8_SU, bflo(a.w) * F8_SU, bfhi(a.w) * F8_SU);
        c8.x = cvt4_fp8(bflo(c.x) * F8_SU, bfhi(c.x) * F8_SU, bflo(c.y) * F8_SU, bfhi(c.y) * F8_SU); c8.y = cvt4_fp8(bflo(c.z) * F8_SU, bfhi(c.z) * F8_SU, bflo(c.w) * F8_SU, bfhi(c.w) * F8_SU);
        unsigned char* Y8 = (unsigned char*)YB;
        *(u32x2*)(Y8 + (size_t)s0 * 1024 + lane * 8) = a8; *(u32x2*)(Y8 + (size_t)s0 * 1024 + 512 + lane * 8) = c8;
        *(u32x2*)(Y8 + (size_t)s1 * 1024 + lane * 8) = a8; *(u32x2*)(Y8 + (size_t)s1 * 1024 + 512 + lane * 8) = c8;
    }
}

__device__ __forceinline__ int rowmap(int kind, int n) {
    if (kind == 0) return n;
    if (kind == 2) return ((n >> 7) << 8) + (n & 127);
    if (kind == 3) return ((n >> 7) << 8) + 128 + (n & 127);
    if (n < 512) return n;
    if (n < 1152) { const int d = n & 63; return (n & ~63) + (d < 32 ? 2 * d : 2 * (d - 32) + 1); }
    if (n < 1280) return n;
    if (n < 1792) { const int d = n & 31; return (n & ~31) + (d < 16 ? 2 * d : 2 * (d - 16) + 1); }
    return n;
}
__device__ __forceinline__ void transpose_item(const float* W, int K, int N, bf16_t* WT, int kind, LAS float* scr, int item, int lane, float f8s = 0.f) {
    const int nblk = N / 32, kb = item / nblk, nb = item % nblk, k0 = 64 * kb, n0 = 32 * nb;
#pragma unroll 8
    for (int i = 0; i < 32; ++i) { const int kk = 2 * i + (lane >> 5); scr[kk * 33 + (lane & 31)] = W[(size_t)(k0 + kk) * N + n0 + (lane & 31)]; }
    asm volatile("s_waitcnt lgkmcnt(0)" ::: "memory");
    const int c = lane & 7;
#pragma unroll
    for (int j = 0; j < 4; ++j) { const int n = (lane >> 3) + 8 * j; const LAS float* s = scr + (8 * c) * 33 + n;
        if (f8s != 0.f) { u32x2 o; o.x = cvt4_fp8(s[0 * 33] * f8s, s[1 * 33] * f8s, s[2 * 33] * f8s, s[3 * 33] * f8s); o.y = cvt4_fp8(s[4 * 33] * f8s, s[5 * 33] * f8s, s[6 * 33] * f8s, s[7 * 33] * f8s);
            *(u32x2*)((unsigned char*)WT + (size_t)rowmap(kind, n0 + n) * K + k0 + 8 * c) = o; }
        else {
        u32x4 o; o.x = cvtpk(s[0 * 33], s[1 * 33]); o.y = cvtpk(s[2 * 33], s[3 * 33]); o.z = cvtpk(s[4 * 33], s[5 * 33]); o.w = cvtpk(s[6 * 33], s[7 * 33]);
        *(u32x4*)(WT + (size_t)rowmap(kind, n0 + n) * K + k0 + 8 * c) = o; } }
    asm volatile("s_waitcnt lgkmcnt(0)" ::: "memory");
}

#ifndef PHMASK
#define PHMASK 0xFFFFF
#endif
#define PHON(n) (((PHMASK) >> (n)) & 1)
#ifndef REP_G
#define REP_G 1
#endif
#ifndef REP_DIFF
#define REP_DIFF 1
#endif
#ifndef REP_SWA
#define REP_SWA 1
#endif
#ifndef REP_LRU
#define REP_LRU 1
#endif
#ifndef REP_P0
#define REP_P0 1
#endif
#ifndef REP_G1
#define REP_G1 REP_G
#endif
#ifndef REP_G2
#define REP_G2 REP_G
#endif
#ifndef REP_G3
#define REP_G3 REP_G
#endif
#ifndef REP_G4
#define REP_G4 REP_G
#endif
#ifndef G3_ALIGN
#define G3_ALIGN true
#endif
#ifndef REP_MISC
#define REP_MISC 1
#endif
#ifndef REP_N1L0
#define REP_N1L0 1
#endif
struct Args { const float* in[26]; float* out; unsigned char* ws; int ph_lo, ph_hi; };
constexpr int PH_P0 = 0, PH_P0B = 1, PH_LAYER0 = 2, PH_PER_LAYER = 8, N_PHASES = PH_LAYER0 + DEPTH * PH_PER_LAYER;
enum { LP_G1 = 0, LP_AT, LP_G2, LP_N1, LP_R1, LP_G3, LP_G4, LP_N2 };
enum { I_X = 0, I_C, I_CTX, I_CCTX, I_ADAW, I_ADAB, I_WIN, I_WOUT, I_CONVW, I_CONVB, I_GATEW, I_GATEB, I_LAM, I_SINK, I_DLAM, I_DNG, I_LNG, I_LNB, I_F1, I_F3, I_F2, I_RW, I_RB, I_M1, I_M3, I_M2 };

#define MOD ((float*)(wsp + WS_MOD))
#define COS64 ((float*)(wsp + WS_COS64))
#define SIN64 ((float*)(wsp + WS_SIN64))
#define COS32 ((float*)(wsp + WS_COS32))
#define SIN32 ((float*)(wsp + WS_SIN32))
#define GWT ((bf16_t*)(wsp + WS_GWT))
#define CM ((float*)(wsp + WS_CM))
#define CARRY ((float*)(wsp + WS_CARRY))
#define LRUAB ((float*)(wsp + WS_AB))
#define KMAX ((float*)(wsp + WS_KMAX))
#define TOKE ((int*)(wsp + WS_TOKE))
#define TOKG ((float*)(wsp + WS_TOKG))
#define TOKR ((int*)(wsp + WS_TOKR))
#define TOKS ((int*)(wsp + WS_TOKS))
#define WIN ((bf16_t*)(wsp + WS_WIN))
#define WOUT ((bf16_t*)(wsp + WS_WOUT))
#define F13 ((bf16_t*)(wsp + WS_F13))
#define F2 ((bf16_t*)(wsp + WS_F2))
#define M13 ((bf16_t*)(wsp + WS_M13))
#define M2 ((bf16_t*)(wsp + WS_M2))
#define H ((float*)(wsp + WS_H))
#define U ((bf16_t*)(wsp + WS_U))
#define LRUX ((bf16_t*)(wsp + WS_LRUX))
#define GATE ((bf16_t*)(wsp + WS_GATE))
#define QS ((bf16_t*)(wsp + WS_QS))
#define KS ((bf16_t*)(wsp + WS_KS))
#define VS ((bf16_t*)(wsp + WS_VS))
#define QD ((bf16_t*)(wsp + WS_QD))
#define KD ((bf16_t*)(wsp + WS_KD))
#define VD ((bf16_t*)(wsp + WS_VD))
#define MIX ((bf16_t*)(wsp + WS_MIX))
#define MB ((bf16_t*)(wsp + WS_MB))
#define YB ((bf16_t*)(wsp + WS_YB))
#define HID ((bf16_t*)(wsp + WS_HID))
#define PART2 ((float*)(wsp + WS_PART2))
#define PART4 ((float*)(wsp + WS_PART4))
#define CTLW ((unsigned*)(wsp + WS_CTL))
#define LAUNDER_WS() unsigned char* wsp = ws; asm volatile("" : "+s"(wsp))
#define IN(k) (lo <= (k) && (k) < hi)
#ifndef REP_BAR
#define REP_BAR 1
#endif
#define SEAM(k) do { if (IN(k) && IN((k) + 1)) for (int rb_ = 0; rb_ < REP_BAR; ++rb_) xcd_barrier(bar); } while (0)
template <int layer>
__device__ __forceinline__ void layer_body(LAS unsigned char* lds, const int wv, const Args& args, unsigned char* ws, const int G, const int bx, const int gw, const int lo, const int hi, const XcdBarrier& bar) {
        const int pb = PH_LAYER0 + layer * PH_PER_LAYER;
        if (hi <= pb || lo >= pb + PH_PER_LAYER) return;
        const bool last = layer == DEPTH - 1, moe = (layer & 1) != 0; const int j2 = layer >> 1;
        const int nrows = last ? TL : T, nMt = nrows / 256;
#define modl (MOD + (size_t)layer * 5 * 6144)
#define cnt (CTLW + CW_CNT + j2 * 64)
#define hl_in (layer == 0 ? args.in[I_X] : H)
#define hc_in (layer == 0 ? args.in[I_CTX] : H + (size_t)TL * 1024)

        if (PHON(2) && IN(pb + LP_G1)) { LAUNDER_WS();
            pg8::Gemm g{U, WIN + (size_t)layer * INC * 1024, 1024}; int tsd[9] = {0, 0x7fffffff, 0x7fffffff, 0x7fffffff, 0x7fffffff, 0x7fffffff, 0x7fffffff, 0x7fffffff, 0}; pg8::TileSched S; S.build(lds, wv, T / 256, INC / 256, G, bx, INC / 256, tsd, 16, 0, 1, 0, true);
            pg8::EpiIn E{LRUX, GATE, QS, KS, VS, QD, KD, VD, COS64, SIN64, COS32, SIN32};
            for (int rep_ = 0; rep_ < REP_G1; ++rep_) { pg8::gemm_phase<pg8::EpiIn, pg8::TileSched, true, true>(lds, wv, g, S, E);
                const pg8::TileSched SH = S.listB(); pg8::gemm_phase<pg8::EpiIn, pg8::TileSched, true, true, true>(lds, wv, g, SH, E); }
        }
        SEAM(pb + LP_G1);
#define LRU_ARGS LruArgs LA{LRUX, GATE, MIX, GWT + (size_t)layer * 16 * 4096, args.in[I_CONVW] + layer * 1024, args.in[I_CONVB] + layer * 256, args.in[I_GATEB] + layer * 1024, args.in[I_LAM] + layer * 512, CM, CARRY, LRUAB}
        if (IN(pb + LP_AT)) { LAUNDER_WS(); LRU_ARGS;
            unsigned* ho = CTLW + CW_HO + layer * 3 * 64;
            { bool did = false; for (int u = G - 1 - bx; u < 64; u += G) { kmax_unit(lds, wv, KD, KMAX, u >> 4, (u >> 2) & 3, u & 3); did = true; }
              if (did) ho_signal(ho + 0, wv); }
            if (PHON(3)) lru_phase<1>(lds, wv, LA, bx, G, REP_LRU);
            ho_signal(ho + 64, wv);
            const float lam_init = layer == 0 ? 0.2f : layer == 1 ? 0.35550906759096926f : layer == 2 ? 0.47071301834358416f : 0.5560582041556405f;
            AttnArgs AA{QS, KS, VS, QD, KD, VD, MIX, args.in[I_SINK] + layer * 8, args.in[I_DLAM] + layer * 128, args.in[I_DNG] + layer * 64, lam_init, KMAX};
            float lam;
            { const int ln = opaque_tid(wv) & 63; const float* dl = AA.dlam; float p = 0.f, q = 0.f; if (ln < 32) { p = dl[ln] * dl[32 + ln]; q = dl[64 + ln] * dl[96 + ln]; }
              p = wave_sum(p); q = wave_sum(q); lam = __uint_as_float(__builtin_amdgcn_readfirstlane(__float_as_uint(fast_exp2(LOG2E * p) - fast_exp2(LOG2E * q) + lam_init))); }
            ho_wait(ho + 0, (unsigned)(G >= 64 ? 64 : G), wv);
            if (PHON(5)) for (int rep_ = 0; rep_ < REP_DIFF; ++rep_) for (int u = bx; u < 256; u += G) { const int x8 = u & 7, idx = u >> 3, bh = 2 * x8 + (idx >> 4), jq = idx & 15; diff_unit(lds, wv, AA, bh >> 2, bh & 3, jq, false, lam); }
            { bool did = false; for (int u = bx; u < NB * 2 * 8; u += G) { if (!did) ho_wait(ho + 64, (unsigned)G, wv); lru_scan_unit(lds, wv, CM, CARRY, u >> 4, (u >> 3) & 1, u & 7); did = true; }
              if (did) ho_signal(ho + 128, wv); }
            if (PHON(6)) for (int rep_ = 0; rep_ < REP_SWA; ++rep_) for (int u = bx; u < 512; u += G) { const int bhk = u & 7, jq = u >> 3; swa_unit(lds, wv, AA, bhk >> 1, bhk & 1, jq, false); }
            if (!last) {
                if (PHON(6)) for (int u = G - 1 - bx; u < 32; u += G) { const int bhk = u & 7, jq = u >> 3; swa_unit(lds, wv, AA, bhk >> 1, bhk & 1, jq, true); }
                if (PHON(5)) for (int u = G - 33 - bx; u < 16; u += G) { if (u >= 0) diff_unit(lds, wv, AA, u >> 2, u & 3, 0, true, lam); }
            }
            ho_wait(ho + 128, 64u, wv);
            if (PHON(4)) lru_phase2c(lds, wv, LA, bx, G);
        }
        SEAM(pb + LP_AT);
        if (PHON(7) && IN(pb + LP_G2)) { LAUNDER_WS();
            pg8::Gemm g{MIX, WOUT + (size_t)layer * 1024 * 1024, 1024}; int tsd[9] = {0, 0x7fffffff, 0x7fffffff, 0x7fffffff, 0x7fffffff, 0x7fffffff, 0x7fffffff, 0x7fffffff, 0}; pg8::TileSched S; S.build(lds, wv, TL / 256, 4, G, bx, 4, tsd, 16, nMt - TL / 256, 8, 2);
            pg8::EpiPlain E{MB, 1024, PART2, TL, 1.f};
            for (int rep_ = 0; rep_ < REP_G2; ++rep_) pg8::gemm_phase<pg8::EpiPlain, pg8::TileSched, true, true>(lds, wv, g, S, E);
        }
        SEAM(pb + LP_G2);
        if (PHON(8) && IN(pb + LP_N1)) { LAUNDER_WS();
            LnArgs N{hl_in, hc_in, H, H + (size_t)TL * 1024, MB, nullptr, nullptr, modl, 2, modl, 3, 4,
                     args.in[I_LNG] + (layer * 2 + 0) * 1024, args.in[I_LNB] + (layer * 2 + 0) * 1024, U, nrows,
                     args.in[I_RW] + (size_t)j2 * 8192, args.in[I_RB] + j2 * 8, TOKE, TOKG, TOKR, cnt, moe ? 0 : 1, PART2, 8};
            if (moe) ln_pass<false, true>(lds, wv, N, gw); else for (int rep_ = 0; rep_ < (layer == 0 ? REP_N1L0 : 1); ++rep_) ln_pass<false, false>(lds, wv, N, gw);
        }
        SEAM(pb + LP_N1);
        if (PHON(9) && IN(pb + LP_R1)) { LAUNDER_WS(); if (moe) for (int rep_ = 0; rep_ < REP_MISC; ++rep_) route_gather(wv, cnt, TOKE, TOKR, TOKS, U, YB, nrows, gw); }
        if (moe) SEAM(pb + LP_R1);
#define MAKE_TS() int ts[9]; if (moe) exp_table(cnt, ts); else { ts[0] = 0; _Pragma("unroll") for (int e = 1; e < 9; ++e) ts[e] = 0x7fffffff; ts[8] = nMt; } const int nT = ts[8]
        if (PHON(10) && IN(pb + LP_G3)) { LAUNDER_WS(); MAKE_TS();
            pg8::TileSched S;
            if (moe) {
                pg8::Gemm g{(const unsigned char*)YB, (const unsigned char*)M13 + (size_t)j2 * 8 * 2 * FF * 1024, 1024}; S.build(lds, wv, nT, 22, G, bx, 22, ts, 8);
                pg8::EpiSwiGLU8 E{(unsigned char*)HID, FF};
                for (int rep_ = 0; rep_ < REP_G3; ++rep_) pg8::gemm_phase<pg8::EpiSwiGLU8, pg8::TileSched, G3_ALIGN, true, false, true>(lds, wv, g, S, E);
            }
            else {
                pg8::Gemm g{(const unsigned char*)U, (const unsigned char*)F13 + (size_t)j2 * 2 * FF * 1024, 1024}; S.build(lds, wv, nT, 22, G, bx, 22, ts, 8);
                pg8::EpiSwiGLU8 E{(unsigned char*)HID, FF};
                for (int rep_ = 0; rep_ < REP_G3; ++rep_) pg8::gemm_phase<pg8::EpiSwiGLU8, pg8::TileSched, G3_ALIGN, true, false, true>(lds, wv, g, S, E);
            }
        }
        SEAM(pb + LP_G3);
        if (PHON(11) && IN(pb + LP_G4)) { LAUNDER_WS(); MAKE_TS();
            pg8::TileSched S;
            if (moe) {
                pg8::Gemm g{(const unsigned char*)HID, (const unsigned char*)M2 + (size_t)j2 * 8 * 1024 * FF, FF}; S.build(lds, wv, nT, 4, G, bx, 4, ts, 22, 0, 1, 0, true);
                pg8::EpiPlain E{YB, 1024, PART4, TL, 1.f / (F8_SH * F8_SW2)};
                for (int rep_ = 0; rep_ < REP_G4; ++rep_) { pg8::gemm_phase<pg8::EpiPlain, pg8::TileSched, true, true, false, true>(lds, wv, g, S, E);
                    const pg8::TileSched SH = S.listB(); pg8::gemm_phase<pg8::EpiPlain, pg8::TileSched, true, true, true, true>(lds, wv, g, SH, E); }
            } else {
                pg8::Gemm g{(const unsigned char*)HID, (const unsigned char*)F2 + (size_t)j2 * 1024 * FF, FF}; S.build(lds, wv, TL / 256, 4, G, bx, 4, ts, 22, nT - TL / 256, 11, 2);
                pg8::EpiPlain E{YB, 1024, PART4, TL, 1.f / (F8_SH * F8_SW2)};
                for (int rep_ = 0; rep_ < REP_G4; ++rep_) pg8::gemm_phase<pg8::EpiPlain, pg8::TileSched, true, true, false, true>(lds, wv, g, S, E);
            }
        }
        SEAM(pb + LP_G4);
        if (PHON(12) && IN(pb + LP_N2)) { LAUNDER_WS();
            const float* modn = last ? nullptr : MOD + (size_t)(layer + 1) * 5 * 6144;
            LnArgs N{H, H + (size_t)TL * 1024, last ? args.out : H, H + (size_t)TL * 1024, YB, TOKS, TOKG, modl, 5, modn, 0, 1,
                     args.in[I_LNG] + (layer * 2 + 1) * 1024, args.in[I_LNB] + (layer * 2 + 1) * 1024, U, nrows,
                     nullptr, nullptr, nullptr, nullptr, nullptr, nullptr, 0, moe ? nullptr : PART4, 11};
            if (moe) ln_pass<true, false>(lds, wv, N, gw); else ln_pass<false, false>(lds, wv, N, gw);
        }
        SEAM(pb + LP_N2);
}

__global__ void __launch_bounds__(512, 2) hymba_fwd(Args args) {
    extern __shared__ __attribute__((aligned(16))) unsigned char lds_raw[];
    LAS unsigned char* lds = (LAS unsigned char*)lds_raw;
    volatile LAS unsigned* MISC = (volatile LAS unsigned*)(lds + MISC_OFF);
    const int wv = __builtin_amdgcn_readfirstlane((int)(threadIdx.x >> 6));
    const int wid = wv, tid = opaque_tid(wv), lane = tid & 63;
    const int G = gridDim.x, bx = blockIdx.x;
    const int gw = bx * 8 + wid, NGW = G * 8;
    unsigned char* ws = args.ws;
    unsigned* ctl = (unsigned*)(ws + WS_CTL);
    for (int u = tid; u < (LDS_BYTES - LDSCTL_OFF) / 4; u += 512) ((LAS unsigned*)(lds + LDSCTL_OFF))[u] = 0u;
    __syncthreads();
    const int lo = args.ph_lo, hi = args.ph_hi;
    XcdBarrier bar; bar.bar = ctl + CW_BAR; bar.x = 0; bar.st = nullptr; bar.wv = wv;
    if (hi - lo > 1) bar = xcd_barrier_post(ctl + CW_BAR, MISC + 8, wv);

    unsigned char* wsp = ws;

    if (PHON(0) && IN(PH_P0)) for (int rep_ = 0; rep_ < REP_P0; ++rep_) {
        if (rep_) __syncthreads();
        {
            LAS float* SC = (LAS float*)lds;
            LAS float* RED = (LAS float*)(lds + 20480);
            for (int i = tid; i < 5 * 1024; i += 512) { const int cb = i >> 10, k = i & 1023; const float x = cb < 4 ? args.in[I_C][cb * 1024 + k] : args.in[I_CCTX][k]; SC[i] = x / (1.f + expf(-x)); }
            __syncthreads();
            for (int it = bx; it < DEPTH * 48; it += G) {
                const int layer = it / 48, cg = it % 48;
                const float* w = args.in[I_ADAW] + (size_t)layer * 1024 * 6144 + cg * 128 + 2 * lane;
                float a[5][2];
#pragma unroll
                for (int cb = 0; cb < 5; ++cb) { a[cb][0] = 0.f; a[cb][1] = 0.f; }
#pragma unroll 8
                for (int kk = 0; kk < 128; ++kk) { const int k = wid * 128 + kk; const f32x2 wv = *(const f32x2*)(w + (size_t)k * 6144);
#pragma unroll
                    for (int cb = 0; cb < 5; ++cb) { const float s = SC[cb * 1024 + k]; a[cb][0] += s * wv[0]; a[cb][1] += s * wv[1]; } }
#pragma unroll
                for (int cb = 0; cb < 5; ++cb) { RED[(wid * 5 + cb) * 128 + 2 * lane] = a[cb][0]; RED[(wid * 5 + cb) * 128 + 2 * lane + 1] = a[cb][1]; }
                __syncthreads();
                for (int i = tid; i < 5 * 128; i += 512) { const int cb = i >> 7, c = i & 127; float s = 0.f;
#pragma unroll
                    for (int w8 = 0; w8 < 8; ++w8) s += RED[(w8 * 5 + cb) * 128 + c];
                    st_sc1(MOD + ((size_t)layer * 5 + cb) * 6144 + cg * 128 + c, s + args.in[I_ADAB][layer * 6144 + cg * 128 + c]); }
                __syncthreads();
            }
            ho_signal(ctl + CW_HOP, wv);
        }
        {
            for (int i = bx * 512 + tid; i < 4096 * 32; i += G * 512) { const int s = i >> 5, j = i & 31; const float inv = powf(10000.f, -(float)(j & 15) / 16.f);
                const float ang = (j < 16 ? (float)(s >> 6) : (float)(s & 63)) * inv; COS64[i] = cosf(ang); SIN64[i] = sinf(ang); }
            for (int i = bx * 512 + tid; i < 4096 * 16; i += G * 512) { const int s = i >> 4, j = i & 15; const float inv = powf(10000.f, -(float)(j & 7) / 8.f);
                const float ang = (j < 8 ? (float)(s >> 6) : (float)(s & 63)) * inv; COS32[i] = cosf(ang); SIN32[i] = sinf(ang); }
        }
        {
            LAS float* scr = (LAS float*)(lds + wid * 16384);
            constexpr int I_WINI = 16 * 64, I_WOUTI = 16 * 32, I_FF = 16 * 88  , I_GW = 2;
            constexpr int N0 = DEPTH * I_WINI, N1 = N0 + DEPTH * I_WOUTI, N2 = N1 + 54 * I_FF, N3 = N2 + 64 * I_GW;
            for (int it = gw; it < N3; it += NGW) {
                if (it < N0) { const int l = it / I_WINI; transpose_item(args.in[I_WIN] + (size_t)l * 1024 * INC, 1024, INC, WIN + (size_t)l * INC * 1024, 1, scr, it % I_WINI, lane); }
                else if (it < N1) { const int r = it - N0, l = r / I_WOUTI; transpose_item(args.in[I_WOUT] + (size_t)l * 1024 * 1024, 1024, 1024, WOUT + (size_t)l * 1024 * 1024, 0, scr, r % I_WOUTI, lane); }
                else if (it < N2) { const int r = it - N1, mi = r / I_FF, item = r % I_FF;
                    const int grp = mi / 3, which = mi % 3;
                    const float* src; bf16_t* dst;
                    if (grp < 2) { src = args.in[which == 0 ? I_F1 : which == 1 ? I_F3 : I_F2] + (size_t)grp * 1024 * FF; dst = which == 2 ? F2 + (size_t)grp * 1024 * FF : F13 + (size_t)grp * 2 * FF * 1024; }
                    else { const int je = grp - 2; src = args.in[which == 0 ? I_M1 : which == 1 ? I_M3 : I_M2] + (size_t)je * 1024 * FF; dst = which == 2 ? M2 + (size_t)je * 1024 * FF : M13 + (size_t)je * 2 * FF * 1024; }
                    const float f8s = which == 2 ? F8_SW2 : F8_SW13;
                    if (grp >= 2) { const int je = grp - 2; dst = (bf16_t*)((unsigned char*)(which == 2 ? M2 : M13) + (size_t)je * (which == 2 ? 1 : 2) * FF * 1024); }
                    else dst = (bf16_t*)((unsigned char*)(which == 2 ? F2 : F13) + (size_t)grp * (which == 2 ? 1 : 2) * FF * 1024);
                    if (which == 2) transpose_item(src, FF, 1024, dst, 0, scr, item, lane, f8s);
                    else transpose_item(src, 1024, FF, dst, which == 0 ? 2 : 3, scr, item, lane, f8s); }
                else { const int r = it - N2, mi = r / I_GW; transpose_item(args.in[I_GATEW] + (size_t)mi * 4096, 64, 64, GWT + (size_t)mi * 4096, 0, scr, r % I_GW, lane); }
            }
        }
        {
            ho_wait(ctl + CW_HOP, (unsigned)G, wv);
        int curcb = -1; f32x4 sc[4], sh[4];
        for (int ri = 0; ri < ROWS_PER_WAVE; ++ri) {
            const int row = wave_row(gw, ri, T); if (row < 0) break;
            const bool lat = row < TL; const int cb = lat ? (row >> 12) : 4;
            if (cb != curcb) { curcb = cb;
#pragma unroll
                for (int j = 0; j < 4; ++j) { const float* ps = MOD + (size_t)(cb * 6 + 0) * 1024 + 4 * lane + 256 * j; const float* pc = MOD + (size_t)(cb * 6 + 1) * 1024 + 4 * lane + 256 * j;
                    sh[j] = (f32x4){ld_sc1(ps), ld_sc1(ps + 1), ld_sc1(ps + 2), ld_sc1(ps + 3)}; sc[j] = (f32x4){ld_sc1(pc), ld_sc1(pc + 1), ld_sc1(pc + 2), ld_sc1(pc + 3)}; } }
            const float* hin = lat ? args.in[I_X] + (size_t)row * 1024 : args.in[I_CTX] + (size_t)(row - TL) * 1024;
#pragma unroll
            for (int j = 0; j < 4; ++j) { f32x4 v = *(const f32x4*)(hin + 4 * lane + 256 * j); v = v * (sc[j] + 1.f) + sh[j];
                u32x2 w; w.x = cvtpk(v[0], v[1]); w.y = cvtpk(v[2], v[3]); *(u32x2*)(U + (size_t)row * 1024 + 4 * lane + 256 * j) = w; }
        }
        }
    }
    SEAM(PH_P0B);

    layer_body<0>(lds, wv, args, ws, G, bx, gw, lo, hi, bar);
    layer_body<1>(lds, wv, args, ws, G, bx, gw, lo, hi, bar);
    layer_body<2>(lds, wv, args, ws, G, bx, gw, lo, hi, bar);
    layer_body<3>(lds, wv, args, ws, G, bx, gw, lo, hi, bar);
#undef IN
#undef SEAM
}

extern "C" void kernel_launch(void* const* d_in, const int* in_sizes, int n_in, void* d_out, int out_size, void* d_ws, size_t ws_size, hipStream_t stream) {
    static int grid = 0;
    if (grid == 0) {
        if (n_in != 26 || out_size != TL * D || ws_size < WS_END) { fprintf(stderr, "kernel_launch: unexpected shapes (n_in %d, out %d, ws %zu < %zu)\n", n_in, out_size, ws_size, (size_t)WS_END); grid = -1; return; }
        int dev = 0, cus = 0, per_cu = 0;
        if (hipGetDevice(&dev) != hipSuccess || hipDeviceGetAttribute(&cus, hipDeviceAttributeMultiprocessorCount, dev) != hipSuccess) { grid = -1; return; }
        if (hipFuncSetAttribute((const void*)hymba_fwd, hipFuncAttributeMaxDynamicSharedMemorySize, LDS_BYTES) != hipSuccess) { fprintf(stderr, "kernel_launch: hipFuncSetAttribute failed\n"); grid = -1; return; }
        if (hipOccupancyMaxActiveBlocksPerMultiprocessor(&per_cu, (const void*)hymba_fwd, 512, LDS_BYTES) != hipSuccess || per_cu < 1) { fprintf(stderr, "kernel_launch: occupancy query reports %d\n", per_cu); }
        (void)hipGetLastError();
        grid = cus;
        if (per_cu < 1) grid = -1;
    }
    if (grid < 0) return;
    if (hipMemsetAsync((char*)d_ws + WS_CTL, 0, CTL_ZERO_BYTES, stream) != hipSuccess) return;
    Args a{};
    for (int i = 0; i < 26; ++i) a.in[i] = (const float*)d_in[i];
    a.out = (float*)d_out; a.ws = (unsigned char*)d_ws;
#if MK_N_LAUNCHES == 1
    a.ph_lo = 0; a.ph_hi = N_PHASES;
    hipLaunchKernelGGL(hymba_fwd, dim3(grid), dim3(512), LDS_BYTES, stream, a);
#else
    for (int p = 0; p < N_PHASES; ++p) {
        const int lp = p - PH_LAYER0;
        if (lp >= 0 && (lp % PH_PER_LAYER) == LP_R1 && (((lp / PH_PER_LAYER) & 1) == 0)) continue;
        a.ph_lo = p; a.ph_hi = p + 1;
        hipLaunchKernelGGL(hymba_fwd, dim3(grid), dim3(512), LDS_BYTES, stream, a);
    }
#endif
}
```

```cpp
#define DIFF_GRPB 0
#include <hip/hip_runtime.h>
#include <cstdio>
#include <cstdint>

#ifndef MK_N_LAUNCHES
#define MK_N_LAUNCHES 1
#endif

#define LAS __attribute__((address_space(3)))
#define GAS __attribute__((address_space(1)))
typedef unsigned short bf16_t;
typedef short bf16x8 __attribute__((ext_vector_type(8)));
typedef float f32x2 __attribute__((ext_vector_type(2)));
typedef float f32x4 __attribute__((ext_vector_type(4)));
typedef float f32x16 __attribute__((ext_vector_type(16)));
typedef unsigned u32x2 __attribute__((ext_vector_type(2)));
typedef unsigned u32x4 __attribute__((ext_vector_type(4)));
typedef short s16x4 __attribute__((ext_vector_type(4)));
typedef __bf16 bf16x2_t __attribute__((ext_vector_type(2)));

constexpr int D = 1024, NB = 4, SEQ = 4096, CTX = 256, TL = NB * SEQ, TC = NB * CTX, T = TL + TC, KEYS = CTX + SEQ;
constexpr int DEPTH = 4, INC = 2048, FF = 2816, NE = 8, NCB = 5;
constexpr int LRU_CH = 256, LRU_CHUNK = 32, LRU_NCH = KEYS / LRU_CHUNK;
constexpr float ALPHA = 1.6817928305074290f;
constexpr float LN_EPS = 1e-5f;
constexpr float LOG2E = 1.4426950408889634f;
constexpr int MOE_ROWS = 36864;

constexpr size_t MiB = 1u << 20;
constexpr size_t WS_CTL = 0, CTL_ZERO_BYTES = 64 * 1024;
constexpr size_t WS_MOD = 1 * MiB;
constexpr size_t WS_COS64 = WS_MOD + 512 * 1024, WS_SIN64 = WS_COS64 + 512 * 1024;
constexpr size_t WS_COS32 = WS_SIN64 + 512 * 1024, WS_SIN32 = WS_COS32 + 256 * 1024;
constexpr size_t WS_GWT = 3 * MiB;
constexpr size_t WS_CM = WS_GWT + 512 * 1024;
constexpr size_t WS_CARRY = WS_CM + 2304 * 1024;
constexpr size_t WS_KMAX = WS_MOD + 500 * 1024;
constexpr size_t WS_TOKE = 7 * MiB, WS_TOKG = WS_TOKE + 144 * 1024, WS_TOKR = WS_TOKG + 144 * 1024, WS_TOKS = WS_TOKR + 144 * 1024;
constexpr size_t WS_WIN = 8 * MiB;
constexpr size_t WS_WOUT = 24 * MiB;
constexpr size_t WS_F13 = 32 * MiB;
constexpr size_t WS_F2 = 54 * MiB;
constexpr size_t WS_M13 = 65 * MiB;
constexpr size_t WS_M2 = 241 * MiB;
constexpr size_t WS_H = 329 * MiB;
constexpr size_t WS_U = 397 * MiB;
constexpr size_t WS_X = 431 * MiB;
constexpr size_t WS_LRUX = WS_X;
constexpr size_t WS_GATE = WS_LRUX + (size_t)T * 256 * 2;
constexpr size_t WS_QS = WS_GATE + (size_t)T * 256 * 2;
constexpr size_t WS_KS = WS_QS + (size_t)T * 512 * 2;
constexpr size_t WS_VS = WS_KS + (size_t)NB * 2 * KEYS * 64 * 2;
constexpr size_t WS_QD = WS_VS + (size_t)NB * 2 * KEYS * 64 * 2;
constexpr size_t WS_KD = WS_QD + (size_t)T * 256 * 2;
constexpr size_t WS_VD = WS_KD + (size_t)NB * 4 * KEYS * 64 * 2;
constexpr size_t WS_MIX = WS_VD + (size_t)NB * 4 * KEYS * 64 * 2;
constexpr size_t WS_MB = WS_MIX + (size_t)T * 1024 * 2;
constexpr size_t WS_YB = WS_X;
constexpr size_t WS_HID = WS_YB + (size_t)MOE_ROWS * 1024 * 2;
constexpr size_t WS_END = WS_HID + (size_t)MOE_ROWS * FF * 2;
constexpr size_t WS_AB = WS_MB + (size_t)T * 1024 * 2;
static_assert(WS_AB + (size_t)NB * LRU_NCH * 2 * 16384 * 4 <= WS_END, "AB");
constexpr size_t WS_YBX = (size_t)602 << 20;
static_assert(WS_YBX >= WS_HID + (size_t)(2 * T + 2048) * 2816, "YBX");
constexpr size_t WS_PART2 = WS_X;
constexpr size_t WS_PART4 = 600 * MiB;
static_assert(WS_PART2 + 8 * 4 * MiB <= WS_MIX && WS_PART4 >= WS_HID + (size_t)T * FF * 2 && WS_PART4 + 11 * 4 * MiB <= WS_END, "partial buffers");
static_assert(WS_MB + (size_t)T * 1024 * 2 <= WS_END && WS_CM + (size_t)NB * LRU_NCH * 1024 * 4 <= WS_CARRY && WS_CARRY + (size_t)NB * LRU_NCH * 512 * 4 <= WS_TOKE && (size_t)T * 8 <= 144 * 1024 && WS_TOKS + 144 * 1024 <= WS_WIN, "ws map");
static_assert(WS_HID >= WS_MIX, "HID must not overlay buffers live during the up GEMM inputs");
constexpr int CW_BAR = 4096;
constexpr int CW_CNT = 1024;
constexpr int CW_HO = 2048;
constexpr int CW_HOP = 3072;
static_assert((CW_BAR + 3456) * 4 <= (int)CTL_ZERO_BYTES, "control words inside the memset region");

constexpr int RING_BYTES = 131072;
constexpr int LDSCTL_OFF = RING_BYTES, MISC_OFF = LDSCTL_OFF + 320;
constexpr int LDS_BYTES = 147456;

__device__ __forceinline__ int lane_id() { return (int)__builtin_amdgcn_mbcnt_hi(~0u, __builtin_amdgcn_mbcnt_lo(~0u, 0u)); }
__device__ __forceinline__ int opaque_tid(int wv) { unsigned z = 0u; asm volatile("" : "+v"(z));
    int t = wv * 64 + (int)__builtin_amdgcn_mbcnt_hi(~0u, __builtin_amdgcn_mbcnt_lo(~0u, z)); asm volatile("" : "+v"(t)); return t; }
#ifndef WT_STORES
#define WT_STORES 0
#endif
__device__ __forceinline__ void st16(void* p, u32x4 v) {
#if WT_STORES
    asm volatile("global_store_dwordx4 %0, %1, off sc1\n\ts_nop 1" :: "v"(p), "v"(v) : "memory");
#else
    *(GAS u32x4*)p = v;
#endif
}
__device__ __forceinline__ void st16f(void* p, f32x4 v) { st16(p, __builtin_bit_cast(u32x4, v)); }
__device__ __forceinline__ float clamp_f8(float v) { return __builtin_amdgcn_fmed3f(v, -416.f, 416.f); }
__device__ __forceinline__ unsigned cvt4_fp8(float a, float b, float c, float d) {
    int w = 0; w = __builtin_amdgcn_cvt_pk_fp8_f32(clamp_f8(a), clamp_f8(b), w, false); w = __builtin_amdgcn_cvt_pk_fp8_f32(clamp_f8(c), clamp_f8(d), w, true); return (unsigned)w;
}
constexpr float F8_SU = 4.f, F8_SW13 = 512.f, F8_SH = 2.f, F8_SW2 = 4096.f;
__device__ __forceinline__ unsigned cvtpk(float lo, float hi) { f32x2 v = {lo, hi}; bf16x2_t b = __builtin_convertvector(v, bf16x2_t); return __builtin_bit_cast(unsigned, b); }
__device__ __forceinline__ float bf2f(unsigned short x) { return __uint_as_float(((unsigned)x) << 16); }
__device__ __forceinline__ float bflo(unsigned w) { return __uint_as_float(w << 16); }
__device__ __forceinline__ float bfhi(unsigned w) { return __uint_as_float(w & 0xffff0000u); }
#define WS_DPP(v_, ctrl_) __uint_as_float((unsigned)__builtin_amdgcn_update_dpp(0, (int)__float_as_uint(v_), (ctrl_), 0xF, 0xF, true))
__device__ __forceinline__ float wave_sum(float v) {
    v += WS_DPP(v, 0xB1);
    v += WS_DPP(v, 0x4E);
    v += WS_DPP(v, 0x141);
    v += WS_DPP(v, 0x140);
    { auto rr = __builtin_amdgcn_permlane16_swap(__float_as_uint(v), __float_as_uint(v), false, false); v = __uint_as_float(rr[0]) + __uint_as_float(rr[1]); }
    { auto rr = __builtin_amdgcn_permlane32_swap(__float_as_uint(v), __float_as_uint(v), false, false); v = __uint_as_float(rr[0]) + __uint_as_float(rr[1]); }
    return v;
}
__device__ __forceinline__ float fast_exp2(float x) { return __builtin_amdgcn_exp2f(x); }
__device__ __forceinline__ float fast_rcp(float x) { return __builtin_amdgcn_rcpf(x); }
__device__ __forceinline__ float sigmoid_f(float x) { return fast_rcp(1.f + fast_exp2(-LOG2E * x)); }
__device__ __forceinline__ float silu_f(float x) { return x * sigmoid_f(x); }
__device__ __forceinline__ float gelu_tanh_f(float x) {
    const float z = 0.7978845608028654f * (x + 0.044715f * x * x * x);
    return x * sigmoid_f(2.f * z);
}

#define RLX_AGENT __ATOMIC_RELAXED, __HIP_MEMORY_SCOPE_AGENT
__device__ __forceinline__ void ho_signal(unsigned* cnt, int wv) {
    asm volatile("s_waitcnt vmcnt(0)" ::: "memory"); __syncthreads();
    if (wv == 0 && lane_id() == 0) __hip_atomic_fetch_add((GAS unsigned*)cnt, 1u, RLX_AGENT);
}
__device__ __forceinline__ void ho_wait(unsigned* cnt, unsigned target, int wv) {
    if (wv == 0) { unsigned sp = 0u; while (__hip_atomic_load((const GAS unsigned*)cnt, RLX_AGENT) < target) { __builtin_amdgcn_s_sleep(4); if (++sp > (1u << 22)) break; } }
    __syncthreads();
}
__device__ __forceinline__ void st_sc1(float* p, float v) { __hip_atomic_store((GAS unsigned*)p, __float_as_uint(v), RLX_AGENT); }
__device__ __forceinline__ float ld_sc1(const float* p) { return __uint_as_float(__hip_atomic_load((const GAS unsigned*)p, RLX_AGENT)); }

namespace pg8 {
#define PG8_LAS __attribute__((address_space(3)))
constexpr int BM = 256, BK = 64, HALF = 128, HTB = HALF * BK * 2  , STAGE_BYTES = 8 * HTB, NXCD = 8, WGM = 8;
__host__ __device__ __forceinline__ int lds_byte(int r, int c) { const int st = (r >> 4) * 2 + (c >> 5), rr = r & 15, cc = c & 31, ob = rr * 64 + cc * 2; return st * 1024 + (ob ^ (((ob >> 9) & 1) << 5)); }
__host__ __device__ __forceinline__ void stage_rc(int b, int& R, int& C) { const int st = b / 1024, sb = b % 1024, swz = sb ^ (((sb >> 9) & 1) << 5); R = (st >> 1) * 16 + swz / 64; C = (st & 1) * 32 + (swz % 64) / 2; }
__host__ __device__ __forceinline__ int perm32(int rho) { const int n = rho >> 4, i = rho & 15; return 8 * (i >> 2) + 4 * n + (i & 3); }

struct Unit { int pm, pn, pb, sp, nk, kofs, hf, pa; };
struct Gemm { const void* A; const void* Bt; int ld; };

constexpr int UNIT_LIST_OFF = RING_BYTES + 1024, UNIT_LIST_MAX = 64;
struct TileSched {
    PG8_LAS unsigned* ul; int nk_full, nk_piece;
    __device__ __forceinline__ void build(PG8_LAS unsigned char* lds, int wv, int nM, int nN, int G, int c, int nNb, const int (&ts)[9], int nkf, int nMs = 0, int nsplit = 1, int nkp = 0, bool halves = false, int gatherT = 0) {
        ul = (PG8_LAS unsigned*)(lds + UNIT_LIST_OFF); nk_full = nkf; nk_piece = nkp;
        const int t = opaque_tid(wv);
        if (t < 2 * UNIT_LIST_MAX) {
            const int i = t & (UNIT_LIST_MAX - 1); const bool listB = t >= UNIT_LIST_MAX;
            const int nwg = nM * nN; int nfullU = nwg; if (halves) { const int f = (nwg / G) * G; if (2 * (nwg - f) <= G) nfullU = f; }
            long L = (long)i * G + c; unsigned w = 0xffffffffu; unsigned hf = 0u; bool whole = false; unsigned wa = 0u;
            if (!listB) { whole = L < nfullU; }
            else { if (L < 2 * (long)(nwg - nfullU)) { hf = (unsigned)(L & 1); L = nfullU + (L >> 1); whole = true; } }
            if (whole) {
                int wgid = (int)L; { const int q = nwg / NXCD, r = nwg % NXCD, xcd = wgid % NXCD, off = wgid / NXCD; wgid = (xcd < r ? xcd * (q + 1) : r * (q + 1) + (xcd - r) * q) + off; }
                const int nig = WGM * nN, gid = wgid / nig, fm = gid * WGM, gsz = (nM - fm) < WGM ? (nM - fm) : WGM;
                const int pm = fm + ((wgid % nig) % gsz), pn = (wgid % nig) / gsz;
                int e = 0, tse = 0;
#pragma unroll
                for (int k = 1; k < 8; ++k) { const bool ge = pm >= ts[k]; e += ge ? 1 : 0; tse = ge ? ts[k] : tse; }
                w = (unsigned)pm | ((unsigned)pn << 10) | ((unsigned)(e * nNb + pn) << 16) | (hf << 29);
                wa = gatherT ? (unsigned)(e * gatherT + (pm - tse)) : (unsigned)pm;
            } else if (!listB && L >= nwg && L - nwg < (long)nMs * nN * nsplit) {
                const int Ls = (int)(L - nwg), per = nN * nsplit, pm = nM + Ls / per, rem = Ls % per, pn = rem / nsplit, sp = rem % nsplit + 1;
                w = (unsigned)pm | ((unsigned)pn << 10) | ((unsigned)pn << 16) | ((unsigned)sp << 24);
                wa = (unsigned)pm;
            }
            ul[t] = w; ul[t + 2 * UNIT_LIST_MAX] = wa;
        }
        __syncthreads();
    }
    __device__ __forceinline__ TileSched listB() const { TileSched s = *this; s.ul = ul + UNIT_LIST_MAX; return s; }
    __device__ __forceinline__ bool next(int i, Unit& u) const {
        if (i >= UNIT_LIST_MAX) return false;
        const unsigned w = (unsigned)__builtin_amdgcn_readfirstlane((int)ul[i]);
        if (w == 0xffffffffu) return false;
        u.pm = (int)(w & 1023u); u.pn = (int)((w >> 10) & 63u); u.pb = (int)((w >> 16) & 255u); u.sp = (int)((w >> 24) & 31u); u.hf = (int)((w >> 29) & 1u); u.pa = __builtin_amdgcn_readfirstlane((int)ul[i + 2 * UNIT_LIST_MAX]);
        u.nk = u.sp ? nk_piece : nk_full; u.kofs = u.sp ? (u.sp - 1) * nk_piece * 128 : 0; return true;
    }
    __device__ __forceinline__ void a_ready(const Unit&) const {}
    __device__ __forceinline__ void done(const Unit&) const {}
};

struct EpiPlain {
    static constexpr bool PERM = true, AFTER_DRAIN = false;
    bf16_t* O; int ldc; float* PART; int prow0; float scale;
    template <bool HN> __device__ __forceinline__ void run(const f32x4 (&acc)[2][2][4][2], const Unit& u, int wr, int wc, int fr_, int fq_) const {
        int ln_ = lane_id(); asm volatile("" : "+v"(ln_)); const int fr = ln_ & 15, fq = ln_ >> 4; (void)fr_; (void)fq_;
        int lrow = wr * 64 + fr, lcol = wc * 32 + 8 * fq; asm volatile("" : "+v"(lrow), "+v"(lcol));
        const int row0 = u.pm * BM + lrow, col0 = u.pn * BM + lcol + (HN ? u.hf * HALF : 0);
        if (!HN && u.sp) {
            bf16_t* P = (bf16_t*)PART + ((size_t)(u.sp - 1) * 1024 + (row0 - prow0)) * ldc + col0;
#pragma unroll
            for (int ai = 0; ai < 2; ++ai)
#pragma unroll
                for (int m = 0; m < 4; ++m) { bf16_t* rowp = P + (size_t)(ai * HALF + m * 16) * ldc;
#pragma unroll
                    for (int bj = 0; bj < 2; ++bj) { const f32x4 a0 = acc[ai][bj][m][0] * scale, a1 = acc[ai][bj][m][1] * scale;
                        u32x4 w; w.x = cvtpk(a0[0], a0[1]); w.y = cvtpk(a0[2], a0[3]); w.z = cvtpk(a1[0], a1[1]); w.w = cvtpk(a1[2], a1[3]); st16(rowp + bj * HALF, w); } }
            return;
        }
#pragma unroll
        for (int ai = 0; ai < 2; ++ai)
#pragma unroll
            for (int m = 0; m < 4; ++m) { bf16_t* rowp = O + (size_t)(row0 + ai * HALF + m * 16) * ldc + col0;
#pragma unroll
                for (int bj = 0; bj < (HN ? 1 : 2); ++bj) { const f32x4 v0 = acc[ai][bj][m][0] * scale, v1 = acc[ai][bj][m][1] * scale;
                    u32x4 w; w.x = cvtpk(v0[0], v0[1]); w.y = cvtpk(v0[2], v0[3]); w.z = cvtpk(v1[0], v1[1]); w.w = cvtpk(v1[2], v1[3]);
                    st16(rowp + bj * HALF, w); } }
    }
};
struct EpiSwiGLU {
    static constexpr bool PERM = true, AFTER_DRAIN = false;
    bf16_t* O; int ldc;
    template <bool HN> __device__ __forceinline__ void run(const f32x4 (&acc)[2][2][4][2], const Unit& u, int wr, int wc, int fr_, int fq_) const {
        int ln_ = lane_id(); asm volatile("" : "+v"(ln_)); const int fr = ln_ & 15, fq = ln_ >> 4; (void)fr_; (void)fq_;
        static_assert(!HN, "SwiGLU tiles pair the two column halves");
        int lrow = wr * 64 + fr, lcol = wc * 32 + 8 * fq; asm volatile("" : "+v"(lrow), "+v"(lcol));
        const int row0 = u.pm * BM + lrow, col0 = u.pn * HALF + lcol;
#pragma unroll
        for (int ai = 0; ai < 2; ++ai)
#pragma unroll
            for (int m = 0; m < 4; ++m) { bf16_t* rowp = O + (size_t)(row0 + ai * HALF + m * 16) * ldc + col0;
                float h[8];
#pragma unroll
                for (int n = 0; n < 2; ++n)
#pragma unroll
                    for (int j = 0; j < 4; ++j) h[4 * n + j] = silu_f(acc[ai][0][m][n][j]) * acc[ai][1][m][n][j];
                u32x4 w; w.x = cvtpk(h[0], h[1]); w.y = cvtpk(h[2], h[3]); w.z = cvtpk(h[4], h[5]); w.w = cvtpk(h[6], h[7]);
                st16(rowp, w); }
    }
};
struct EpiSwiGLU8 {
    static constexpr bool PERM = true, AFTER_DRAIN = false;
    unsigned char* O8; int ldc;
    template <bool HN> __device__ __forceinline__ void run(const f32x4 (&acc)[2][2][4][2], const Unit& u, int wr, int wc, int fr_, int fq_) const {
        int ln_ = lane_id(); asm volatile("" : "+v"(ln_)); const int fr = ln_ & 15, fq = ln_ >> 4; (void)fr_; (void)fq_;
        static_assert(!HN, "SwiGLU tiles pair the two column halves");
        int lrow = wr * 64 + fr, lcol = wc * 32 + 8 * fq; asm volatile("" : "+v"(lrow), "+v"(lcol));
        const int row0 = u.pm * BM + lrow, col0 = u.pn * HALF + lcol;
        const unsigned off0 = (unsigned)row0 * (unsigned)FF + (unsigned)col0;
        constexpr float si = 1.f / (F8_SU * F8_SW13);
        constexpr float KINV = (F8_SU * F8_SW13) * (F8_SU * F8_SW13) / F8_SH, KL2 = 21.f;
        static_assert(F8_SU * F8_SW13 == 2048.f && F8_SH == 2.f, "K = 2^-21");
#pragma unroll
        for (int ai = 0; ai < 2; ++ai)
#pragma unroll
            for (int m = 0; m < 4; ++m) { unsigned char* rowp = O8 + (off0 + (unsigned)((ai * HALF + m * 16) * FF));
                float h[8];
#pragma unroll
                for (int n = 0; n < 2; ++n)
#pragma unroll
                    for (int j = 0; j < 4; ++j) {
                        const float a0 = acc[ai][0][m][n][j], a1 = acc[ai][1][m][n][j];
                        h[4 * n + j] = (a0 * a1) * fast_rcp(KINV + fast_exp2(__builtin_fmaf(a0, -LOG2E * si, KL2))); }
                u32x2 w; w.x = cvt4_fp8(h[0], h[1], h[2], h[3]); w.y = cvt4_fp8(h[4], h[5], h[6], h[7]);
                *(GAS u32x2*)rowp = w; }
    }
};
struct EpiIn {
    static constexpr bool PERM = true, AFTER_DRAIN = false;
    bf16_t *LRUX, *GATE, *QS, *KS, *VS, *QD, *KD, *VD; const float *c64, *s64, *c32, *s32;
    template <bool HN> __device__ __forceinline__ void run(const f32x4 (&acc)[2][2][4][2], const Unit& u, int wr, int wc, int fr_, int fq_) const {
        int ln_ = lane_id(); asm volatile("" : "+v"(ln_)); const int fr = ln_ & 15, fq = ln_ >> 4; (void)fr_; (void)fq_;
        const int pm = u.pm, pn = u.pn;
        const bool lat = pm < 64;
        const int b = lat ? (pm >> 4) : (pm - 64);
        const int kr0 = lat ? CTX + (pm & 15) * 256 : 0;
        const int s0 = (pm & 15) * 256;
        const int lr0 = wr * 64 + fr;
        int cw = wc * 32 + 8 * fq;
        asm volatile("" : "+v"(cw));
#pragma unroll
        for (int bjl = 0; bjl < (HN ? 1 : 2); ++bjl) {
            const int bj = HN ? u.hf : bjl;
            const int ct = bj * HALF + cw;
            bf16_t* base; int stride; int mode = 0; float scale = 1.f; int pidx = 0; bool gel = false;
            if (pn == 0) { base = LRUX + (size_t)pm * 256 * 256 + ct; stride = 256; }
            else if (pn == 1) { base = GATE + (size_t)pm * 256 * 256 + ct; stride = 256; gel = true; }
            else if (pn == 2 || pn == 3) { const int col = (pn - 2) * 256 + ct; base = QS + (size_t)pm * 256 * 512 + col; stride = 512; mode = 1; pidx = (col & 63) >> 1; scale = 0.125f * LOG2E; }
            else if (pn == 4) { const int hk = (ct & 127) >> 6; bf16_t* kv = bj == 0 ? KS : VS; base = kv + ((size_t)(b * 2 + hk) * KEYS + kr0) * 64 + (ct & 63); stride = 64; mode = bj == 0 ? 1 : 0; pidx = (ct & 63) >> 1; }
            else if (pn == 5) { base = QD + (size_t)pm * 256 * 256 + ct; stride = 256; mode = 2; pidx = (ct & 31) >> 1; scale = 0.17677669529663687f * LOG2E; }
            else { const int h = ct >> 6; bf16_t* kv = pn == 6 ? KD : VD; base = kv + ((size_t)(b * 4 + h) * KEYS + kr0) * 64 + (ct & 63); stride = 64; mode = pn == 6 ? 2 : 0; pidx = (ct & 31) >> 1; }
            if (!lat) mode = 0;
            const bool colb = mode == 1 ? (pidx >= 16) : (pidx >= 8);
            f32x4 ce[4], se[4];
            if (mode != 0) {
#pragma unroll
                for (int k = 0; k < 4; ++k) { const int sk = s0 + lr0 + (colb ? 16 * k : 128 * (k & 1));
                    const float* ct_ = mode == 1 ? c64 + (size_t)sk * 32 + pidx : c32 + (size_t)sk * 16 + pidx;
                    const float* st_ = mode == 1 ? s64 + (size_t)sk * 32 + pidx : s32 + (size_t)sk * 16 + pidx;
                    ce[k] = *(const GAS f32x4*)ct_; se[k] = *(const GAS f32x4*)st_; }
            }
#pragma unroll
            for (int ai = 0; ai < 2; ++ai)
#pragma unroll
                for (int m = 0; m < 4; ++m) {
                    const int lr = lr0 + ai * HALF + m * 16;
                    f32x4 v0 = acc[ai][bjl][m][0], v1 = acc[ai][bjl][m][1];
                    if (mode != 0) {
                        f32x4 cs, sn;
#pragma unroll
                        for (int j = 0; j < 4; ++j) { cs[j] = colb ? ce[m][j] : ce[ai][j]; sn[j] = colb ? se[m][j] : se[ai][j]; }
                        f32x4 r0, r1;
                        r0[0] = v0[0] * cs[0] - v0[1] * sn[0]; r0[1] = v0[1] * cs[0] + v0[0] * sn[0];
                        r0[2] = v0[2] * cs[1] - v0[3] * sn[1]; r0[3] = v0[3] * cs[1] + v0[2] * sn[1];
                        r1[0] = v1[0] * cs[2] - v1[1] * sn[2]; r1[1] = v1[1] * cs[2] + v1[0] * sn[2];
                        r1[2] = v1[2] * cs[3] - v1[3] * sn[3]; r1[3] = v1[3] * cs[3] + v1[2] * sn[3];
                        v0 = r0; v1 = r1;
                    }
                    if (gel) {
#pragma unroll
                        for (int j = 0; j < 4; ++j) { v0[j] = gelu_tanh_f(v0[j]); v1[j] = gelu_tanh_f(v1[j]); }
                    }
                    v0 = v0 * scale; v1 = v1 * scale;
                    u32x4 w; w.x = cvtpk(v0[0], v0[1]); w.y = cvtpk(v0[2], v0[3]); w.z = cvtpk(v1[0], v1[1]); w.w = cvtpk(v1[2], v1[3]);
                    st16(base + (size_t)lr * stride, w);
                }
            asm volatile("" ::: "memory");
        }
    }
};

template <class Epi, class Sched, bool ALIGN_EPI = false, bool SP2 = false, bool HN = false, bool F8 = false>
__device__ __forceinline__ void gemm_phase(PG8_LAS unsigned char* lds, const int wv, const Gemm g, const Sched& S, const Epi& E) {
    const int tid = opaque_tid(wv), wid = __builtin_amdgcn_readfirstlane(tid >> 6), lane = tid & 63, wr = wid >> 2, wc = wid & 3, fr = lane & 15, fq = lane >> 4;
    constexpr int ESZ = F8 ? 1 : 2;
    const int K = g.ld;
    unsigned voffA[2], voffB[2];
#pragma unroll
    for (int i = 0; i < 2; ++i) { int R, C; stage_rc(tid * 16 + i * 8192, R, C); const int Rb = Epi::PERM ? ((R & ~31) + perm32(R & 31)) : R;
        voffA[i] = (unsigned)(R * K * ESZ + C * 2); voffB[i] = (unsigned)(Rb * K * ESZ + C * 2); }
    const size_t kstep = (size_t)(BK * 2);
    const size_t hstep = (size_t)HALF * K * ESZ;
    const size_t tstep = 2 * hstep;
    const unsigned ldsbase = (unsigned)(uintptr_t)lds + (unsigned)wid * 1024u;
    const unsigned ldsw = (unsigned)wid * 1024u;
    const int aoff = lds_byte(wr * 64 + fr, fq * 8), boff = lds_byte(wc * 32 + fr, fq * 8);
#define PG8_SA(b, h) (((b) * 2 + (h)) * HTB)
#define PG8_SB(b, h) ((4 + (b) * 2 + (h)) * HTB)
#define PG8_STAGE(bufoff, gbase, voff) do { _Pragma("unroll") for (int _i = 0; _i < 2; ++_i) { \
        asm volatile("s_mov_b32 m0, %2\n\ts_nop 0\n\tglobal_load_lds_dwordx4 %0, %1" \
                     :: "v"((voff)[_i]), "s"((const char*)(gbase)), "s"(ldsbase + (unsigned)((bufoff) + _i * 8192)) : "memory", "m0"); } } while (0)
#define PG8_LDA(dst, b, h) do { _Pragma("unroll") for (int m = 0; m < 4; ++m) { if constexpr (F8) { dst##8[m].lo = *(const PG8_LAS v4i_t*)(lds + PG8_SA(b, h) + aoff + m * 2048); dst##8[m].hi = *(const PG8_LAS v4i_t*)(lds + PG8_SA(b, h) + aoff + m * 2048 + 1024); } \
        else { _Pragma("unroll") for (int k = 0; k < 2; ++k) dst[m][k] = *(const PG8_LAS bf16x8*)(lds + PG8_SA(b, h) + aoff + m * 2048 + k * 1024); } } } while (0)
#define PG8_LDB(dst, b, h) do { _Pragma("unroll") for (int n = 0; n < 2; ++n) { if constexpr (F8) { dst##8[n].lo = *(const PG8_LAS v4i_t*)(lds + PG8_SB(b, h) + boff + n * 2048); dst##8[n].hi = *(const PG8_LAS v4i_t*)(lds + PG8_SB(b, h) + boff + n * 2048 + 1024); } \
        else { _Pragma("unroll") for (int k = 0; k < 2; ++k) dst[n][k] = *(const PG8_LAS bf16x8*)(lds + PG8_SB(b, h) + boff + n * 2048 + k * 1024); } } } while (0)
#define PG8_MMA(ai, bj, At, Bt) do { __builtin_amdgcn_s_setprio(1); _Pragma("unroll") for (int m = 0; m < 4; ++m) _Pragma("unroll") for (int n = 0; n < 2; ++n) { \
        if constexpr (F8) acc[ai][bj][m][n] = __builtin_amdgcn_mfma_scale_f32_16x16x128_f8f6f4(Bt##8[n], At##8[m], acc[ai][bj][m][n], 0, 0, 0, f8one, 0, f8one); \
        else { _Pragma("unroll") for (int k = 0; k < 2; ++k) acc[ai][bj][m][n] = __builtin_amdgcn_mfma_f32_16x16x32_bf16(Bt[n][k], At[m][k], acc[ai][bj][m][n], 0, 0, 0); } } \
        __builtin_amdgcn_s_setprio(0); } while (0)
#define PG8_MMAZ(ai, bj, At, Bt) do { __builtin_amdgcn_s_setprio(1); _Pragma("unroll") for (int m = 0; m < 4; ++m) _Pragma("unroll") for (int n = 0; n < 2; ++n) { \
        if constexpr (F8) acc[ai][bj][m][n] = __builtin_amdgcn_mfma_scale_f32_16x16x128_f8f6f4(Bt##8[n], At##8[m], (f32x4){0.f, 0.f, 0.f, 0.f}, 0, 0, 0, f8one, 0, f8one); \
        else { acc[ai][bj][m][n] = __builtin_amdgcn_mfma_f32_16x16x32_bf16(Bt[n][0], At[m][0], (f32x4){0.f, 0.f, 0.f, 0.f}, 0, 0, 0); acc[ai][bj][m][n] = __builtin_amdgcn_mfma_f32_16x16x32_bf16(Bt[n][1], At[m][1], acc[ai][bj][m][n], 0, 0, 0); } } \
        __builtin_amdgcn_s_setprio(0); } while (0)
#define PG8_MMAF(ai, bj, At, Bt) do { if constexpr (F8) PG8_MMA(ai, bj, At, Bt); else { if (t == 0) PG8_MMAZ(ai, bj, At, Bt); else PG8_MMA(ai, bj, At, Bt); } } while (0)
#define PG8_WAIT_V(n) asm volatile("s_waitcnt vmcnt(" #n ")" ::: "memory")
#define PG8_WAIT_L(n) asm volatile("s_waitcnt lgkmcnt(" #n ")" ::: "memory")
#define PG8_BAR __builtin_amdgcn_s_barrier()
#define PG8_SCHED __builtin_amdgcn_sched_barrier(0)
    typedef unsigned long long pg8_u64x2 __attribute__((ext_vector_type(2)));
#define PG8_ZERO4(x_) do { unsigned long long lo_, hi_; asm volatile("v_mov_b64 %0, 0" : "=v"(lo_)); asm volatile("v_mov_b64 %0, 0" : "=v"(hi_)); x_ = __builtin_bit_cast(f32x4, (pg8_u64x2){lo_, hi_}); } while (0)
    Unit cur, nxt; int ui = 0;
    if (!S.next(0, cur)) return;
    f32x4 acc[2][2][4][2];
    if constexpr (!SP2 || F8) {
#pragma unroll
    for (int a = 0; a < 2; ++a)
#pragma unroll
        for (int b = 0; b < 2; ++b)
#pragma unroll
            for (int m = 0; m < 4; ++m)
#pragma unroll
                for (int n = 0; n < 2; ++n) PG8_ZERO4(acc[a][b][m][n]);
    }
    int f8one; asm volatile("s_mov_b32 %0, 0x7f7f7f7f" : "=s"(f8one));
    typedef int v4i_t __attribute__((ext_vector_type(4))); typedef int v8i_t __attribute__((ext_vector_type(8)));
    bf16x8 At[4][2], B0[2][2], B1[2][2]; v8i_t At8[4], B08[2], B18[2];
    const char* cA = (const char*)g.A + (size_t)cur.pa * tstep + (size_t)cur.kofs; const char* cB = (const char*)g.Bt + (size_t)cur.pb * tstep + (size_t)cur.hf * hstep + (size_t)cur.kofs;
    int nt = cur.nk;
    S.a_ready(cur);
    if constexpr (SP2 && HN) {
        static_assert(!HN || SP2, "HN needs SP2");
        PG8_STAGE(PG8_SB(0, 0), cB, voffB); PG8_STAGE(PG8_SA(0, 0), cA, voffA); PG8_STAGE(PG8_SA(0, 1), cA + hstep, voffA);
        if (wr == 1) PG8_BAR;
        PG8_WAIT_V(2); PG8_BAR;
        PG8_STAGE(PG8_SB(1, 0), cB + kstep, voffB); PG8_STAGE(PG8_SA(1, 0), cA + kstep, voffA);
        PG8_WAIT_V(4); PG8_BAR;
    } else if constexpr (SP2) {
        PG8_STAGE(PG8_SB(0, 0), cB, voffB); PG8_STAGE(PG8_SB(0, 1), cB + hstep, voffB); PG8_STAGE(PG8_SA(0, 0), cA, voffA); PG8_STAGE(PG8_SA(0, 1), cA + hstep, voffA);
        if (wr == 1) PG8_BAR;
        PG8_WAIT_V(2); PG8_BAR;
        PG8_STAGE(PG8_SB(1, 0), cB + kstep, voffB); PG8_STAGE(PG8_SA(1, 0), cA + kstep, voffA); PG8_STAGE(PG8_SB(1, 1), cB + hstep + kstep, voffB);
        PG8_WAIT_V(6); PG8_BAR;
    } else {
        PG8_STAGE(PG8_SB(0, 0), cB, voffB); PG8_STAGE(PG8_SA(0, 0), cA, voffA); PG8_STAGE(PG8_SB(0, 1), cB + hstep, voffB); PG8_STAGE(PG8_SA(0, 1), cA + hstep, voffA);
        if (wr == 1) PG8_BAR;
        PG8_WAIT_V(4); PG8_BAR;
        PG8_STAGE(PG8_SB(1, 0), cB + kstep, voffB); PG8_STAGE(PG8_SA(1, 0), cA + kstep, voffA); PG8_STAGE(PG8_SB(1, 1), cB + hstep + kstep, voffB);
        PG8_WAIT_V(6); PG8_BAR;
    }
    for (;;) {
        const bool has_next = S.next(ui + 1, nxt);
        const char* nA = has_next ? (const char*)g.A + (size_t)nxt.pa * tstep + (size_t)nxt.kofs : cA; const char* nB = has_next ? (const char*)g.Bt + (size_t)nxt.pb * tstep + (size_t)nxt.hf * hstep + (size_t)nxt.kofs : cB;
        for (int t = 0; t < nt; t += 2) {
            const bool last = (t == nt - 2);
            const char* a1 = cA + (size_t)(t + 1) * kstep;
            const char* a2 = last ? nA : cA + (size_t)(t + 2) * kstep; const char* b2 = last ? nB : cB + (size_t)(t + 2) * kstep;
            const char* a3 = a2 + kstep; const char* b3 = b2 + kstep;
            if (last && has_next) S.a_ready(nxt);
            if constexpr (SP2 && HN) {
            PG8_LDB(B0, 0, 0); PG8_SCHED; PG8_LDA(At, 0, 0); PG8_STAGE(PG8_SA(1, 1), a1 + hstep, voffA);
            PG8_WAIT_V(6); PG8_WAIT_L(0); PG8_BAR; PG8_MMAF(0, 0, At, B0); PG8_BAR; PG8_SCHED;
            PG8_LDA(At, 0, 1); PG8_STAGE(PG8_SB(0, 0), b2, voffB); PG8_STAGE(PG8_SA(0, 0), a2, voffA);
            PG8_WAIT_V(6); PG8_WAIT_L(0); PG8_BAR; PG8_MMAF(1, 0, At, B0); PG8_BAR; PG8_SCHED;
            PG8_LDB(B0, 1, 0); PG8_SCHED; PG8_LDA(At, 1, 0); PG8_STAGE(PG8_SA(0, 1), a2 + hstep, voffA);
            PG8_WAIT_V(6); PG8_WAIT_L(0); PG8_BAR; PG8_MMA(0, 0, At, B0); PG8_BAR; PG8_SCHED;
            PG8_LDA(At, 1, 1); PG8_STAGE(PG8_SB(1, 0), b3, voffB); PG8_STAGE(PG8_SA(1, 0), a3, voffA);
            PG8_WAIT_V(6); PG8_WAIT_L(0); PG8_BAR; PG8_MMA(1, 0, At, B0); PG8_BAR; PG8_SCHED;
            } else if constexpr (SP2) {
            PG8_LDB(B0, 0, 0); PG8_LDB(B1, 0, 1); PG8_SCHED; PG8_LDA(At, 0, 0); PG8_STAGE(PG8_SA(1, 1), a1 + hstep, voffA);
            PG8_WAIT_V(8); PG8_WAIT_L(0); PG8_BAR; PG8_MMAF(0, 0, At, B0); PG8_MMAF(0, 1, At, B1); PG8_BAR; PG8_SCHED;
            PG8_LDA(At, 0, 1); PG8_STAGE(PG8_SB(0, 0), b2, voffB); PG8_STAGE(PG8_SB(0, 1), b2 + hstep, voffB); PG8_STAGE(PG8_SA(0, 0), a2, voffA);
            PG8_WAIT_V(8); PG8_WAIT_L(0); PG8_BAR; PG8_MMAF(1, 0, At, B0); PG8_MMAF(1, 1, At, B1); PG8_BAR; PG8_SCHED;
            PG8_LDB(B0, 1, 0); PG8_LDB(B1, 1, 1); PG8_SCHED; PG8_LDA(At, 1, 0); PG8_STAGE(PG8_SA(0, 1), a2 + hstep, voffA);
            PG8_WAIT_V(8); PG8_WAIT_L(0); PG8_BAR; PG8_MMA(0, 0, At, B0); PG8_MMA(0, 1, At, B1); PG8_BAR; PG8_SCHED;
            PG8_LDA(At, 1, 1); PG8_STAGE(PG8_SB(1, 0), b3, voffB); PG8_STAGE(PG8_SB(1, 1), b3 + hstep, voffB); PG8_STAGE(PG8_SA(1, 0), a3, voffA);
            PG8_WAIT_V(8); PG8_WAIT_L(0); PG8_BAR; PG8_MMA(1, 0, At, B0); PG8_MMA(1, 1, At, B1); PG8_BAR; PG8_SCHED;
            } else {
            PG8_LDB(B0, 0, 0); PG8_SCHED; PG8_LDA(At, 0, 0); PG8_STAGE(PG8_SA(1, 1), a1 + hstep, voffA);
            PG8_WAIT_L(8); PG8_BAR; PG8_WAIT_L(0); PG8_MMA(0, 0, At, B0); PG8_BAR; PG8_SCHED;
            PG8_LDB(B1, 0, 1); PG8_STAGE(PG8_SB(0, 0), b2, voffB);
            PG8_BAR; PG8_WAIT_L(0); PG8_MMA(0, 1, At, B1); PG8_BAR;
            PG8_LDA(At, 0, 1); PG8_STAGE(PG8_SA(0, 0), a2, voffA);
            PG8_BAR; PG8_WAIT_L(0); PG8_MMA(1, 0, At, B0); PG8_BAR; PG8_SCHED;
            PG8_STAGE(PG8_SB(0, 1), b2 + hstep, voffB);
            PG8_WAIT_V(6); PG8_BAR; PG8_MMA(1, 1, At, B1); PG8_BAR;
            PG8_LDB(B0, 1, 0); PG8_SCHED; PG8_LDA(At, 1, 0); PG8_STAGE(PG8_SA(0, 1), a2 + hstep, voffA);
            PG8_WAIT_L(8); PG8_BAR; PG8_WAIT_L(0); PG8_MMA(0, 0, At, B0); PG8_BAR; PG8_SCHED;
            PG8_LDB(B1, 1, 1); PG8_STAGE(PG8_SB(1, 0), b3, voffB);
            PG8_BAR; PG8_WAIT_L(0); PG8_MMA(0, 1, At, B1); PG8_BAR;
            PG8_LDA(At, 1, 1); PG8_STAGE(PG8_SA(1, 0), a3, voffA);
            PG8_BAR; PG8_WAIT_L(0); PG8_MMA(1, 0, At, B0); PG8_BAR; PG8_SCHED;
            PG8_STAGE(PG8_SB(1, 1), b3 + hstep, voffB);
            PG8_WAIT_V(6); PG8_BAR; PG8_MMA(1, 1, At, B1); PG8_BAR;
            }
        }
        if constexpr (ALIGN_EPI) { if (wr == 0) PG8_BAR; }
        if constexpr (!Epi::AFTER_DRAIN) { E.template run<HN>(acc, cur, wr, wc, fr, fq); S.done(cur); }
        if (!has_next) break;
        if constexpr (!SP2 || F8) {
#pragma unroll
        for (int a = 0; a < 2; ++a)
#pragma unroll
            for (int b = 0; b < 2; ++b)
#pragma unroll
                for (int m = 0; m < 4; ++m)
#pragma unroll
                    for (int n = 0; n < 2; ++n) PG8_ZERO4(acc[a][b][m][n]);
        }
        cur = nxt; cA = nA; cB = nB; ++ui; nt = cur.nk;
        if constexpr (ALIGN_EPI) { if (wr == 1) PG8_BAR; }
    }
    PG8_WAIT_V(0);
    if constexpr (!ALIGN_EPI) { if (wr == 0) PG8_BAR; }
    PG8_BAR;
    if constexpr (Epi::AFTER_DRAIN) { E.fused(acc, cur, wr, wc, fr, fq, lds, wid, lane); S.done(cur); }
#undef PG8_SA
#undef PG8_SB
#undef PG8_STAGE
#undef PG8_LDA
#undef PG8_LDB
#undef PG8_MMA
#undef PG8_ZERO4
#undef PG8_MMAZ
#undef PG8_MMAF
#undef PG8_WAIT_V
#undef PG8_WAIT_L
#undef PG8_BAR
#undef PG8_SCHED
}
}

#define XB_TMO      128
#define XB_XCNT(j)  (256  + 64 * (j))
#define XB_XSUB(j)  (1280 + 64 * (j))
#define XB_XGEN(j)  (2304 + 64 * (j))
#define XB_TOP      3328
#define XB_TOPGEN   3392
#define XCD_BAR_WORDS 3456
#define XB_SPIN_CAP (1u << 18)
#ifndef XB_EARLY_WB
#define XB_EARLY_WB 0
#endif

__device__ __forceinline__ unsigned xb_ld(unsigned* p)              { return __hip_atomic_load(p, __ATOMIC_RELAXED, __HIP_MEMORY_SCOPE_AGENT); }
__device__ __forceinline__ unsigned xb_add(unsigned* p, unsigned v) { return __hip_atomic_fetch_add(p, v, __ATOMIC_RELAXED, __HIP_MEMORY_SCOPE_AGENT); }
__device__ __forceinline__ unsigned xb_xcc_id() { return (unsigned)__builtin_amdgcn_s_getreg((3 << 11) | 20) & 0xFu; }
#define XB_SPIN(cond, bar) do { unsigned _sp = 0; while (cond) { __builtin_amdgcn_s_sleep(1); \
    if ((++_sp & 255u) == 0u) { if (xb_ld(&(bar)[XB_TMO])) break; if (_sp > XB_SPIN_CAP) { atomicAdd(&(bar)[XB_TMO], 1u); break; } } } } while (0)

struct XcdBarrier {
    unsigned* bar; unsigned x; int wv;
    volatile LAS unsigned* st;
};

__device__ __forceinline__ XcdBarrier xcd_barrier_post(unsigned* bar, volatile LAS unsigned* st, int wv) {
    XcdBarrier b; b.bar = bar; b.x = xb_xcc_id(); b.st = st; b.wv = wv;
    if (wv == 0 && lane_id() == 0) (void)xb_add(&bar[XB_XCNT(b.x)], 1u);
    return b;
}
__device__ __forceinline__ void xcd_barrier_complete(unsigned* bar, unsigned x, unsigned& nloc, unsigned& nx) {
    const unsigned G = gridDim.x * gridDim.y * gridDim.z;
    unsigned sum, cnt, mine, sp = 0u;
    for (;;) {
        sum = 0u; cnt = 0u; mine = 0u;
#pragma unroll
        for (unsigned j = 0; j < 16; ++j) { const unsigned c = xb_ld(&bar[XB_XCNT(j)]); sum += c; cnt += (c > 0u) ? 1u : 0u; mine = (j == x) ? c : mine; }
        if (sum == G) break;
        __builtin_amdgcn_s_sleep(1);
        if ((++sp & 255u) == 0u) { if (xb_ld(&bar[XB_TMO])) break; if (sp > XB_SPIN_CAP) { atomicAdd(&bar[XB_TMO], 1u); break; } }
    }
    nloc = mine > 0u ? mine : 1u; nx = cnt > 0u ? cnt : 1u;
}

__device__ __forceinline__ void xcd_barrier(const XcdBarrier& b) {
    asm volatile("s_waitcnt vmcnt(0)" ::: "memory");
    __syncthreads();
    if (b.wv == 0 && lane_id() == 0) {
        unsigned* bar = b.bar;
        __builtin_amdgcn_s_waitcnt(0);
        unsigned nloc = b.st[0], nx = b.st[1];
        if (nloc == 0u) { xcd_barrier_complete(bar, b.x, nloc, nx); b.st[0] = nloc; b.st[1] = nx; }
#if XB_EARLY_WB
        __builtin_amdgcn_fence(__ATOMIC_RELEASE, "agent");
#endif
        const unsigned old = xb_add(&bar[XB_XSUB(b.x)], 1u);
        const unsigned gen = old / nloc;
        if (old + 1u == (gen + 1u) * nloc) {
            __builtin_amdgcn_fence(__ATOMIC_RELEASE, "agent");
            asm volatile("s_waitcnt vmcnt(0)" ::: "memory");
            const unsigned og = xb_add(&bar[XB_TOP], 1u);
            const unsigned tg = og / nx;
            if (og + 1u == (tg + 1u) * nx) xb_add(&bar[XB_TOPGEN], 1u);
            else XB_SPIN(xb_ld(&bar[XB_TOPGEN]) == tg, bar);
            __builtin_amdgcn_fence(__ATOMIC_ACQUIRE, "agent");
            xb_add(&bar[XB_XGEN(b.x)], 1u);
            asm volatile("s_waitcnt vmcnt(0)" ::: "memory");
        } else {
            XB_SPIN(xb_ld(&bar[XB_XGEN(b.x)]) == gen, bar);
            __builtin_amdgcn_fence(__ATOMIC_ACQUIRE, "agent");
            asm volatile("s_waitcnt vmcnt(0)" ::: "memory");
        }
    }
    __syncthreads();
}

#ifndef SWA_FIXM
#define SWA_FIXM 1
#endif
#ifndef FD_SPREAD
#define FD_SPREAD 1
#endif
#ifndef DIFF_GRPB
#define DIFF_GRPB 1
#endif
#ifndef DIFF_STAG
#define DIFF_STAG 1
#endif
__device__ __forceinline__ int crow(int e, int h) { return (e & 3) + 8 * (e >> 2) + 4 * h; }
__device__ __forceinline__ float xhalf_max(float m) { auto rr = __builtin_amdgcn_permlane32_swap(__float_as_uint(m), __float_as_uint(m), false, false); return fmaxf(__uint_as_float(rr[0]), __uint_as_float(rr[1])); }
__device__ __forceinline__ float xhalf_sum(float m) { auto rr = __builtin_amdgcn_permlane32_swap(__float_as_uint(m), __float_as_uint(m), false, false); return __uint_as_float(rr[0]) + __uint_as_float(rr[1]); }
typedef short v4i16_t __attribute__((ext_vector_type(4)));
__device__ __forceinline__ void glds16(const void* gsrc, unsigned lds_dst) {
    asm volatile("s_mov_b32 m0, %1\n\ts_nop 0\n\tglobal_load_lds_dwordx4 %0, off" :: "v"(gsrc), "s"(lds_dst) : "memory", "m0"); }
__device__ __forceinline__ s16x4 vtr(LAS unsigned char* p) { return __builtin_bit_cast(s16x4, __builtin_amdgcn_ds_read_tr16_b64_v4i16((LAS v4i16_t*)p)); }

__device__ __forceinline__ f32x16 mfma_from_c(bf16x8 a, bf16x8 b, const f32x16& c) {
    f32x16 d; asm("s_nop 1\n\tv_mfma_f32_32x32x16_bf16 %0, %1, %2, %3" : "=&v"(d) : "v"(a), "v"(b), "v"(c)); return d;
}
template <int NCOMP, int KSTEPS, bool MASK, bool FIXM>
__device__ __forceinline__ void flash_unit(LAS unsigned char* lds, const int wv, const bf16_t* qrow, const bf16_t* Kb, const bf16_t* Vb, int ntiles, int kb0, int qabs,
                                           float m0, float l0, const float* kmax, f32x16 (&o)[NCOMP][2], float (&lsum)[NCOMP]) {
    const int tid = opaque_tid(wv), lane = tid & 63, r = lane & 31, h = lane >> 5;
    bf16x8 q[NCOMP][KSTEPS];
#pragma unroll
    for (int m = 0; m < NCOMP; ++m)
#pragma unroll
        for (int s = 0; s < KSTEPS; ++s) q[m][s] = *(const GAS bf16x8*)(qrow + m * 32 + 16 * s + 8 * h);
    float mrun[NCOMP], lrun[NCOMP];
    f32x16 negm;
    if (FIXM) {
        float bmax = 0.f;
#pragma unroll
        for (int m = 0; m < NCOMP; ++m) { float qq = 0.f;
#pragma unroll
            for (int s = 0; s < KSTEPS; ++s)
#pragma unroll
                for (int j = 0; j < 8; ++j) { const float x = bf2f((unsigned short)q[m][s][j]); qq += x * x; }
            qq = xhalf_sum(qq);
            bmax = fmaxf(bmax, __builtin_amdgcn_sqrtf(qq) * kmax[m]); }
        const float ref = fmaxf(bmax * 1.001f + 1e-3f, m0);
        l0 = l0 * fast_exp2(m0 - ref);
#pragma unroll
        for (int e = 0; e < 16; ++e) negm[e] = -ref;
    }
#pragma unroll
    for (int m = 0; m < NCOMP; ++m) { mrun[m] = m0; lrun[m] = (h == 0) ? l0 : 0.f; o[m][0] = f32x16{}; o[m][1] = f32x16{}; }
    bf16x8 onesA; f32x4 lacc[NCOMP];
    { const int g_ = lane >> 4, mr_ = lane & 15; const short v_ = ((mr_ == 0 && !(g_ & 1)) || (mr_ == 1 && (g_ & 1))) ? (short)0x3F80 : (short)0;
      onesA = (bf16x8){v_, v_, v_, v_, v_, v_, v_, v_}; }
#pragma unroll
    for (int m = 0; m < NCOMP; ++m) lacc[m] = f32x4{0.f, 0.f, 0.f, 0.f};
    const int wid_u = __builtin_amdgcn_readfirstlane(tid >> 6);
    const int srow = tid >> 3, scl = tid & 7;
    const size_t ksoff = (size_t)srow * 64 + ((scl ^ ((srow >> 1) & 7)) << 3);
    const size_t vsoff = (size_t)srow * 64 + ((scl ^ (((srow >> 1) & 1) << 2)) << 3);
    const unsigned lds0 = (unsigned)(uintptr_t)lds + (unsigned)wid_u * 1024u;
#define FA_STAGE(bufsel, krow_) do { const size_t g0_ = (size_t)(krow_) * 64; const unsigned d_ = (unsigned)__builtin_amdgcn_readfirstlane((int)(lds0 + (unsigned)(bufsel) * 16384u)); \
        glds16(Kb + g0_ + ksoff, d_); glds16(Vb + g0_ + vsoff, d_ + 8192u); } while (0)
    const int kswz = (r >> 1) & 7, kro = r * 128;
    const int q4 = (lane & 15) >> 2, p4 = lane & 3, grp = (lane >> 4) & 1;
    const int vro = 8192 + (4 * h + q4) * 128, vcol = grp * 32 + p4 * 8, vswz = ((q4 >> 1) & 1) << 6;
    FA_STAGE(0, 0);
    asm volatile("s_waitcnt vmcnt(0)" ::: "memory"); __syncthreads();
#pragma nounroll
    for (int it = 0; it < ntiles; ++it) {
        LAS unsigned char* buf = lds + (it & 1) * 16384;
        const bool more = it + 1 < ntiles;
        if (more) { const int kn = (it + 1 < 4) ? 64 * (it + 1) : kb0 + 64 * (it + 1 - 4); FA_STAGE((it + 1) & 1, kn); }
        const int ktile = (it < 4) ? 64 * it : kb0 + 64 * (it - 4);
        bf16x8 pk[NCOMP][4];
        bf16x8 ka[NCOMP][KSTEPS][2];
#pragma unroll
        for (int m = 0; m < NCOMP; ++m)
#pragma unroll
            for (int s = 0; s < KSTEPS; ++s) { const int c = m * 4 + 2 * s + h;
                ka[m][s][0] = *(LAS bf16x8*)(buf + kro + ((c ^ kswz) << 4)); ka[m][s][1] = *(LAS bf16x8*)(buf + 4096 + kro + ((c ^ kswz) << 4)); }
        f32x16 sc[NCOMP][2];
#pragma unroll
        for (int m = 0; m < NCOMP; ++m) {
            if (FIXM) { sc[m][0] = mfma_from_c(ka[m][0][0], q[m][0], negm); sc[m][1] = mfma_from_c(ka[m][0][1], q[m][0], negm); }
            else { sc[m][0] = __builtin_amdgcn_mfma_f32_32x32x16_bf16(ka[m][0][0], q[m][0], f32x16{}, 0, 0, 0); sc[m][1] = __builtin_amdgcn_mfma_f32_32x32x16_bf16(ka[m][0][1], q[m][0], f32x16{}, 0, 0, 0); }
#pragma unroll
            for (int s = 1; s < KSTEPS; ++s) {
                sc[m][0] = __builtin_amdgcn_mfma_f32_32x32x16_bf16(ka[m][s][0], q[m][s], sc[m][0], 0, 0, 0);
                sc[m][1] = __builtin_amdgcn_mfma_f32_32x32x16_bf16(ka[m][s][1], q[m][s], sc[m][1], 0, 0, 0);
            }
        }
        bf16x8 vf[2][4];
#pragma unroll
        for (int db = 0; db < 2; ++db)
#pragma unroll
            for (int ks = 0; ks < 4; ++ks) { LAS unsigned char* vp = buf + vro + ks * 2048 + ((db * 64 + vcol) ^ vswz);
                const s16x4 lo = vtr(vp), hi = vtr(vp + 1024);
                vf[db][ks] = (bf16x8){lo[0], lo[1], lo[2], lo[3], hi[0], hi[1], hi[2], hi[3]}; }
#pragma unroll
        for (int m = 0; m < NCOMP; ++m) {
            f32x16 s0 = sc[m][0], s1 = sc[m][1];
            if (MASK && (it == 4 || it == ntiles - 1)) {
                const int kt0 = ktile - CTX - qabs + 4 * h;
#pragma unroll
                for (int e = 0; e < 16; ++e) { const int d0 = kt0 + (e & 3) + 8 * (e >> 2), d1 = d0 + 32;
                    if (d0 > 128 || d0 < -128) s0[e] = -1e30f;
                    if (d1 > 128 || d1 < -128) s1[e] = -1e30f; }
            }
            if (FIXM) {
#pragma unroll
                for (int e = 0; e < 16; ++e) { s0[e] = fast_exp2(s0[e]); s1[e] = fast_exp2(s1[e]); }
            } else {
            float mx = fmaxf(s0[0], s1[0]);
#pragma unroll
            for (int e = 1; e < 16; ++e) mx = fmaxf(mx, fmaxf(s0[e], s1[e]));
            mx = xhalf_max(mx);
            const float mn = fmaxf(mrun[m], mx), alpha = fast_exp2(mrun[m] - mn); mrun[m] = mn;
            float ps = 0.f;
#pragma unroll
            for (int e = 0; e < 16; ++e) { s0[e] = fast_exp2(s0[e] - mn); s1[e] = fast_exp2(s1[e] - mn); ps += s0[e] + s1[e]; }
            lrun[m] = lrun[m] * alpha + ps;
            if (__any(alpha != 1.f)) { o[m][0] = o[m][0] * alpha; o[m][1] = o[m][1] * alpha; }
            }
            u32x4 w;
            w.x = cvtpk(s0[0], s0[1]); w.y = cvtpk(s0[2], s0[3]); w.z = cvtpk(s0[4], s0[5]); w.w = cvtpk(s0[6], s0[7]); pk[m][0] = __builtin_bit_cast(bf16x8, w);
            w.x = cvtpk(s0[8], s0[9]); w.y = cvtpk(s0[10], s0[11]); w.z = cvtpk(s0[12], s0[13]); w.w = cvtpk(s0[14], s0[15]); pk[m][1] = __builtin_bit_cast(bf16x8, w);
            w.x = cvtpk(s1[0], s1[1]); w.y = cvtpk(s1[2], s1[3]); w.z = cvtpk(s1[4], s1[5]); w.w = cvtpk(s1[6], s1[7]); pk[m][2] = __builtin_bit_cast(bf16x8, w);
            w.x = cvtpk(s1[8], s1[9]); w.y = cvtpk(s1[10], s1[11]); w.z = cvtpk(s1[12], s1[13]); w.w = cvtpk(s1[14], s1[15]); pk[m][3] = __builtin_bit_cast(bf16x8, w);
#pragma unroll
            for (int db = 0; db < 2; ++db)
#pragma unroll
                for (int ks = 0; ks < 4; ++ks) o[m][db] = __builtin_amdgcn_mfma_f32_32x32x16_bf16(vf[db][ks], pk[m][ks], o[m][db], 0, 0, 0);
            if (FIXM) {
#pragma unroll
                for (int ks = 0; ks < 4; ++ks) lacc[m] = __builtin_amdgcn_mfma_f32_16x16x32_bf16(onesA, pk[m][ks], lacc[m], 0, 0, 0);
            }
        }
        asm volatile("s_waitcnt vmcnt(0)" ::: "memory"); __syncthreads();
    }
#pragma unroll
    for (int m = 0; m < NCOMP; ++m) {
        if (FIXM) { const float a0 = __shfl(lacc[m][0], r & 15), a1 = __shfl(lacc[m][1], r & 15); lsum[m] = ((r >> 4) ? a1 : a0) + l0; }
        else lsum[m] = xhalf_sum(lrun[m]);
    }
#undef FA_STAGE
}

#define FD_SB() __builtin_amdgcn_sched_barrier(0)
#ifndef FD_DUM3
#define FD_DUM3 0
#endif
#ifndef FD_DUM4
#define FD_DUM4 0
#endif
#ifndef FD_DUMOP
#define FD_DUMOP "v_exp_f32 %0, %1"
#endif
#define FD_DUMMY(n_) do { _Pragma("unroll") for (int d_ = 0; d_ < (n_); ++d_) { float dd_; asm volatile(FD_DUMOP : "=v"(dd_) : "v"(negm[0])); } } while (0)
template <bool GRPB>
__device__ __forceinline__ void flash_diff(LAS unsigned char* lds, const int wv, const bf16_t* qrow, const bf16_t* Kb, const bf16_t* Vb, int ntiles, int kb0, const float* kmax,
                                           f32x16 (&o)[2][2], float (&lsum)[2]) {
    const int tid = opaque_tid(wv), lane = tid & 63, r = lane & 31, h = lane >> 5;
    bf16x8 q[2][2];
#pragma unroll
    for (int m = 0; m < 2; ++m)
#pragma unroll
        for (int s = 0; s < 2; ++s) q[m][s] = *(const GAS bf16x8*)(qrow + m * 32 + 16 * s + 8 * h);
    f32x16 negm;
    { float bmax = 0.f;
#pragma unroll
      for (int m = 0; m < 2; ++m) { float qq = 0.f;
#pragma unroll
          for (int s = 0; s < 2; ++s)
#pragma unroll
              for (int j = 0; j < 8; ++j) { const float x = bf2f((unsigned short)q[m][s][j]); qq += x * x; }
          qq = xhalf_sum(qq);
          bmax = fmaxf(bmax, __builtin_amdgcn_sqrtf(qq) * kmax[m]); }
      const float ref = bmax * 1.001f + 1e-3f;
#pragma unroll
      for (int e = 0; e < 16; ++e) negm[e] = -ref; }
    bf16x8 onesA; f32x4 lacc[2];
    { const int g_ = lane >> 4, mr_ = lane & 15; const short v_ = ((mr_ == 0 && !(g_ & 1)) || (mr_ == 1 && (g_ & 1))) ? (short)0x3F80 : (short)0;
      onesA = (bf16x8){v_, v_, v_, v_, v_, v_, v_, v_}; }
#pragma unroll
    for (int m = 0; m < 2; ++m) { lacc[m] = f32x4{0.f, 0.f, 0.f, 0.f}; o[m][0] = f32x16{}; o[m][1] = f32x16{}; }
    const int wid_u = __builtin_amdgcn_readfirstlane(tid >> 6);
    const int srow = tid >> 3, scl = tid & 7;
    const size_t ksoff = (size_t)srow * 64 + ((scl ^ ((srow >> 1) & 7)) << 3);
    const size_t vsoff = (size_t)srow * 64 + ((scl ^ (((srow >> 1) & 1) << 2)) << 3);
    const unsigned lds0 = (unsigned)(uintptr_t)lds + (unsigned)wid_u * 1024u;
#define FD_STAGE(bufsel, krow_) do { const size_t g0_ = (size_t)(krow_) * 64; const unsigned d_ = (unsigned)__builtin_amdgcn_readfirstlane((int)(lds0 + (unsigned)(bufsel) * 16384u)); \
        glds16(Kb + g0_ + ksoff, d_); glds16(Vb + g0_ + vsoff, d_ + 8192u); } while (0)
#define FD_KROW(t_) (((t_) < 4) ? 64 * (t_) : kb0 + 64 * ((t_) - 4))
#define FD_SYNC(it_) do { asm volatile("s_waitcnt vmcnt(0)" ::: "memory"); __syncthreads(); const int tn_ = ((it_) + 2 < ntiles) ? (it_) + 2 : ntiles - 1; FD_STAGE((it_) & 1, FD_KROW(tn_)); } while (0)
#define FD_EXP4(v_, e0_) do { _Pragma("unroll") for (int e_ = (e0_); e_ < (e0_) + 4; ++e_) v_[e_] = fast_exp2(v_[e_]); } while (0)
#define FD_PACK(dst_, v_, e0_) do { u32x4 w_; w_.x = cvtpk(v_[(e0_)], v_[(e0_) + 1]); w_.y = cvtpk(v_[(e0_) + 2], v_[(e0_) + 3]); w_.z = cvtpk(v_[(e0_) + 4], v_[(e0_) + 5]); w_.w = cvtpk(v_[(e0_) + 6], v_[(e0_) + 7]); \
        dst_ = __builtin_bit_cast(bf16x8, w_); } while (0)
#define FD_MFMA(a_, b_, c_) __builtin_amdgcn_mfma_f32_32x32x16_bf16(a_, b_, c_, 0, 0, 0)
#define FD_SUM(m_, b_) lacc[m_] = __builtin_amdgcn_mfma_f32_16x16x32_bf16(onesA, b_, lacc[m_], 0, 0, 0)
    const int kswz = (r >> 1) & 7, kro = r * 128;
    const int q4 = (lane & 15) >> 2, p4 = lane & 3, grp = (lane >> 4) & 1;
    const int vro = 8192 + (4 * h + q4) * 128, vcol = grp * 32 + p4 * 8, vswz = ((q4 >> 1) & 1) << 6;
    FD_STAGE(0, 0);
    asm volatile("s_waitcnt vmcnt(0)" ::: "memory"); __syncthreads();
    FD_STAGE(1, FD_KROW(1));
#pragma nounroll
    for (int it = 0; it < ntiles; ++it) {
        LAS unsigned char* buf = lds + (it & 1) * 16384;
        bf16x8 ka[2][2][2];
#pragma unroll
        for (int m = 0; m < 2; ++m)
#pragma unroll
            for (int s = 0; s < 2; ++s) { const int c = m * 4 + 2 * s + h;
                ka[m][s][0] = *(LAS bf16x8*)(buf + kro + ((c ^ kswz) << 4)); ka[m][s][1] = *(LAS bf16x8*)(buf + 4096 + kro + ((c ^ kswz) << 4)); }
#if FD_SPREAD == 3
        f32x16 s00 = mfma_from_c(ka[0][0][0], q[0][0], negm); s00 = FD_MFMA(ka[0][1][0], q[0][1], s00);
        bf16x8 vf[2][4];
#pragma unroll
        for (int db = 0; db < 2; ++db)
#pragma unroll
            for (int ks = 0; ks < 4; ++ks) { LAS unsigned char* vp = buf + vro + ks * 2048 + ((db * 64 + vcol) ^ vswz);
                const s16x4 lo = vtr(vp), hi = vtr(vp + 1024);
                vf[db][ks] = (bf16x8){lo[0], lo[1], lo[2], lo[3], hi[0], hi[1], hi[2], hi[3]}; }
        FD_SB();
        f32x16 s01 = mfma_from_c(ka[0][0][1], q[0][0], negm); FD_EXP4(s00, 0); FD_SB();
        s01 = FD_MFMA(ka[0][1][1], q[0][1], s01); FD_EXP4(s00, 4); FD_SB();
        f32x16 s10 = mfma_from_c(ka[1][0][0], q[1][0], negm); FD_EXP4(s00, 8); FD_SB();
        f32x16 s11 = mfma_from_c(ka[1][0][1], q[1][0], negm); FD_EXP4(s00, 12); FD_SB();
        bf16x8 pk0[4], pk1[4];
        s10 = FD_MFMA(ka[1][1][0], q[1][1], s10); FD_PACK(pk0[0], s00, 0); FD_EXP4(s01, 0); FD_SB();
        s11 = FD_MFMA(ka[1][1][1], q[1][1], s11); FD_PACK(pk0[1], s00, 8); FD_EXP4(s01, 4); FD_SB();
        o[0][0] = FD_MFMA(vf[0][0], pk0[0], o[0][0]); FD_EXP4(s01, 8); FD_PACK(pk0[2], s01, 0); FD_SB();
        o[0][1] = FD_MFMA(vf[1][0], pk0[0], o[0][1]); FD_EXP4(s01, 12); FD_SB();
        o[0][0] = FD_MFMA(vf[0][1], pk0[1], o[0][0]); FD_PACK(pk0[3], s01, 8); FD_EXP4(s10, 0); FD_SB();
        o[0][1] = FD_MFMA(vf[1][1], pk0[1], o[0][1]); FD_EXP4(s10, 4); FD_SUM(0, pk0[0]); FD_SB();
        o[0][0] = FD_MFMA(vf[0][2], pk0[2], o[0][0]); FD_EXP4(s10, 8); FD_PACK(pk1[0], s10, 0); FD_SB();
        o[0][1] = FD_MFMA(vf[1][2], pk0[2], o[0][1]); FD_EXP4(s10, 12); FD_SUM(0, pk0[1]); FD_SB();
        o[0][0] = FD_MFMA(vf[0][3], pk0[3], o[0][0]); FD_PACK(pk1[1], s10, 8); FD_EXP4(s11, 0); FD_SUM(0, pk0[2]); FD_SB();
        o[0][1] = FD_MFMA(vf[1][3], pk0[3], o[0][1]); FD_EXP4(s11, 4); FD_SUM(0, pk0[3]); FD_SB();
        o[1][0] = FD_MFMA(vf[0][0], pk1[0], o[1][0]); FD_EXP4(s11, 8); FD_PACK(pk1[2], s11, 0); FD_SB();
        o[1][1] = FD_MFMA(vf[1][0], pk1[0], o[1][1]); FD_EXP4(s11, 12); FD_SUM(1, pk1[0]); FD_SB();
        o[1][0] = FD_MFMA(vf[0][1], pk1[1], o[1][0]); FD_PACK(pk1[3], s11, 8); FD_SB();
        o[1][1] = FD_MFMA(vf[1][1], pk1[1], o[1][1]); FD_SUM(1, pk1[1]); FD_SB();
        o[1][0] = FD_MFMA(vf[0][2], pk1[2], o[1][0]); FD_SB(); o[1][1] = FD_MFMA(vf[1][2], pk1[2], o[1][1]); FD_SUM(1, pk1[2]); FD_SB();
        o[1][0] = FD_MFMA(vf[0][3], pk1[3], o[1][0]); FD_SB(); o[1][1] = FD_MFMA(vf[1][3], pk1[3], o[1][1]); FD_SUM(1, pk1[3]); FD_SB();
#else
        f32x16 s00 = mfma_from_c(ka[0][0][0], q[0][0], negm), s01 = mfma_from_c(ka[0][0][1], q[0][0], negm);
        s00 = FD_MFMA(ka[0][1][0], q[0][1], s00); s01 = FD_MFMA(ka[0][1][1], q[0][1], s01);
        bf16x8 vf[2][4];
#pragma unroll
        for (int db = 0; db < 2; ++db)
#pragma unroll
            for (int ks = 0; ks < 4; ++ks) { LAS unsigned char* vp = buf + vro + ks * 2048 + ((db * 64 + vcol) ^ vswz);
                const s16x4 lo = vtr(vp), hi = vtr(vp + 1024);
                vf[db][ks] = (bf16x8){lo[0], lo[1], lo[2], lo[3], hi[0], hi[1], hi[2], hi[3]}; }
        FD_SB();
        f32x16 s10 = mfma_from_c(ka[1][0][0], q[1][0], negm); FD_EXP4(s00, 0); FD_SB();
        f32x16 s11 = mfma_from_c(ka[1][0][1], q[1][0], negm); FD_EXP4(s00, 4); FD_SB();
        s10 = FD_MFMA(ka[1][1][0], q[1][1], s10); FD_EXP4(s00, 8); FD_SB();
        s11 = FD_MFMA(ka[1][1][1], q[1][1], s11); FD_EXP4(s00, 12); FD_SB();
#if FD_SPREAD
        bf16x8 pk0[4], pk1[4];
        FD_PACK(pk0[0], s00, 0); FD_PACK(pk0[1], s00, 8);
        FD_SB();
        if (GRPB) { FD_SYNC(it); FD_SB(); }
        o[0][0] = FD_MFMA(vf[0][0], pk0[0], o[0][0]); FD_EXP4(s01, 0); FD_SB();
        o[0][1] = FD_MFMA(vf[1][0], pk0[0], o[0][1]); FD_EXP4(s01, 4); FD_PACK(pk0[2], s01, 0); FD_SB();
        o[0][0] = FD_MFMA(vf[0][1], pk0[1], o[0][0]); FD_EXP4(s01, 8); FD_SB();
        o[0][1] = FD_MFMA(vf[1][1], pk0[1], o[0][1]); FD_EXP4(s01, 12); FD_PACK(pk0[3], s01, 8); FD_SUM(0, pk0[0]); FD_SB();
        o[0][0] = FD_MFMA(vf[0][2], pk0[2], o[0][0]); FD_EXP4(s10, 0); FD_SB();
        o[0][1] = FD_MFMA(vf[1][2], pk0[2], o[0][1]); FD_EXP4(s10, 4); FD_PACK(pk1[0], s10, 0); FD_SUM(0, pk0[1]); FD_SB();
        o[0][0] = FD_MFMA(vf[0][3], pk0[3], o[0][0]); FD_EXP4(s10, 8); FD_SUM(0, pk0[2]); FD_SB();
        o[0][1] = FD_MFMA(vf[1][3], pk0[3], o[0][1]); FD_EXP4(s10, 12); FD_PACK(pk1[1], s10, 8); FD_SUM(0, pk0[3]); FD_SB();
        o[1][0] = FD_MFMA(vf[0][0], pk1[0], o[1][0]); FD_EXP4(s11, 0); FD_SB();
        o[1][1] = FD_MFMA(vf[1][0], pk1[0], o[1][1]); FD_EXP4(s11, 4); FD_PACK(pk1[2], s11, 0); FD_SUM(1, pk1[0]); FD_SB();
        o[1][0] = FD_MFMA(vf[0][1], pk1[1], o[1][0]); FD_EXP4(s11, 8); FD_SB();
        o[1][1] = FD_MFMA(vf[1][1], pk1[1], o[1][1]); FD_EXP4(s11, 12); FD_PACK(pk1[3], s11, 8); FD_SUM(1, pk1[1]); FD_SB();
        o[1][0] = FD_MFMA(vf[0][2], pk1[2], o[1][0]); FD_SB(); o[1][1] = FD_MFMA(vf[1][2], pk1[2], o[1][1]); FD_SUM(1, pk1[2]); FD_SB();
        o[1][0] = FD_MFMA(vf[0][3], pk1[3], o[1][0]); FD_SB(); o[1][1] = FD_MFMA(vf[1][3], pk1[3], o[1][1]); FD_SUM(1, pk1[3]); FD_SB();
#else
        bf16x8 pk0[4], pk1[4];
        FD_PACK(pk0[0], s00, 0); FD_PACK(pk0[1], s00, 8);
        FD_EXP4(s01, 0); FD_EXP4(s01, 4); FD_EXP4(s01, 8); FD_EXP4(s01, 12);
        FD_PACK(pk0[2], s01, 0); FD_PACK(pk0[3], s01, 8);
        FD_SB();
        if (GRPB) { FD_SYNC(it); FD_SB(); }
        o[0][0] = FD_MFMA(vf[0][0], pk0[0], o[0][0]); FD_EXP4(s10, 0); FD_DUMMY(FD_DUM3); FD_SB();
        o[0][1] = FD_MFMA(vf[1][0], pk0[0], o[0][1]); FD_EXP4(s10, 4); FD_DUMMY(FD_DUM3); FD_SB();
        o[0][0] = FD_MFMA(vf[0][1], pk0[1], o[0][0]); FD_EXP4(s10, 8); FD_PACK(pk1[0], s10, 0); FD_DUMMY(FD_DUM3); FD_SB();
        o[0][1] = FD_MFMA(vf[1][1], pk0[1], o[0][1]); FD_EXP4(s10, 12); FD_SUM(0, pk0[0]); FD_DUMMY(FD_DUM3); FD_SB();
        o[0][0] = FD_MFMA(vf[0][2], pk0[2], o[0][0]); FD_EXP4(s11, 0); FD_PACK(pk1[1], s10, 8); FD_DUMMY(FD_DUM3); FD_SB();
        o[0][1] = FD_MFMA(vf[1][2], pk0[2], o[0][1]); FD_EXP4(s11, 4); FD_SUM(0, pk0[1]); FD_DUMMY(FD_DUM3); FD_SB();
        o[0][0] = FD_MFMA(vf[0][3], pk0[3], o[0][0]); FD_EXP4(s11, 8); FD_PACK(pk1[2], s11, 0); FD_SUM(0, pk0[2]); FD_DUMMY(FD_DUM3); FD_SB();
        o[0][1] = FD_MFMA(vf[1][3], pk0[3], o[0][1]); FD_EXP4(s11, 12); FD_PACK(pk1[3], s11, 8); FD_SUM(0, pk0[3]); FD_DUMMY(FD_DUM3); FD_SB();
#pragma unroll
        for (int ks = 0; ks < 4; ++ks) { o[1][0] = FD_MFMA(vf[0][ks], pk1[ks], o[1][0]); FD_DUMMY(FD_DUM4); FD_SB(); o[1][1] = FD_MFMA(vf[1][ks], pk1[ks], o[1][1]); FD_DUMMY(FD_DUM4); FD_SUM(1, pk1[ks]); FD_SB(); }
#endif
#endif
        FD_SB();
        if (!GRPB) FD_SYNC(it);
    }
    asm volatile("s_waitcnt vmcnt(0)" ::: "memory"); __syncthreads();
#pragma unroll
    for (int m = 0; m < 2; ++m) { const float a0 = __shfl(lacc[m][0], r & 15), a1 = __shfl(lacc[m][1], r & 15); lsum[m] = (r >> 4) ? a1 : a0; }
#undef FD_STAGE
#undef FD_KROW
#undef FD_SYNC
#undef FD_EXP4
#undef FD_PACK
#undef FD_MFMA
#undef FD_SUM
}

__device__ __forceinline__ void store_ot(bf16_t* dst, const f32x16 (&v)[2], int h) {
#pragma unroll
    for (int db = 0; db < 2; ++db)
#pragma unroll
        for (int e4 = 0; e4 < 4; ++e4) { u32x2 w; w.x = cvtpk(v[db][4 * e4], v[db][4 * e4 + 1]); w.y = cvtpk(v[db][4 * e4 + 2], v[db][4 * e4 + 3]);
            *(GAS u32x2*)(dst + 32 * db + 8 * e4 + 4 * h) = w; }
}

struct AttnArgs { const bf16_t *QS, *KS, *VS, *QD, *KD, *VD; bf16_t* MIX; const float *sink, *dlam, *dng; float lam_init; const float* kmax; };

__device__ __forceinline__ void swa_unit(LAS unsigned char* lds, const int wv, const AttnArgs& A, int b, int hk, int jq, bool ctxq) {
    const int tid = opaque_tid(wv), lane = tid & 63, wid = tid >> 6, r = lane & 31, h = lane >> 5;
    const int head = hk * 4 + (wid >> 1), qpos = 64 * jq + 32 * (wid & 1) + r;
    const int row = ctxq ? TL + b * CTX + qpos : b * SEQ + qpos;
    const bf16_t* qrow = A.QS + (size_t)row * 512 + head * 64;
    const bf16_t* Kb = A.KS + (size_t)(b * 2 + hk) * KEYS * 64; const bf16_t* Vb = A.VS + (size_t)(b * 2 + hk) * KEYS * 64;
    int ntiles = 4, kb0 = CTX;
    if (!ctxq) { const int q0 = 64 * jq; int lo = q0 - 128; if (lo < 0) lo = 0; int hi = q0 + 64 + 128; if (hi > SEQ) hi = SEQ; kb0 = CTX + lo; ntiles = 4 + (hi - lo) / 64; }
    f32x16 o[1][2]; float ls[1];
    const float m0 = A.sink[head] * LOG2E;
    float km[1];
#if SWA_FIXM
    { const float* kp = A.kmax + 128 + (size_t)(b * 2 + hk) * 8;
      km[0] = sqrtf(fmaxf(fmaxf(ld_sc1(kp + 0), ld_sc1(kp + 2)), fmaxf(ld_sc1(kp + 4), ld_sc1(kp + 6))) + fmaxf(fmaxf(ld_sc1(kp + 1), ld_sc1(kp + 3)), fmaxf(ld_sc1(kp + 5), ld_sc1(kp + 7)))); }
    if (ctxq) flash_unit<1, 4, false, true>(lds, wv, qrow, Kb, Vb, ntiles, kb0, 0, m0, 1.f, km, o, ls);
    else flash_unit<1, 4, true, true>(lds, wv, qrow, Kb, Vb, ntiles, kb0, qpos, m0, 1.f, km, o, ls);
#else
    km[0] = 0.f;
    if (ctxq) flash_unit<1, 4, false, false>(lds, wv, qrow, Kb, Vb, ntiles, kb0, 0, m0, 1.f, km, o, ls);
    else flash_unit<1, 4, true, false>(lds, wv, qrow, Kb, Vb, ntiles, kb0, qpos, m0, 1.f, km, o, ls);
#endif
    const float inv = 1.f / ls[0];
    o[0][0] = o[0][0] * inv; o[0][1] = o[0][1] * inv;
    store_ot(A.MIX + (size_t)row * 1024 + 256 + head * 64, o[0], h);
}

__device__ __forceinline__ void kmax_unit(LAS unsigned char* lds, const int wv, const bf16_t* KD, float* KMAXP, int b, int hd, int qt, int nh = 4) {
    const int tid = opaque_tid(wv), lane = tid & 63, wid = tid >> 6;
    const bf16_t* Kb = KD + (size_t)(b * nh + hd) * KEYS * 64;
    float m1 = 0.f, m2 = 0.f;
    for (int key = qt * (KEYS / 4) + tid; key < (qt + 1) * (KEYS / 4); key += 512) {
        float n1 = 0.f, n2 = 0.f;
#pragma unroll
        for (int c = 0; c < 8; ++c) { const u32x4 w = *(const GAS u32x4*)(Kb + (size_t)key * 64 + c * 8);
            const float s = bflo(w.x) * bflo(w.x) + bfhi(w.x) * bfhi(w.x) + bflo(w.y) * bflo(w.y) + bfhi(w.y) * bfhi(w.y) + bflo(w.z) * bflo(w.z) + bfhi(w.z) * bfhi(w.z) + bflo(w.w) * bflo(w.w) + bfhi(w.w) * bfhi(w.w);
            if (c < 4) n1 += s; else n2 += s; }
        m1 = fmaxf(m1, n1); m2 = fmaxf(m2, n2);
    }
#pragma unroll
    for (int o = 1; o < 64; o <<= 1) { m1 = fmaxf(m1, __shfl_xor(m1, o)); m2 = fmaxf(m2, __shfl_xor(m2, o)); }
    LAS float* R = (LAS float*)lds;
    if (lane == 0) { R[wid * 2] = m1; R[wid * 2 + 1] = m2; }
    __syncthreads();
    if (tid < 2) { float m = 0.f;
#pragma unroll
        for (int w = 0; w < 8; ++w) m = fmaxf(m, R[w * 2 + tid]);
        st_sc1(KMAXP + ((b * nh + hd) * 4 + qt) * 2 + tid, m); }
    __syncthreads();
}

__device__ __forceinline__ void diff_unit(LAS unsigned char* lds, const int wv, const AttnArgs& A, int b, int hd, int jq, bool ctxq, float lam) {
    const int tid = opaque_tid(wv), lane = tid & 63, wid = tid >> 6, r = lane & 31, h = lane >> 5;
    const int qpos = 256 * jq + 32 * wid + r;
    const int row = ctxq ? TL + b * CTX + qpos : b * SEQ + qpos;
    const bf16_t* qrow = A.QD + (size_t)row * 256 + hd * 64;
    const bf16_t* Kb = A.KD + (size_t)(b * 4 + hd) * KEYS * 64; const bf16_t* Vb = A.VD + (size_t)(b * 4 + hd) * KEYS * 64;
    const int ntiles = ctxq ? 4 : KEYS / 64;
    f32x16 o[2][2]; float ls[2];
    float km[2];
    { const float* kp = A.kmax + (size_t)(b * 4 + hd) * 8; km[0] = sqrtf(fmaxf(fmaxf(ld_sc1(kp + 0), ld_sc1(kp + 2)), fmaxf(ld_sc1(kp + 4), ld_sc1(kp + 6)))); km[1] = sqrtf(fmaxf(fmaxf(ld_sc1(kp + 1), ld_sc1(kp + 3)), fmaxf(ld_sc1(kp + 5), ld_sc1(kp + 7)))); }
#if DIFF_STAG
    if (DIFF_GRPB && __builtin_amdgcn_readfirstlane(wid) >= 4) flash_diff<true>(lds, wv, qrow, Kb, Vb, ntiles, CTX, km, o, ls);
    else flash_diff<false>(lds, wv, qrow, Kb, Vb, ntiles, CTX, km, o, ls);
#else
    flash_unit<2, 2, false, true>(lds, wv, qrow, Kb, Vb, ntiles, CTX, 0, -1e30f, 0.f, km, o, ls);
#endif
    const float i1 = 1.f / ls[0], i2 = lam / ls[1];
    f32x16 v[2]; float ss = 0.f;
#pragma unroll
    for (int db = 0; db < 2; ++db)
#pragma unroll
        for (int e = 0; e < 16; ++e) { const float x = o[0][db][e] * i1 - o[1][db][e] * i2; v[db][e] = x; ss += x * x; }
    ss = xhalf_sum(ss);
    const float rn = rsqrtf(ss * (1.f / 64.f) + LN_EPS) * (1.f - A.lam_init);
#pragma unroll
    for (int db = 0; db < 2; ++db)
#pragma unroll
        for (int e4 = 0; e4 < 4; ++e4) { const f32x4 g = *(const GAS f32x4*)(A.dng + 32 * db + 8 * e4 + 4 * h);
#pragma unroll
            for (int j = 0; j < 4; ++j) v[db][4 * e4 + j] *= rn * g[j]; }
    store_ot(A.MIX + (size_t)row * 1024 + 768 + hd * 64, v, h);
}
__device__ __forceinline__ unsigned cvtpk_h(float lo, float hi) { unsigned r; asm("v_cvt_pk_f16_f32 %0, %1, %2" : "=v"(r) : "v"(lo), "v"(hi)); return r; }
__device__ __forceinline__ float h_lo(unsigned w) { float r; asm("v_cvt_f32_f16 %0, %1" : "=v"(r) : "v"(w)); return r; }
__device__ __forceinline__ float h_hi(unsigned w) { float r; const unsigned s = w >> 16; asm("v_cvt_f32_f16 %0, %1" : "=v"(r) : "v"(s)); return r; }
__device__ __forceinline__ f32x4 h4_to_f4(u32x2 w) { return (f32x4){h_lo(w.x), h_hi(w.x), h_lo(w.y), h_hi(w.y)}; }

struct LruArgs { const bf16_t* LRUX; const bf16_t* GATE; bf16_t* MIX; const bf16_t* GWT; const float *conv_w, *conv_b, *gate_b, *lam; float* CM; float* CARRY; float* AB; };
constexpr int LRU_AA = 0, LRU_BX = 32768, LRU_UF = 65536, LRU_UB = 81920, LRU_UBP = 272, LRU_C8 = LRU_UB + 32 * LRU_UBP, LRU_CAR = LRU_C8 + 1024, LRU_END = LRU_CAR + 1024;
static_assert(LRU_END <= RING_BYTES, "LRU LDS map");

template <int PASS>
__device__ __forceinline__ void lru_phase(LAS unsigned char* lds, const int wv, const LruArgs& A, int bx, int G, int reps) {
    const int tid = opaque_tid(wv), lane = tid & 63, wid = __builtin_amdgcn_readfirstlane(tid >> 6), r = lane & 31, h = lane >> 5;
    LAS float* AA = (LAS float*)(lds + LRU_AA); LAS float* BX = (LAS float*)(lds + LRU_BX); LAS float* UF = (LAS float*)(lds + LRU_UF);
    LAS unsigned char* UB = lds + LRU_UB; LAS unsigned char* XS = lds + LRU_AA;
    LAS float* C8 = (LAS float*)(lds + LRU_C8); LAS float* CAR = (LAS float*)(lds + LRU_CAR);
    const int chh = bx & 1, ch0 = 128 * chh;
    const int k2 = wid & 1, nb = (wid >> 1) & 1, wd = wid >> 2;
    bf16x8 gw0[4], gw1[4];
    {   const bf16_t* g0 = A.GWT + ((size_t)((wd * 2 + 0) * 4 + 2 * chh + k2) * 64 + 32 * nb + r) * 64 + 8 * h;
        const bf16_t* g1 = A.GWT + ((size_t)((wd * 2 + 1) * 4 + 2 * chh + k2) * 64 + 32 * nb + r) * 64 + 8 * h;
#pragma unroll
        for (int s = 0; s < 4; ++s) { gw0[s] = *(const GAS bf16x8*)(g0 + 16 * s); gw1[s] = *(const GAS bf16x8*)(g1 + 16 * s); } }
    if (tid < 256) {
        const int d = tid >> 7, ch = ch0 + (tid & 127);
        {
            const float e = fast_exp2(-LOG2E * A.lam[d * 256 + ch]);
            const float sp = e < 0.0625f ? e * (1.f + e * (-0.5f + e * (0.33333334f + e * (-0.25f + e * 0.2f)))) : 0.6931471805599453f * __builtin_amdgcn_logf(1.f + e);
            C8[tid] = -8.f * sp; }
    }
    const float cw0_ = A.conv_w[ch0 + (tid & 127)], cw1_ = A.conv_w[256 + ch0 + (tid & 127)], cw2_ = A.conv_w[512 + ch0 + (tid & 127)], cw3_ = A.conv_w[768 + ch0 + (tid & 127)], ccb_ = A.conv_b[ch0 + (tid & 127)];
    const float gba_ = A.gate_b[(wd * 2 + 0) * 256 + ch0 + 64 * k2 + 32 * nb + r], gbi_ = A.gate_b[(wd * 2 + 1) * 256 + ch0 + 64 * k2 + 32 * nb + r];
    for (int rep_ = 0; rep_ < reps; ++rep_) {
    u32x4 xr0 = {0u, 0u, 0u, 0u}, xr1 = {0u, 0u, 0u, 0u}; float cnx = 0.f;
#define LRU_FETCH(P) do { const int pb_ = (P) / LRU_NCH, pc_ = (P) % LRU_NCH; const bool ic_ = pc_ < 8; \
        const int sg_ = ic_ ? TL + pb_ * CTX : pb_ * SEQ, sl_ = ic_ ? CTX : SEQ, tt_ = ic_ ? 32 * pc_ : 32 * (pc_ - 8); \
        { const int rr = tid >> 4, c16 = tid & 15, t = tt_ - 1 + rr; xr0 = (u32x4){0u, 0u, 0u, 0u}; if (t >= 0 && t < sl_) xr0 = *(const GAS u32x4*)(A.LRUX + (size_t)(sg_ + t) * 256 + ch0 + c16 * 8); } \
        if (tid < 48) { const int rr = (tid + 512) >> 4, c16 = tid & 15, t = tt_ - 1 + rr; xr1 = (u32x4){0u, 0u, 0u, 0u}; if (t >= 0 && t < sl_) xr1 = *(const GAS u32x4*)(A.LRUX + (size_t)(sg_ + t) * 256 + ch0 + c16 * 8); } \
        if (PASS == 2 && tid < 256) { const int d = tid >> 7, ch = ch0 + (tid & 127); cnx = ld_sc1(A.CARRY + ((size_t)(pb_ * LRU_NCH + pc_) * 2 + d) * 256 + ch); } } while (0)
    const bool active = bx < 2 * (G >> 1);
    if (active && (bx >> 1) < NB * LRU_NCH) LRU_FETCH(bx >> 1);
    for (int p = (bx >> 1); p < NB * LRU_NCH && active; p += (G >> 1)) {
    const int b = p / LRU_NCH, ci = p % LRU_NCH;
    const bool isctx = ci < 8;
    const int seg0 = isctx ? TL + b * CTX : b * SEQ, t0 = isctx ? 32 * ci : 32 * (ci - 8);
    if (PASS == 2 && tid < 256) CAR[tid] = cnx;
    *(LAS u32x4*)(XS + (tid >> 4) * 256 + (tid & 15) * 16) = xr0;
    if (tid < 48) *(LAS u32x4*)(XS + ((tid + 512) >> 4) * 256 + (tid & 15) * 16) = xr1;
    __syncthreads();
    if (p + (G >> 1) < NB * LRU_NCH) LRU_FETCH(p + (G >> 1));
    {
        const int cl = tid & 127, tq = tid >> 7, ch = ch0 + cl;
        const float w0 = cw0_, w1 = cw1_, w2 = cw2_, w3 = cw3_, cb = ccb_; (void)ch;
        const LAS unsigned short* xs = (const LAS unsigned short*)XS + (tq * 8) * 128 + cl;
        float x0 = bf2f(xs[0]), x1 = bf2f(xs[128]), x2 = bf2f(xs[256]);
#pragma unroll
        for (int t = 0; t < 8; ++t) { const float x3 = bf2f(xs[(t + 3) * 128]); const float u = cb + w0 * x0 + w1 * x1 + w2 * x2 + w3 * x3; x0 = x1; x1 = x2; x2 = x3;
            const int tok = tq * 8 + t; UF[tok * 128 + cl] = u; *(LAS unsigned short*)(UB + tok * LRU_UBP + cl * 2) = (unsigned short)(cvtpk(u, 0.f) & 0xffffu); }
    }
    __syncthreads();
    {
        f32x16 acc0 = f32x16{}, acc1 = f32x16{};
#pragma unroll
        for (int s = 0; s < 4; ++s) {
            const bf16x8 a = *(LAS bf16x8*)(UB + r * LRU_UBP + (64 * k2 + 16 * s + 8 * h) * 2);
            acc0 = __builtin_amdgcn_mfma_f32_32x32x16_bf16(a, gw0[s], acc0, 0, 0, 0);
            acc1 = __builtin_amdgcn_mfma_f32_32x32x16_bf16(a, gw1[s], acc1, 0, 0, 0);
        }
        const int cl = 64 * k2 + 32 * nb + r, ch = ch0 + cl;
        const float ba = gba_, bi = gbi_, c8 = C8[wd * 128 + cl]; (void)ch;
        LAS float* aa = AA + wd * 4096; LAS float* bx = BX + wd * 4096;
#pragma unroll
        for (int e = 0; e < 16; ++e) { const int tok = crow(e, h);
            const float rr = sigmoid_f(acc0[e] + ba), ii = sigmoid_f(acc1[e] + bi), la = c8 * rr;
            const float av = fast_exp2(LOG2E * la), x2 = 2.f * la;
            const float ser = -x2 * (1.f + x2 * (0.5f + x2 * (0.16666667f + x2 * (0.041666668f + x2 * 0.0083333338f))));
            const float om = x2 > -0.125f ? ser : 1.f - av * av;
            const float bxv = __builtin_amdgcn_sqrtf(om) * ii * UF[tok * 128 + cl];
            aa[tok * 128 + cl] = av; bx[tok * 128 + cl] = bxv;
            if (PASS == 1) { GAS unsigned* ab = (GAS unsigned*)A.AB + ((size_t)(b * LRU_NCH + ci) * 2 + chh) * 8192 + wd * 4096 + tok * 128 + cl; ab[0] = cvtpk_h(om * fast_rcp(1.f + av), bxv); } }
    }
    __syncthreads();
    if (tid < 256) {
        const int d = tid >> 7, cl = tid & 127;
        LAS float* aa = AA + d * 4096 + cl; LAS float* bx = BX + d * 4096 + cl;
        if (PASS == 1) {
            float ap = 1.f, hh = 0.f;
            if (d == 0) {
#pragma unroll
                for (int t = 0; t < 32; ++t) { const float av = aa[t * 128]; hh = av * hh + bx[t * 128]; ap *= av; }
            } else {
#pragma unroll
                for (int t = 31; t >= 0; --t) { const float av = aa[t * 128]; hh = av * hh + bx[t * 128]; ap *= av; }
            }
            float* cm = A.CM + ((size_t)(b * LRU_NCH + ci) * 2 + d) * 512 + ch0 + cl; st_sc1(cm, ap); st_sc1(cm + 256, hh);
        } else {
            float hh = CAR[tid];
            float av[32], bv[32];
#pragma unroll
            for (int t = 0; t < 32; ++t) { av[t] = aa[t * 128]; bv[t] = bx[t * 128]; }
            if (d == 0) {
#pragma unroll
                for (int t = 0; t < 32; ++t) { hh = av[t] * hh + bv[t]; bv[t] = hh; }
            } else {
#pragma unroll
                for (int t = 31; t >= 0; --t) { hh = av[t] * hh + bv[t]; bv[t] = hh; }
            }
#pragma unroll
            for (int t = 0; t < 32; ++t) bx[t * 128] = bv[t];
        }
    }
    if (PASS == 2) {
        __syncthreads();
        const int t = tid >> 4, cg = tid & 15;
        const size_t row = (size_t)(seg0 + t0 + t);
        const u32x4 gv = *(const GAS u32x4*)(A.GATE + row * 256 + ch0 + cg * 8);
        const f32x4 f0 = *(LAS f32x4*)(BX + t * 128 + cg * 8), f1 = *(LAS f32x4*)(BX + t * 128 + cg * 8 + 4);
        const f32x4 r0 = *(LAS f32x4*)(BX + 4096 + t * 128 + cg * 8), r1 = *(LAS f32x4*)(BX + 4096 + t * 128 + cg * 8 + 4);
        u32x4 w;
        w.x = cvtpk((f0[0] + r0[0]) * bflo(gv.x), (f0[1] + r0[1]) * bfhi(gv.x)); w.y = cvtpk((f0[2] + r0[2]) * bflo(gv.y), (f0[3] + r0[3]) * bfhi(gv.y));
        w.z = cvtpk((f1[0] + r1[0]) * bflo(gv.z), (f1[1] + r1[1]) * bfhi(gv.z)); w.w = cvtpk((f1[2] + r1[2]) * bflo(gv.w), (f1[3] + r1[3]) * bfhi(gv.w));
        *(GAS u32x4*)(A.MIX + row * 1024 + ch0 + cg * 8) = w;
    }
    __syncthreads();
    }
    }
#undef LRU_FETCH
}

__device__ __forceinline__ void lru_phase2c(LAS unsigned char* lds, const int wv, const LruArgs& A, int bx, int G) {
    const int tid = opaque_tid(wv);
    LAS float* BX = (LAS float*)(lds + LRU_BX);
    const int chh = bx & 1, ch0 = 128 * chh;
    const bool active = bx < 2 * (G >> 1);
    unsigned rw[32]; float cn = 0.f; u32x4 gvn = {0u, 0u, 0u, 0u};
#pragma unroll
    for (int t = 0; t < 32; ++t) rw[t] = 0u;
#define LRU2_FETCH(P) do { const int pb_ = (P) / LRU_NCH, pc_ = (P) % LRU_NCH; const bool ic_ = pc_ < 8; const int sg_ = ic_ ? TL + pb_ * CTX : pb_ * SEQ, tt_ = ic_ ? 32 * pc_ : 32 * (pc_ - 8); \
        if (tid < 256) { const int d_ = tid >> 7, cl_ = tid & 127; const float* ab_ = A.AB + ((size_t)(pb_ * LRU_NCH + pc_) * 2 + chh) * 8192 + d_ * 4096 + cl_; \
            cn = ld_sc1(A.CARRY + ((size_t)(pb_ * LRU_NCH + pc_) * 2 + d_) * 256 + ch0 + cl_); \
            _Pragma("unroll") for (int t = 0; t < 32; ++t) rw[t] = __float_as_uint(ld_sc1(ab_ + t * 128)); } \
        gvn = *(const GAS u32x4*)(A.GATE + (size_t)(sg_ + tt_ + (tid >> 4)) * 256 + ch0 + (tid & 15) * 8); } while (0)
    if (active && (bx >> 1) < NB * LRU_NCH) LRU2_FETCH(bx >> 1);
    for (int p = (bx >> 1); p < NB * LRU_NCH && active; p += (G >> 1)) {
        const int b = p / LRU_NCH, ci = p % LRU_NCH;
        const bool isctx = ci < 8;
        const int seg0 = isctx ? TL + b * CTX : b * SEQ, t0 = isctx ? 32 * ci : 32 * (ci - 8);
        float av[32], bv[32]; float hh = cn;
#pragma unroll
        for (int t = 0; t < 32; ++t) { av[t] = 1.f - h_lo(rw[t]); bv[t] = h_hi(rw[t]); }
        const u32x4 gv = gvn;
        if (p + (G >> 1) < NB * LRU_NCH) LRU2_FETCH(p + (G >> 1));
        if (tid < 256) {
            const int d = tid >> 7, cl = tid & 127;
            LAS float* bxl = BX + d * 4096 + cl;
            if (d == 0) {
#pragma unroll
                for (int t = 0; t < 32; ++t) { hh = av[t] * hh + bv[t]; bxl[t * 128] = hh; }
            } else {
#pragma unroll
                for (int t = 31; t >= 0; --t) { hh = av[t] * hh + bv[t]; bxl[t * 128] = hh; }
            }
        }
        __syncthreads();
        {
            const int t = tid >> 4, cg = tid & 15;
            const size_t row = (size_t)(seg0 + t0 + t);
            const f32x4 f0 = *(LAS f32x4*)(BX + t * 128 + cg * 8), f1 = *(LAS f32x4*)(BX + t * 128 + cg * 8 + 4);
            const f32x4 r0 = *(LAS f32x4*)(BX + 4096 + t * 128 + cg * 8), r1 = *(LAS f32x4*)(BX + 4096 + t * 128 + cg * 8 + 4);
            u32x4 w;
            w.x = cvtpk((f0[0] + r0[0]) * bflo(gv.x), (f0[1] + r0[1]) * bfhi(gv.x)); w.y = cvtpk((f0[2] + r0[2]) * bflo(gv.y), (f0[3] + r0[3]) * bfhi(gv.y));
            w.z = cvtpk((f1[0] + r1[0]) * bflo(gv.z), (f1[1] + r1[1]) * bfhi(gv.z)); w.w = cvtpk((f1[2] + r1[2]) * bflo(gv.w), (f1[3] + r1[3]) * bfhi(gv.w));
            *(GAS u32x4*)(A.MIX + row * 1024 + ch0 + cg * 8) = w;
        }
        __syncthreads();
    }
#undef LRU2_FETCH
}

__device__ __forceinline__ void lru_scan_unit(LAS unsigned char* lds, const int wv, const float* CMp, float* CARRY, int b, int d, int cg) {
    const int tid = opaque_tid(wv), c = tid & 31, part = tid >> 5;
    LAS float* PT = (LAS float*)lds;
    float a[9], bb[9];
#pragma unroll
    for (int j = 0; j < 9; ++j) { const int p = part * 9 + j; const int ci = d == 0 ? p : (p < 8 ? 7 - p : 143 - p);
        if (p < LRU_NCH) { const float* cm = CMp + ((size_t)(b * LRU_NCH + ci) * 2 + d) * 512 + cg * 32 + c; a[j] = ld_sc1(cm); bb[j] = ld_sc1(cm + 256); } else { a[j] = 1.f; bb[j] = 0.f; } }
    float ap = 1.f, hp = 0.f;
#pragma unroll
    for (int j = 0; j < 9; ++j) { hp = a[j] * hp + bb[j]; ap *= a[j]; }
    PT[(part * 2 + 0) * 32 + c] = ap; PT[(part * 2 + 1) * 32 + c] = hp;
    __syncthreads();
    float h = 0.f;
    for (int q = 0; q < part; ++q) h = PT[(q * 2 + 0) * 32 + c] * h + PT[(q * 2 + 1) * 32 + c];
#pragma unroll
    for (int j = 0; j < 9; ++j) { const int p = part * 9 + j; const int ci = d == 0 ? p : (p < 8 ? 7 - p : 143 - p);
        if (p < LRU_NCH) st_sc1(CARRY + ((size_t)(b * LRU_NCH + ci) * 2 + d) * 256 + cg * 32 + c, h);
        h = a[j] * h + bb[j]; }
    __syncthreads();
}

struct LnArgs {
    const float *hl, *hc; float *ol, *oc;
    const bf16_t* BR; const int* slot; const float* gts;
    const float* mod; int gate_idx;
    const float* modn; int sh_idx, sc_idx;
    const float *lng, *lnb; bf16_t* U; int nrows;
    const float *rw, *rb; int* toke; float* tokg; int* tokr; unsigned* cnt;
    int u8;
    const float* part; int nsplit;
    unsigned char* ybx;
    int ts[8];
};
constexpr int LN_STASH = 36864;
constexpr int ROWS_PER_WAVE = 9;
__device__ __forceinline__ int wave_row(int gw, int ri, int nrows) { return ri < 8 ? gw * 8 + ri : ((nrows > TL && gw < TC) ? TL + gw : -1); }

template <bool MOE_BR, bool ROUTER, bool HIN16 = false, bool HOUT16 = false, int NSPLIT = 11>
__device__ __forceinline__ void ln_pass(LAS unsigned char* lds, const int wv, const LnArgs& A, int gw) {
    const int tid = opaque_tid(wv), lane = tid & 63, wid = __builtin_amdgcn_readfirstlane(tid >> 6);
    LAS float* RWT = (LAS float*)lds;
    LAS int* WC = (LAS int*)(lds + 32768);
    if (ROUTER) { for (int i = tid; i < 8192; i += 512) { const int k = i >> 3, e = i & 7; RWT[e * 1024 + k] = A.rw[i]; } __syncthreads(); }
    f32x4 g4[4], b4[4];
#pragma unroll
    for (int j = 0; j < 4; ++j) { g4[j] = *(const GAS f32x4*)(A.lng + 4 * lane + 256 * j); b4[j] = *(const GAS f32x4*)(A.lnb + 4 * lane + 256 * j); }
    f32x4 gt[4], sc[4], sh[4]; int curcb = -1;
    int cw0 = 0, cw1 = 0, cw2 = 0, cw3 = 0, cw4 = 0, cw5 = 0, cw6 = 0, cw7 = 0; unsigned long long packed = 0ull;
    const int rbeg = gw * ROWS_PER_WAVE;
    f32x4 nh[4]; u32x2 nh16[4]; u32x2 nb0[4], nb1[4]; float nq0 = 0.f, nq1 = 0.f;
#define LN_LOADROW(R) do { const int r_ = (R); \
        if (HIN16) { const unsigned short* hin_ = r_ < TL ? (const unsigned short*)A.hl + (size_t)r_ * 1024 : (const unsigned short*)A.hc + (size_t)(r_ - TL) * 1024; \
            _Pragma("unroll") for (int j = 0; j < 4; ++j) nh16[j] = *(const GAS u32x2*)(hin_ + 4 * lane + 256 * j); } \
        else { const float* hin_ = r_ < TL ? A.hl + (size_t)r_ * 1024 : A.hc + (size_t)(r_ - TL) * 1024; \
            _Pragma("unroll") for (int j = 0; j < 4; ++j) nh[j] = *(const GAS f32x4*)(hin_ + 4 * lane + 256 * j); } \
        if (MOE_BR) { const int e0_ = ((const GAS int*)A.toke)[r_ * 2], e1_ = ((const GAS int*)A.toke)[r_ * 2 + 1]; int b0_ = 0, b1_ = 0; _Pragma("unroll") for (int e_ = 1; e_ < 8; ++e_) { b0_ = (e0_ == e_) ? A.ts[e_] : b0_; b1_ = (e1_ == e_) ? A.ts[e_] : b1_; } \
            const int s0_ = b0_ * 256 + ((const GAS int*)A.tokr)[r_ * 2], s1_ = b1_ * 256 + ((const GAS int*)A.tokr)[r_ * 2 + 1]; nq0 = ((const GAS float*)A.gts)[r_ * 2]; nq1 = ((const GAS float*)A.gts)[r_ * 2 + 1]; \
            _Pragma("unroll") for (int j = 0; j < 4; ++j) { nb0[j] = *(const GAS u32x2*)(A.BR + (size_t)s0_ * 1024 + 4 * lane + 256 * j); nb1[j] = *(const GAS u32x2*)(A.BR + (size_t)s1_ * 1024 + 4 * lane + 256 * j); } } \
        else { _Pragma("unroll") for (int j = 0; j < 4; ++j) nb0[j] = *(const GAS u32x2*)(A.BR + (size_t)r_ * 1024 + 4 * lane + 256 * j); } } while (0)
    if (wave_row(gw, 0, A.nrows) >= 0 && wave_row(gw, 0, A.nrows) < A.nrows) LN_LOADROW(wave_row(gw, 0, A.nrows));
    for (int ri = 0; ri < ROWS_PER_WAVE; ++ri) {
        const int row = wave_row(gw, ri, A.nrows); if (row < 0 || row >= A.nrows) break;
        const bool lat = row < TL; const int cb = lat ? (row >> 12) : 4;
        if (cb != curcb) { curcb = cb;
#pragma unroll
            for (int j = 0; j < 4; ++j) { gt[j] = *(const GAS f32x4*)(A.mod + (size_t)(cb * 6 + A.gate_idx) * 1024 + 4 * lane + 256 * j);
                if (A.modn) { sc[j] = *(const GAS f32x4*)(A.modn + (size_t)(cb * 6 + A.sc_idx) * 1024 + 4 * lane + 256 * j); sh[j] = *(const GAS f32x4*)(A.modn + (size_t)(cb * 6 + A.sh_idx) * 1024 + 4 * lane + 256 * j); } } }
        unsigned char* hout = lat ? (unsigned char*)A.ol + (size_t)row * (HOUT16 ? 2048 : 4096) : (unsigned char*)A.oc + (size_t)(row - TL) * (HOUT16 ? 2048 : 4096);
        f32x4 v[4];
        if (HIN16) {
#pragma unroll
            for (int j = 0; j < 4; ++j) nh[j] = h4_to_f4(nh16[j]);
        }
        if (MOE_BR) {
#pragma unroll
            for (int j = 0; j < 4; ++j) { const u32x2 w0 = nb0[j], w1 = nb1[j]; const float q0 = nq0, q1 = nq1;
                f32x4 f; f[0] = q0 * bflo(w0.x) + q1 * bflo(w1.x); f[1] = q0 * bfhi(w0.x) + q1 * bfhi(w1.x); f[2] = q0 * bflo(w0.y) + q1 * bflo(w1.y); f[3] = q0 * bfhi(w0.y) + q1 * bfhi(w1.y);
                v[j] = nh[j] * ALPHA + gt[j] * f; }
        } else if (A.part != nullptr && !lat) {
#pragma unroll
            for (int j = 0; j < 4; ++j) { u32x2 pv[NSPLIT];
#pragma unroll
                for (int s = 0; s < NSPLIT; ++s) pv[s] = *(const GAS u32x2*)((const bf16_t*)A.part + ((size_t)s * 1024 + (row - TL)) * 1024 + 4 * lane + 256 * j);
                f32x4 f = (f32x4){bflo(pv[0].x), bfhi(pv[0].x), bflo(pv[0].y), bfhi(pv[0].y)};
#pragma unroll
                for (int s = 1; s < NSPLIT; ++s) f = f + (f32x4){bflo(pv[s].x), bfhi(pv[s].x), bflo(pv[s].y), bfhi(pv[s].y)};
                v[j] = nh[j] * ALPHA + gt[j] * f; }
        } else {
#pragma unroll
            for (int j = 0; j < 4; ++j) { const u32x2 w0 = nb0[j];
                f32x4 f; f[0] = bflo(w0.x); f[1] = bfhi(w0.x); f[2] = bflo(w0.y); f[3] = bfhi(w0.y);
                v[j] = nh[j] * ALPHA + gt[j] * f; }
        }
        { const int nr_ = ri + 1 < ROWS_PER_WAVE ? wave_row(gw, ri + 1, A.nrows) : -1; if (nr_ >= 0 && nr_ < A.nrows) LN_LOADROW(nr_); }
        float s = 0.f;
#pragma unroll
        for (int j = 0; j < 4; ++j) s += (v[j][0] + v[j][1]) + (v[j][2] + v[j][3]);
        const float mean = wave_sum(s) * (1.f / 1024.f); float s2 = 0.f;
#pragma unroll
        for (int j = 0; j < 4; ++j) { v[j] = v[j] - mean; s2 += (v[j][0] * v[j][0] + v[j][1] * v[j][1]) + (v[j][2] * v[j][2] + v[j][3] * v[j][3]); }
        const float rstd = rsqrtf(wave_sum(s2) * (1.f / 1024.f) + LN_EPS);
#pragma unroll
        for (int j = 0; j < 4; ++j) { v[j] = v[j] * rstd * g4[j] + b4[j];
            if (HOUT16) { u32x2 w; w.x = cvtpk_h(v[j][0], v[j][1]); w.y = cvtpk_h(v[j][2], v[j][3]); *(GAS u32x2*)(hout + 8 * lane + 512 * j) = w; }
            else st16f(hout + 16 * lane + 1024 * j, v[j]); }
        if (A.modn) {
#pragma unroll
            for (int j = 0; j < 4; ++j) { v[j] = v[j] * (sc[j] + 1.f) + sh[j];
                if (ROUTER) *(LAS unsigned*)(lds + LN_STASH + (wid * ROWS_PER_WAVE + ri) * 1024 + 4 * lane + 256 * j) = cvt4_fp8(v[j][0] * F8_SU, v[j][1] * F8_SU, v[j][2] * F8_SU, v[j][3] * F8_SU);
                else if (A.u8) *(GAS unsigned*)((unsigned char*)A.U + (size_t)row * 1024 + 4 * lane + 256 * j) = cvt4_fp8(v[j][0] * F8_SU, v[j][1] * F8_SU, v[j][2] * F8_SU, v[j][3] * F8_SU);
                else { u32x2 w; w.x = cvtpk(v[j][0], v[j][1]); w.y = cvtpk(v[j][2], v[j][3]); *(GAS u32x2*)(A.U + (size_t)row * 1024 + 4 * lane + 256 * j) = w; } }
        }
        if (ROUTER) {
            float lg[8];
#pragma unroll
            for (int e = 0; e < 8; ++e) { float p = 0.f;
#pragma unroll
                for (int j = 0; j < 4; ++j) { const f32x4 w = *(LAS f32x4*)(RWT + e * 1024 + 4 * lane + 256 * j); p += (v[j][0] * w[0] + v[j][1] * w[1]) + (v[j][2] * w[2] + v[j][3] * w[3]); }
                lg[e] = wave_sum(p) + A.rb[e]; }
            float v1 = lg[0]; int i1 = 0;
#pragma unroll
            for (int e = 1; e < 8; ++e) if (lg[e] > v1) { v1 = lg[e]; i1 = e; }
            float v2 = -3.0e38f; int i2 = 0;
#pragma unroll
            for (int e = 0; e < 8; ++e) if (e != i1 && lg[e] > v2) { v2 = lg[e]; i2 = e; }
            const float q1 = fast_rcp(1.f + fast_exp2(LOG2E * (v2 - v1))), q2 = 1.f - q1;
            if (lane == 0) { ((GAS int*)A.toke)[row * 2] = i1; ((GAS int*)A.toke)[row * 2 + 1] = i2; ((GAS float*)A.tokg)[row * 2] = q1; ((GAS float*)A.tokg)[row * 2 + 1] = q2; }
            i1 = __builtin_amdgcn_readfirstlane(i1); i2 = __builtin_amdgcn_readfirstlane(i2);
            cw0 += (i1 == 0) + (i2 == 0); cw1 += (i1 == 1) + (i2 == 1); cw2 += (i1 == 2) + (i2 == 2); cw3 += (i1 == 3) + (i2 == 3);
            cw4 += (i1 == 4) + (i2 == 4); cw5 += (i1 == 5) + (i2 == 5); cw6 += (i1 == 6) + (i2 == 6); cw7 += (i1 == 7) + (i2 == 7);
            packed |= (unsigned long long)(i1 | (i2 << 3)) << (6 * ri);
        }
    }
    if (ROUTER) {
        if (lane < 8) { const int c = lane == 0 ? cw0 : lane == 1 ? cw1 : lane == 2 ? cw2 : lane == 3 ? cw3 : lane == 4 ? cw4 : lane == 5 ? cw5 : lane == 6 ? cw6 : cw7; WC[wid * 8 + lane] = c; }
        __syncthreads();
        if (tid < 8) { int tot = 0;
#pragma unroll
            for (int w = 0; w < 8; ++w) tot += WC[w * 8 + tid];
            WC[64 + tid] = tot ? (int)atomicAdd(A.cnt + tid, (unsigned)tot) : 0; }
        __syncthreads();
        int off[8];
#pragma unroll
        for (int e = 0; e < 8; ++e) { int o = WC[64 + e];
#pragma unroll
            for (int w = 0; w < 8; ++w) o += (w < wid) ? WC[w * 8 + e] : 0;
            off[e] = __builtin_amdgcn_readfirstlane(o); }
        for (int ri = 0; ri < ROWS_PER_WAVE; ++ri) {
            const int row = wave_row(gw, ri, A.nrows); if (row < 0 || row >= A.nrows) break;
            const int pr = (int)((packed >> (6 * ri)) & 63ull), i1 = pr & 7, i2 = pr >> 3; int r1 = 0, r2 = 0;
#pragma unroll
            for (int e = 0; e < 8; ++e) { if (i1 == e) { r1 = off[e]; off[e] += 1; } }
#pragma unroll
            for (int e = 0; e < 8; ++e) { if (i2 == e) { r2 = off[e]; off[e] += 1; } }
            if (lane == 0) { ((GAS int*)A.tokr)[row * 2] = r1; ((GAS int*)A.tokr)[row * 2 + 1] = r2; }
            const u32x4 sr = *(LAS u32x4*)(lds + LN_STASH + (wid * ROWS_PER_WAVE + ri) * 1024 + 16 * lane);
            *(GAS u32x4*)(A.ybx + ((size_t)i1 * T + r1) * 1024 + 16 * lane) = sr; *(GAS u32x4*)(A.ybx + ((size_t)i2 * T + r2) * 1024 + 16 * lane) = sr;
        }
    }
}

struct ExpTab { int ts[9]; };
__device__ __forceinline__ void exp_table(const unsigned* cnt, int (&ts)[9]) {
    int acc = 0;
#pragma unroll
    for (int e = 0; e < 8; ++e) { ts[e] = acc; const int c = __builtin_amdgcn_readfirstlane((int)__hip_atomic_load(cnt + e, __ATOMIC_RELAXED, __HIP_MEMORY_SCOPE_AGENT)); acc += (c + 255) >> 8; }
    ts[8] = acc;
}
__device__ __forceinline__ void route_gather(const int wv, const unsigned* cnt, const int* toke, const int* tokr, int* toks, const bf16_t* U, bf16_t* YB, int nrows, int gw) {
    const int lane = opaque_tid(wv) & 63;
    int ts[9]; exp_table(cnt, ts);
    const int rbeg = gw * ROWS_PER_WAVE;
#pragma unroll 3
    for (int ri = 0; ri < ROWS_PER_WAVE; ++ri) {
        const int row = wave_row(gw, ri, nrows); if (row < 0 || row >= nrows) break;
        const int e0 = toke[row * 2], e1 = toke[row * 2 + 1]; int b0 = 0, b1 = 0;
#pragma unroll
        for (int e = 0; e < 8; ++e) { if (e0 == e) b0 = ts[e]; if (e1 == e) b1 = ts[e]; }
        const int s0 = b0 * 256 + tokr[row * 2], s1 = b1 * 256 + tokr[row * 2 + 1];
        if (lane == 0) { toks[row * 2] = s0; toks[row * 2 + 1] = s1; }
        const u32x4 a = *(const GAS u32x4*)(U + (size_t)row * 1024 + lane * 8), c = *(const GAS u32x4*)(U + (size_t)row * 1024 + 512 + lane * 8);
        u32x2 a8, c8;
        a8.x = cvt4_fp8(bflo(a.x) * F8_SU, bfhi(a.x) * F8_SU, bflo(a.y) * F8_SU, bfhi(a.y) * F8_SU); a8.y = cvt4_fp8(bflo(a.z) * F8_SU, bfhi(a.z) * F8_SU, bflo(a.w) * F8_SU, bfhi(a.w) * F8_SU);
        c8.x = cvt4_fp8(bflo(c.x) * F8_SU, bfhi(c.x) * F8_SU, bflo(c.y) * F8_SU, bfhi(c.y) * F8_SU); c8.y = cvt4_fp8(bflo(c.z) * F8_SU, bfhi(c.z) * F8_SU, bflo(c.w) * F8_SU, bfhi(c.w) * F8_SU);
        unsigned char* Y8 = (unsigned char*)YB;
        *(GAS u32x2*)(Y8 + (size_t)s0 * 1024 + lane * 8) = a8; *(GAS u32x2*)(Y8 + (size_t)s0 * 1024 + 512 + lane * 8) = c8;
        *(GAS u32x2*)(Y8 + (size_t)s1 * 1024 + lane * 8) = a8; *(GAS u32x2*)(Y8 + (size_t)s1 * 1024 + 512 + lane * 8) = c8;
    }
}

__device__ __forceinline__ int rowmap(int kind, int n) {
    if (kind == 0) return n;
    if (kind == 2) return ((n >> 7) << 8) + (n & 127);
    if (kind == 3) return ((n >> 7) << 8) + 128 + (n & 127);
    if (n < 512) return n;
    if (n < 1152) { const int d = n & 63; return (n & ~63) + (d < 32 ? 2 * d : 2 * (d - 32) + 1); }
    if (n < 1280) return n;
    if (n < 1792) { const int d = n & 31; return (n & ~31) + (d < 16 ? 2 * d : 2 * (d - 16) + 1); }
    return n;
}
__device__ __forceinline__ void transpose_item(const float* W, int K, int N, bf16_t* WT, int kind, LAS float* scr, int item, int lane, float f8s = 0.f) {
    const int nblk = N / 32, kb = item / nblk, nb = item % nblk, k0 = 64 * kb, n0 = 32 * nb;
    {
        f32x4 v[8]; const float* wp = W + (size_t)(k0 + (lane >> 3)) * N + n0 + 4 * (lane & 7);
#pragma unroll
        for (int i = 0; i < 8; ++i) v[i] = *(const GAS f32x4*)(wp + (size_t)(8 * i) * N);
#pragma unroll
        for (int i = 0; i < 8; ++i) { LAS float* d = scr + (8 * i + (lane >> 3)) * 33 + 4 * (lane & 7); d[0] = v[i][0]; d[1] = v[i][1]; d[2] = v[i][2]; d[3] = v[i][3]; }
    }
    asm volatile("s_waitcnt lgkmcnt(0)" ::: "memory");
    const int c = lane & 7;
#pragma unroll
    for (int j = 0; j < 4; ++j) { const int n = (lane >> 3) + 8 * j; const LAS float* s = scr + (8 * c) * 33 + n;
        if (f8s != 0.f) { u32x2 o; o.x = cvt4_fp8(s[0 * 33] * f8s, s[1 * 33] * f8s, s[2 * 33] * f8s, s[3 * 33] * f8s); o.y = cvt4_fp8(s[4 * 33] * f8s, s[5 * 33] * f8s, s[6 * 33] * f8s, s[7 * 33] * f8s);
            *(GAS u32x2*)((unsigned char*)WT + (size_t)rowmap(kind, n0 + n) * K + k0 + 8 * c) = o; }
        else {
        u32x4 o; o.x = cvtpk(s[0 * 33], s[1 * 33]); o.y = cvtpk(s[2 * 33], s[3 * 33]); o.z = cvtpk(s[4 * 33], s[5 * 33]); o.w = cvtpk(s[6 * 33], s[7 * 33]);
        *(GAS u32x4*)(WT + (size_t)rowmap(kind, n0 + n) * K + k0 + 8 * c) = o; } }
    asm volatile("s_waitcnt lgkmcnt(0)" ::: "memory");
}

#ifndef PHMASK
#define PHMASK 0xFFFFF
#endif
#define PHON(n) (((PHMASK) >> (n)) & 1)
#ifndef REP_G
#define REP_G 1
#endif
#ifndef REP_DIFF
#define REP_DIFF 1
#endif
#ifndef REP_SWA
#define REP_SWA 1
#endif
#ifndef REP_LRU
#define REP_LRU 1
#endif
#ifndef REP_P0
#define REP_P0 1
#endif
#ifndef REP_G1
#define REP_G1 REP_G
#endif
#ifndef REP_G2
#define REP_G2 REP_G
#endif
#ifndef REP_G3
#define REP_G3 REP_G
#endif
#ifndef REP_G4
#define REP_G4 REP_G
#endif
#ifndef G3_ALIGN
#define G3_ALIGN true
#endif
#ifndef REP_MISC
#define REP_MISC 1
#endif
#ifndef REP_N1L0
#define REP_N1L0 1
#endif
struct Args { const float* in[26]; float* out; unsigned char* ws; int ph_lo, ph_hi; };
constexpr int PH_P0 = 0, PH_P0B = 1, PH_LAYER0 = 2, PH_PER_LAYER = 8, N_PHASES = PH_LAYER0 + DEPTH * PH_PER_LAYER;
enum { LP_G1 = 0, LP_AT, LP_G2, LP_N1, LP_R1, LP_G3, LP_G4, LP_N2 };
enum { I_X = 0, I_C, I_CTX, I_CCTX, I_ADAW, I_ADAB, I_WIN, I_WOUT, I_CONVW, I_CONVB, I_GATEW, I_GATEB, I_LAM, I_SINK, I_DLAM, I_DNG, I_LNG, I_LNB, I_F1, I_F3, I_F2, I_RW, I_RB, I_M1, I_M3, I_M2 };

#define MOD ((float*)(wsp + WS_MOD))
#define COS64 ((float*)(wsp + WS_COS64))
#define SIN64 ((float*)(wsp + WS_SIN64))
#define COS32 ((float*)(wsp + WS_COS32))
#define SIN32 ((float*)(wsp + WS_SIN32))
#define GWT ((bf16_t*)(wsp + WS_GWT))
#define CM ((float*)(wsp + WS_CM))
#define CARRY ((float*)(wsp + WS_CARRY))
#define LRUAB ((float*)(wsp + WS_AB))
#define KMAX ((float*)(wsp + WS_KMAX))
#define TOKE ((int*)(wsp + WS_TOKE))
#define TOKG ((float*)(wsp + WS_TOKG))
#define TOKR ((int*)(wsp + WS_TOKR))
#define TOKS ((int*)(wsp + WS_TOKS))
#define WIN ((bf16_t*)(wsp + WS_WIN))
#define WOUT ((bf16_t*)(wsp + WS_WOUT))
#define F13 ((bf16_t*)(wsp + WS_F13))
#define F2 ((bf16_t*)(wsp + WS_F2))
#define M13 ((bf16_t*)(wsp + WS_M13))
#define M2 ((bf16_t*)(wsp + WS_M2))
#define H ((float*)(wsp + WS_H))
#ifndef RES16
#define RES16 1
#endif
#define H16C ((float*)(wsp + WS_H + (size_t)TL * 1024 * (RES16 == 1 ? 2 : 4)))
#define HX ((float*)(wsp + ((size_t)740 << 20)))
#define HXC ((float*)(wsp + ((size_t)740 << 20) + (size_t)TL * 2048))
#define U ((bf16_t*)(wsp + WS_U))
#define LRUX ((bf16_t*)(wsp + WS_LRUX))
#define GATE ((bf16_t*)(wsp + WS_GATE))
#define QS ((bf16_t*)(wsp + WS_QS))
#define KS ((bf16_t*)(wsp + WS_KS))
#define VS ((bf16_t*)(wsp + WS_VS))
#define QD ((bf16_t*)(wsp + WS_QD))
#define KD ((bf16_t*)(wsp + WS_KD))
#define VD ((bf16_t*)(wsp + WS_VD))
#define MIX ((bf16_t*)(wsp + WS_MIX))
#define MB ((bf16_t*)(wsp + WS_MB))
#define YB ((bf16_t*)(wsp + WS_YB))
#define YBX ((unsigned char*)(wsp + WS_YBX))
#define HID ((bf16_t*)(wsp + WS_HID))
#define PART2 ((float*)(wsp + WS_PART2))
#define PART4 ((float*)(wsp + WS_PART4))
#define CTLW ((unsigned*)(wsp + WS_CTL))
#define LAUNDER_WS() unsigned char* wsp = ws; asm volatile("" : "+s"(wsp))
#define IN(k) (lo <= (k) && (k) < hi)
#ifndef REP_BAR
#define REP_BAR 1
#endif
#define SEAM(k) do { if (IN(k) && IN((k) + 1)) for (int rb_ = 0; rb_ < REP_BAR; ++rb_) xcd_barrier(bar); } while (0)
#ifndef DEFER_W
#define DEFER_W 1
#endif
#ifndef DEFER_M
#define DEFER_M 6
#endif
__device__ __forceinline__ void ffn_item(const Args& args, unsigned char* wsp, int mi, int item, LAS float* scr, int lane) {
    const int grp = mi / 3, which = mi % 3;
    const float* src; unsigned char* dst;
    if (grp < 2) { src = args.in[which == 0 ? I_F1 : which == 1 ? I_F3 : I_F2] + (size_t)grp * 1024 * FF; dst = (unsigned char*)(which == 2 ? F2 : F13) + (size_t)grp * (which == 2 ? 1 : 2) * FF * 1024; }
    else { const int je = grp - 2; src = args.in[which == 0 ? I_M1 : which == 1 ? I_M3 : I_M2] + (size_t)je * 1024 * FF; dst = (unsigned char*)(which == 2 ? M2 : M13) + (size_t)je * (which == 2 ? 1 : 2) * FF * 1024; }
    const float f8s = which == 2 ? F8_SW2 : F8_SW13;
    if (which == 2) transpose_item(src, FF, 1024, (bf16_t*)dst, 0, scr, item, lane, f8s);
    else transpose_item(src, 1024, FF, (bf16_t*)dst, which == 0 ? 2 : 3, scr, item, lane, f8s);
}
constexpr int I_FFI = 16 * 88;
template <int layer>
__device__ __forceinline__ void layer_body(LAS unsigned char* lds, const int wv, const Args& args, unsigned char* ws, const int G, const int bx, const int gw, const int lo, const int hi, const XcdBarrier& bar) {
        const int pb = PH_LAYER0 + layer * PH_PER_LAYER;
        if (hi <= pb || lo >= pb + PH_PER_LAYER) return;
        const bool last = layer == DEPTH - 1, moe = (layer & 1) != 0; const int j2 = layer >> 1;
        const int nrows = last ? TL : T, nMt = nrows / 256;
#define modl (MOD + (size_t)layer * 5 * 6144)
#define cnt (CTLW + CW_CNT + j2 * 64)
#define hl_in (layer == 0 ? args.in[I_X] : H)
#define hc_in (layer == 0 ? args.in[I_CTX] : H16C)

        if (PHON(2) && IN(pb + LP_G1)) { LAUNDER_WS();
            pg8::Gemm g{U, WIN + (size_t)layer * INC * 1024, 1024}; int tsd[9] = {0, 0x7fffffff, 0x7fffffff, 0x7fffffff, 0x7fffffff, 0x7fffffff, 0x7fffffff, 0x7fffffff, 0}; pg8::TileSched S; S.build(lds, wv, T / 256, INC / 256, G, bx, INC / 256, tsd, 16, 0, 1, 0, true);
            pg8::EpiIn E{LRUX, GATE, QS, KS, VS, QD, KD, VD, COS64, SIN64, COS32, SIN32};
            for (int rep_ = 0; rep_ < REP_G1; ++rep_) { pg8::gemm_phase<pg8::EpiIn, pg8::TileSched, true, true>(lds, wv, g, S, E);
                const pg8::TileSched SH = S.listB(); pg8::gemm_phase<pg8::EpiIn, pg8::TileSched, true, true, true>(lds, wv, g, SH, E); }
#if DEFER_W
            {
                const int nb = (G == 256) ? 64 : 0;
                if (bx >= nb) { __syncthreads(); LAS float* scr = (LAS float*)(lds + wv * 16384); const int ln = opaque_tid(wv) & 63;
                    const int mi0 = (layer < 2 ? 6 : 30) + (layer & 1) * DEFER_M;
                    for (int it = (bx - nb) * 8 + wv; it < DEFER_M * I_FFI; it += (G - nb) * 8) ffn_item(args, wsp, mi0 + it / I_FFI, it % I_FFI, scr, ln); }
            }
#endif
        }
        SEAM(pb + LP_G1);
#define LRU_BX(b_) (b_)
#define LRU_ARGS LruArgs LA{LRUX, GATE, MIX, GWT + (size_t)layer * 16 * 4096, args.in[I_CONVW] + layer * 1024, args.in[I_CONVB] + layer * 256, args.in[I_GATEB] + layer * 1024, args.in[I_LAM] + layer * 512, CM, CARRY, LRUAB}
        if (IN(pb + LP_AT)) { LAUNDER_WS(); LRU_ARGS;
            unsigned* ho = CTLW + CW_HO + layer * 3 * 64;
            { bool did = false; for (int u = G - 1 - bx; u < 64 + 32 * SWA_FIXM; u += G) { if (u < 64) kmax_unit(lds, wv, KD, KMAX, u >> 4, (u >> 2) & 3, u & 3); else kmax_unit(lds, wv, KS, KMAX + 128, (u - 64) >> 3, ((u - 64) >> 2) & 1, u & 3, 2); did = true; }
              if (did) ho_signal(ho + 0, wv); }
            if (PHON(3)) lru_phase<1>(lds, wv, LA, LRU_BX(bx), G, REP_LRU);
            ho_signal(ho + 64, wv);
            const float lam_init = layer == 0 ? 0.2f : layer == 1 ? 0.35550906759096926f : layer == 2 ? 0.47071301834358416f : 0.5560582041556405f;
            AttnArgs AA{QS, KS, VS, QD, KD, VD, MIX, args.in[I_SINK] + layer * 8, args.in[I_DLAM] + layer * 128, args.in[I_DNG] + layer * 64, lam_init, KMAX};
            float lam;
            { const int ln = opaque_tid(wv) & 63; const float* dl = AA.dlam; float p = 0.f, q = 0.f; if (ln < 32) { p = dl[ln] * dl[32 + ln]; q = dl[64 + ln] * dl[96 + ln]; }
              p = wave_sum(p); q = wave_sum(q); lam = __uint_as_float(__builtin_amdgcn_readfirstlane(__float_as_uint(fast_exp2(LOG2E * p) - fast_exp2(LOG2E * q) + lam_init))); }
            ho_wait(ho + 0, (unsigned)(G >= 64 + 32 * SWA_FIXM ? 64 + 32 * SWA_FIXM : G), wv);
            if (PHON(5)) for (int rep_ = 0; rep_ < REP_DIFF; ++rep_) for (int u = bx; u < 256; u += G) { const int x8 = u & 7, idx = u >> 3, bh = 2 * x8 + (idx >> 4), jq = idx & 15; diff_unit(lds, wv, AA, bh >> 2, bh & 3, jq, false, lam); }
            { bool did = false; for (int u = bx; u < NB * 2 * 8; u += G) { if (!did) ho_wait(ho + 64, (unsigned)G, wv); lru_scan_unit(lds, wv, CM, CARRY, u >> 4, (u >> 3) & 1, u & 7); did = true; }
              if (did) ho_signal(ho + 128, wv); }
            if (PHON(6)) for (int rep_ = 0; rep_ < REP_SWA; ++rep_) for (int u = bx; u < 512; u += G) { const int bhk = u & 7, jq = u >> 3; swa_unit(lds, wv, AA, bhk >> 1, bhk & 1, jq, false); }
            if (!last) {
                if (PHON(6)) for (int u = G - 1 - bx; u < 32; u += G) { const int bhk = u & 7, jq = u >> 3; swa_unit(lds, wv, AA, bhk >> 1, bhk & 1, jq, true); }
                if (PHON(5)) for (int u = G - 33 - bx; u < 16; u += G) { if (u >= 0) diff_unit(lds, wv, AA, u >> 2, u & 3, 0, true, lam); }
            }
            ho_wait(ho + 128, 64u, wv);
            if (PHON(4)) lru_phase2c(lds, wv, LA, LRU_BX(bx), G);
        }
        SEAM(pb + LP_AT);
        if (PHON(7) && IN(pb + LP_G2)) { LAUNDER_WS();
            pg8::Gemm g{MIX, WOUT + (size_t)layer * 1024 * 1024, 1024}; int tsd[9] = {0, 0x7fffffff, 0x7fffffff, 0x7fffffff, 0x7fffffff, 0x7fffffff, 0x7fffffff, 0x7fffffff, 0}; pg8::TileSched S; S.build(lds, wv, TL / 256, 4, G, bx, 4, tsd, 16, nMt - TL / 256, 8, 2);
            pg8::EpiPlain E{MB, 1024, PART2, TL, 1.f};
            for (int rep_ = 0; rep_ < REP_G2; ++rep_) pg8::gemm_phase<pg8::EpiPlain, pg8::TileSched, true, true>(lds, wv, g, S, E);
        }
        SEAM(pb + LP_G2);
        if (PHON(8) && IN(pb + LP_N1)) { LAUNDER_WS();
            LnArgs N{hl_in, hc_in, (RES16 == 2 && layer == 0) ? HX : H, (RES16 == 2 && layer == 0) ? HXC : H16C, MB, nullptr, nullptr, modl, 2, modl, 3, 4,
                     args.in[I_LNG] + (layer * 2 + 0) * 1024, args.in[I_LNB] + (layer * 2 + 0) * 1024, U, nrows,
                     args.in[I_RW] + (size_t)j2 * 8192, args.in[I_RB] + j2 * 8, TOKE, TOKG, TOKR, cnt, moe ? 0 : 1, PART2, 8, YBX, {0, 0, 0, 0, 0, 0, 0, 0}};
            if (moe) ln_pass<false, true, (RES16 == 1 && layer != 0), (RES16 == 1), 8>(lds, wv, N, gw); else ln_pass<false, false, (RES16 == 1 && layer != 0), (RES16 == 1 || (RES16 == 2 && layer == 0)), 8>(lds, wv, N, gw);
        }
        SEAM(pb + LP_N1);
#define MAKE_TS() int ts[9]; if (moe) exp_table(cnt, ts); else { ts[0] = 0; _Pragma("unroll") for (int e = 1; e < 9; ++e) ts[e] = 0x7fffffff; ts[8] = nMt; } const int nT = ts[8]
        if (PHON(10) && IN(pb + LP_G3)) { LAUNDER_WS(); MAKE_TS();
            pg8::TileSched S;
            if (moe) {
                pg8::Gemm g{(const unsigned char*)YBX, (const unsigned char*)M13 + (size_t)j2 * 8 * 2 * FF * 1024, 1024}; S.build(lds, wv, nT, 22, G, bx, 22, ts, 8, 0, 1, 0, false, T / 256);
                pg8::EpiSwiGLU8 E{(unsigned char*)HID, FF};
                for (int rep_ = 0; rep_ < REP_G3; ++rep_) pg8::gemm_phase<pg8::EpiSwiGLU8, pg8::TileSched, G3_ALIGN, true, false, true>(lds, wv, g, S, E);
            }
            else {
                pg8::Gemm g{(const unsigned char*)U, (const unsigned char*)F13 + (size_t)j2 * 2 * FF * 1024, 1024}; S.build(lds, wv, nT, 22, G, bx, 22, ts, 8);
                pg8::EpiSwiGLU8 E{(unsigned char*)HID, FF};
                for (int rep_ = 0; rep_ < REP_G3; ++rep_) pg8::gemm_phase<pg8::EpiSwiGLU8, pg8::TileSched, G3_ALIGN, true, false, true>(lds, wv, g, S, E);
            }
        }
        SEAM(pb + LP_G3);
        if (PHON(11) && IN(pb + LP_G4)) { LAUNDER_WS(); MAKE_TS();
            pg8::TileSched S;
            if (moe) {
                pg8::Gemm g{(const unsigned char*)HID, (const unsigned char*)M2 + (size_t)j2 * 8 * 1024 * FF, FF}; S.build(lds, wv, nT, 4, G, bx, 4, ts, 22, 0, 1, 0, true);
                pg8::EpiPlain E{YB, 1024, PART4, TL, 1.f / (F8_SH * F8_SW2)};
                for (int rep_ = 0; rep_ < REP_G4; ++rep_) { pg8::gemm_phase<pg8::EpiPlain, pg8::TileSched, true, true, false, true>(lds, wv, g, S, E);
                    const pg8::TileSched SH = S.listB(); pg8::gemm_phase<pg8::EpiPlain, pg8::TileSched, true, true, true, true>(lds, wv, g, SH, E); }
#if DEFER_W
                if (layer == 1) {
                    const int nwg_ = nT * 4, rem_ = nwg_ - (nwg_ / G) * G, busy_ = (2 * rem_ <= G) ? 2 * rem_ : rem_; const int nb = (G - busy_ >= 64) ? busy_ : 0;
                    if (bx >= nb) { __syncthreads(); LAS float* scr = (LAS float*)(lds + wv * 16384); const int ln = opaque_tid(wv) & 63;
                        for (int it = (bx - nb) * 8 + wv; it < 6 * I_FFI; it += (G - nb) * 8) ffn_item(args, wsp, 30 + 2 * DEFER_M + it / I_FFI, it % I_FFI, scr, ln); }
                }
#endif
            } else {
                pg8::Gemm g{(const unsigned char*)HID, (const unsigned char*)F2 + (size_t)j2 * 1024 * FF, FF}; S.build(lds, wv, TL / 256, 4, G, bx, 4, ts, 22, nT - TL / 256, 11, 2);
                pg8::EpiPlain E{YB, 1024, PART4, TL, 1.f / (F8_SH * F8_SW2)};
                for (int rep_ = 0; rep_ < REP_G4; ++rep_) pg8::gemm_phase<pg8::EpiPlain, pg8::TileSched, true, true, false, true>(lds, wv, g, S, E);
            }
        }
        SEAM(pb + LP_G4);
        if (PHON(12) && IN(pb + LP_N2)) { LAUNDER_WS();
            const float* modn = last ? nullptr : MOD + (size_t)(layer + 1) * 5 * 6144;
            LnArgs N{(RES16 == 2 && layer == 0) ? HX : H, (RES16 == 2 && layer == 0) ? HXC : H16C, last ? args.out : H, H16C, YB, nullptr, TOKG, modl, 5, modn, 0, 1,
                     args.in[I_LNG] + (layer * 2 + 1) * 1024, args.in[I_LNB] + (layer * 2 + 1) * 1024, U, nrows,
                     nullptr, nullptr, TOKE, nullptr, TOKR, nullptr, 0, moe ? nullptr : PART4, 11, nullptr, {0, 0, 0, 0, 0, 0, 0, 0}};
            if (moe) { int tsn[9]; exp_table(cnt, tsn); _Pragma("unroll") for (int e = 0; e < 8; ++e) N.ts[e] = tsn[e]; }
            if (moe) ln_pass<true, false, (RES16 == 1), (RES16 == 1 && !last)>(lds, wv, N, gw); else ln_pass<false, false, (RES16 == 1 || (RES16 == 2 && layer == 0)), (RES16 == 1 && !last)>(lds, wv, N, gw);
        }
        SEAM(pb + LP_N2);
}

__global__ void __launch_bounds__(512, 2) hymba_fwd(Args args) {
    extern __shared__ __attribute__((aligned(16))) unsigned char lds_raw[];
    LAS unsigned char* lds = (LAS unsigned char*)lds_raw;
    volatile LAS unsigned* MISC = (volatile LAS unsigned*)(lds + MISC_OFF);
    const int wv = __builtin_amdgcn_readfirstlane((int)(threadIdx.x >> 6));
    const int wid = wv, tid = opaque_tid(wv), lane = tid & 63;
    const int G = gridDim.x, bx = blockIdx.x;
    const int gw = bx * 8 + wid, NGW = G * 8;
    unsigned char* ws = args.ws;
    unsigned* ctl = (unsigned*)(ws + WS_CTL);
    for (int u = tid; u < (LDS_BYTES - LDSCTL_OFF) / 4; u += 512) ((LAS unsigned*)(lds + LDSCTL_OFF))[u] = 0u;
    __syncthreads();
    const int lo = args.ph_lo, hi = args.ph_hi;
    XcdBarrier bar; bar.bar = ctl + CW_BAR; bar.x = 0; bar.st = nullptr; bar.wv = wv;
    if (hi - lo > 1) bar = xcd_barrier_post(ctl + CW_BAR, MISC + 8, wv);

    unsigned char* wsp = ws;

    if (PHON(0) && IN(PH_P0)) for (int rep_ = 0; rep_ < REP_P0; ++rep_) {
        if (rep_) __syncthreads();
        {
            LAS float* SC = (LAS float*)lds;
            LAS float* RED = (LAS float*)(lds + 20480);
            for (int i = tid; i < 5 * 1024; i += 512) { const int cb = i >> 10, k = i & 1023; const float x = cb < 4 ? args.in[I_C][cb * 1024 + k] : args.in[I_CCTX][k]; SC[i] = x / (1.f + expf(-x)); }
            __syncthreads();
            for (int it = bx; it < DEPTH * 48; it += G) {
                const int layer = it / 48, cg = it % 48;
                const float* w = args.in[I_ADAW] + (size_t)layer * 1024 * 6144 + cg * 128 + 2 * lane;
                float a[5][2];
#pragma unroll
                for (int cb = 0; cb < 5; ++cb) { a[cb][0] = 0.f; a[cb][1] = 0.f; }
#pragma unroll 32
                for (int kk = 0; kk < 128; ++kk) { const int k = wid * 128 + kk; const f32x2 wv = *(const GAS f32x2*)(w + (size_t)k * 6144);
#pragma unroll
                    for (int cb = 0; cb < 5; ++cb) { const float s = SC[cb * 1024 + k]; a[cb][0] += s * wv[0]; a[cb][1] += s * wv[1]; } }
#pragma unroll
                for (int cb = 0; cb < 5; ++cb) { RED[(wid * 5 + cb) * 128 + 2 * lane] = a[cb][0]; RED[(wid * 5 + cb) * 128 + 2 * lane + 1] = a[cb][1]; }
                __syncthreads();
                for (int i = tid; i < 5 * 128; i += 512) { const int cb = i >> 7, c = i & 127; float s = 0.f;
#pragma unroll
                    for (int w8 = 0; w8 < 8; ++w8) s += RED[(w8 * 5 + cb) * 128 + c];
                    st_sc1(MOD + ((size_t)layer * 5 + cb) * 6144 + cg * 128 + c, s + args.in[I_ADAB][layer * 6144 + cg * 128 + c]); }
                __syncthreads();
            }
            ho_signal(ctl + CW_HOP, wv);
        }
        {
            for (int i = bx * 512 + tid; i < 4096 * 32; i += G * 512) { const int s = i >> 5, j = i & 31; const float inv = powf(10000.f, -(float)(j & 15) / 16.f);
                const float ang = (j < 16 ? (float)(s >> 6) : (float)(s & 63)) * inv; COS64[i] = cosf(ang); SIN64[i] = sinf(ang); }
            for (int i = bx * 512 + tid; i < 4096 * 16; i += G * 512) { const int s = i >> 4, j = i & 15; const float inv = powf(10000.f, -(float)(j & 7) / 8.f);
                const float ang = (j < 8 ? (float)(s >> 6) : (float)(s & 63)) * inv; COS32[i] = cosf(ang); SIN32[i] = sinf(ang); }
        }
        {
            LAS float* scr = (LAS float*)(lds + wid * 16384);
            constexpr int I_WINI = 16 * 64, I_WOUTI = 16 * 32, I_FF = 16 * 88  , I_GW = 2;
            constexpr int DEF2 = DEFER_W ? 6 : 0;
            constexpr int NFFM = DEFER_W ? 54 - 4 * DEFER_M - DEF2 : 54, NKEEP = 24 - 2 * DEFER_M;
            constexpr int N0 = DEPTH * I_WINI, N1 = N0 + DEPTH * I_WOUTI, N2 = N1 + NFFM * I_FF, N3 = N2 + 64 * I_GW;
            for (int it = gw; it < N3; it += NGW) {
                if (it < N0) { const int l = it / I_WINI; transpose_item(args.in[I_WIN] + (size_t)l * 1024 * INC, 1024, INC, WIN + (size_t)l * INC * 1024, 1, scr, it % I_WINI, lane); }
                else if (it < N1) { const int r = it - N0, l = r / I_WOUTI; transpose_item(args.in[I_WOUT] + (size_t)l * 1024 * 1024, 1024, 1024, WOUT + (size_t)l * 1024 * 1024, 0, scr, r % I_WOUTI, lane); }
                else if (it < N2) { const int r = it - N1, k = r / I_FF, item = r % I_FF;
                    const int mi = !DEFER_W ? k : (k < 6 ? k : k < 6 + NKEEP ? 6 + 2 * DEFER_M + (k - 6) : 30 + 2 * DEFER_M + DEF2 + (k - 6 - NKEEP));
                    ffn_item(args, wsp, mi, item, scr, lane); }
                else { const int r = it - N2, mi = r / I_GW; transpose_item(args.in[I_GATEW] + (size_t)mi * 4096, 64, 64, GWT + (size_t)mi * 4096, 0, scr, r % I_GW, lane); }
            }
        }
        {
            ho_wait(ctl + CW_HOP, (unsigned)G, wv);
        int curcb = -1; f32x4 sc[4], sh[4];
        for (int ri = 0; ri < ROWS_PER_WAVE; ++ri) {
            const int row = wave_row(gw, ri, T); if (row < 0) break;
            const bool lat = row < TL; const int cb = lat ? (row >> 12) : 4;
            if (cb != curcb) { curcb = cb;
#pragma unroll
                for (int j = 0; j < 4; ++j) { const float* ps = MOD + (size_t)(cb * 6 + 0) * 1024 + 4 * lane + 256 * j; const float* pc = MOD + (size_t)(cb * 6 + 1) * 1024 + 4 * lane + 256 * j;
                    sh[j] = (f32x4){ld_sc1(ps), ld_sc1(ps + 1), ld_sc1(ps + 2), ld_sc1(ps + 3)}; sc[j] = (f32x4){ld_sc1(pc), ld_sc1(pc + 1), ld_sc1(pc + 2), ld_sc1(pc + 3)}; } }
            const float* hin = lat ? args.in[I_X] + (size_t)row * 1024 : args.in[I_CTX] + (size_t)(row - TL) * 1024;
#pragma unroll
            for (int j = 0; j < 4; ++j) { f32x4 v = *(const GAS f32x4*)(hin + 4 * lane + 256 * j); v = v * (sc[j] + 1.f) + sh[j];
                u32x2 w; w.x = cvtpk(v[0], v[1]); w.y = cvtpk(v[2], v[3]); *(GAS u32x2*)(U + (size_t)row * 1024 + 4 * lane + 256 * j) = w; }
        }
        }
    }
    SEAM(PH_P0B);

    layer_body<0>(lds, wv, args, ws, G, bx, gw, lo, hi, bar);
    layer_body<1>(lds, wv, args, ws, G, bx, gw, lo, hi, bar);
    layer_body<2>(lds, wv, args, ws, G, bx, gw, lo, hi, bar);
    layer_body<3>(lds, wv, args, ws, G, bx, gw, lo, hi, bar);
#undef IN
#undef SEAM
}

extern "C" void kernel_launch(void* const* d_in, const int* in_sizes, int n_in, void* d_out, int out_size, void* d_ws, size_t ws_size, hipStream_t stream) {
    static int grid = 0;
    if (grid == 0) {
        if (n_in != 26 || out_size != TL * D || ws_size < WS_END) { fprintf(stderr, "kernel_launch: unexpected shapes (n_in %d, out %d, ws %zu < %zu)\n", n_in, out_size, ws_size, (size_t)WS_END); grid = -1; return; }
        int dev = 0, cus = 0, per_cu = 0;
        if (hipGetDevice(&dev) != hipSuccess || hipDeviceGetAttribute(&cus, hipDeviceAttributeMultiprocessorCount, dev) != hipSuccess) { grid = -1; return; }
        if (hipFuncSetAttribute((const void*)hymba_fwd, hipFuncAttributeMaxDynamicSharedMemorySize, LDS_BYTES) != hipSuccess) { fprintf(stderr, "kernel_launch: hipFuncSetAttribute failed\n"); grid = -1; return; }
        if (hipOccupancyMaxActiveBlocksPerMultiprocessor(&per_cu, (const void*)hymba_fwd, 512, LDS_BYTES) != hipSuccess || per_cu < 1) { fprintf(stderr, "kernel_launch: occupancy query reports %d\n", per_cu); }
        (void)hipGetLastError();
        grid = cus;
        if (per_cu < 1) grid = -1;
    }
    if (grid < 0) return;
    if (hipMemsetAsync((char*)d_ws + WS_CTL, 0, CTL_ZERO_BYTES, stream) != hipSuccess) return;
    Args a{};
    for (int i = 0; i < 26; ++i) a.in[i] = (const float*)d_in[i];
    a.out = (float*)d_out; a.ws = (unsigned char*)d_ws;
#if MK_N_LAUNCHES == 1
    a.ph_lo = 0; a.ph_hi = N_PHASES;
    hipLaunchKernelGGL(hymba_fwd, dim3(grid), dim3(512), LDS_BYTES, stream, a);
#else
    for (int p = 0; p < N_PHASES; ++p) {
        const int lp = p - PH_LAYER0;
        if (lp >= 0 && (lp % PH_PER_LAYER) == LP_R1 && (((lp / PH_PER_LAYER) & 1) == 0)) continue;
        a.ph_lo = p; a.ph_hi = p + 1;
        hipLaunchKernelGGL(hymba_fwd, dim3(grid), dim3(512), LDS_BYTES, stream, a);
    }
#endif
}
```

```cpp
#define DIFF_GRPB 0
#include <hip/hip_runtime.h>
#include <cstdio>
#include <cstdint>

#ifndef MK_N_LAUNCHES
#define MK_N_LAUNCHES 1
#endif

#define LAS __attribute__((address_space(3)))
#define GAS __attribute__((address_space(1)))
typedef unsigned short bf16_t;
typedef short bf16x8 __attribute__((ext_vector_type(8)));
typedef float f32x2 __attribute__((ext_vector_type(2)));
typedef float f32x4 __attribute__((ext_vector_type(4)));
typedef float f32x16 __attribute__((ext_vector_type(16)));
typedef unsigned u32x2 __attribute__((ext_vector_type(2)));
typedef unsigned u32x4 __attribute__((ext_vector_type(4)));
typedef short s16x4 __attribute__((ext_vector_type(4)));
typedef __bf16 bf16x2_t __attribute__((ext_vector_type(2)));

constexpr int D = 1024, NB = 4, SEQ = 4096, CTX = 256, TL = NB * SEQ, TC = NB * CTX, T = TL + TC, KEYS = CTX + SEQ;
constexpr int DEPTH = 4, INC = 2048, FF = 2816, NE = 8, NCB = 5;
constexpr int LRU_CH = 256, LRU_CHUNK = 32, LRU_NCH = KEYS / LRU_CHUNK;
constexpr float ALPHA = 1.6817928305074290f;
constexpr float LN_EPS = 1e-5f;
constexpr float LOG2E = 1.4426950408889634f;
constexpr int MOE_ROWS = 36864;

constexpr size_t MiB = 1u << 20;
constexpr size_t WS_CTL = 0, CTL_ZERO_BYTES = 64 * 1024;
constexpr size_t WS_MOD = 1 * MiB;
constexpr size_t WS_COS64 = WS_MOD + 512 * 1024, WS_SIN64 = WS_COS64 + 512 * 1024;
constexpr size_t WS_COS32 = WS_SIN64 + 512 * 1024, WS_SIN32 = WS_COS32 + 256 * 1024;
constexpr size_t WS_GWT = 3 * MiB;
constexpr size_t WS_CM = WS_GWT + 512 * 1024;
constexpr size_t WS_CARRY = WS_CM + 2304 * 1024;
constexpr size_t WS_KMAX = WS_MOD + 500 * 1024;
constexpr size_t WS_TOKE = 7 * MiB, WS_TOKG = WS_TOKE + 144 * 1024, WS_TOKR = WS_TOKG + 144 * 1024, WS_TOKS = WS_TOKR + 144 * 1024;
constexpr size_t WS_WIN = 8 * MiB;
constexpr size_t WS_WOUT = 24 * MiB;
constexpr size_t WS_F13 = 32 * MiB;
constexpr size_t WS_F2 = 54 * MiB;
constexpr size_t WS_M13 = 65 * MiB;
constexpr size_t WS_M2 = 241 * MiB;
constexpr size_t WS_H = 329 * MiB;
constexpr size_t WS_U = 397 * MiB;
constexpr size_t WS_X = 431 * MiB;
constexpr size_t WS_LRUX = WS_X;
constexpr size_t WS_GATE = WS_LRUX + (size_t)T * 256 * 2;
constexpr size_t WS_QS = WS_GATE + (size_t)T * 256 * 2;
constexpr size_t WS_KS = WS_QS + (size_t)T * 512 * 2;
constexpr size_t WS_VS = WS_KS + (size_t)NB * 2 * KEYS * 64 * 2;
constexpr size_t WS_QD = WS_VS + (size_t)NB * 2 * KEYS * 64 * 2;
constexpr size_t WS_KD = WS_QD + (size_t)T * 256 * 2;
constexpr size_t WS_VD = WS_KD + (size_t)NB * 4 * KEYS * 64 * 2;
constexpr size_t WS_MIX = WS_VD + (size_t)NB * 4 * KEYS * 64 * 2;
constexpr size_t WS_MB = WS_MIX + (size_t)T * 1024 * 2;
constexpr size_t WS_YB = WS_X;
constexpr size_t WS_HID = WS_YB + (size_t)MOE_ROWS * 1024 * 2;
constexpr size_t WS_END = WS_HID + (size_t)MOE_ROWS * FF * 2;
constexpr size_t WS_AB = WS_MB + (size_t)T * 1024 * 2;
static_assert(WS_AB + (size_t)NB * LRU_NCH * 2 * 16384 * 4 <= WS_END, "AB");
constexpr size_t WS_YBX = (size_t)602 << 20;
static_assert(WS_YBX >= WS_HID + (size_t)(2 * T + 2048) * 2816, "YBX");
constexpr size_t WS_PART2 = WS_X;
constexpr size_t WS_PART4 = 600 * MiB;
static_assert(WS_PART2 + 8 * 4 * MiB <= WS_MIX && WS_PART4 >= WS_HID + (size_t)T * FF * 2 && WS_PART4 + 11 * 4 * MiB <= WS_END, "partial buffers");
static_assert(WS_MB + (size_t)T * 1024 * 2 <= WS_END && WS_CM + (size_t)NB * LRU_NCH * 1024 * 4 <= WS_CARRY && WS_CARRY + (size_t)NB * LRU_NCH * 512 * 4 <= WS_TOKE && (size_t)T * 8 <= 144 * 1024 && WS_TOKS + 144 * 1024 <= WS_WIN, "ws map");
static_assert(WS_HID >= WS_MIX, "HID must not overlay buffers live during the up GEMM inputs");
constexpr int CW_BAR = 4096;
constexpr int CW_CNT = 1024;
constexpr int CW_HO = 2048;
constexpr int CW_HOP = 3072;
static_assert((CW_BAR + 3456) * 4 <= (int)CTL_ZERO_BYTES, "control words inside the memset region");

constexpr int RING_BYTES = 131072;
constexpr int LDSCTL_OFF = RING_BYTES, MISC_OFF = LDSCTL_OFF + 320;
constexpr int LDS_BYTES = 147456;

__device__ __forceinline__ int lane_id() { return (int)__builtin_amdgcn_mbcnt_hi(~0u, __builtin_amdgcn_mbcnt_lo(~0u, 0u)); }
__device__ __forceinline__ int opaque_tid(int wv) { unsigned z = 0u; asm volatile("" : "+v"(z));
    int t = wv * 64 + (int)__builtin_amdgcn_mbcnt_hi(~0u, __builtin_amdgcn_mbcnt_lo(~0u, z)); asm volatile("" : "+v"(t)); return t; }
#ifndef WT_STORES
#define WT_STORES 0
#endif
__device__ __forceinline__ void st16(void* p, u32x4 v) {
#if WT_STORES
    asm volatile("global_store_dwordx4 %0, %1, off sc1\n\ts_nop 1" :: "v"(p), "v"(v) : "memory");
#else
    *(GAS u32x4*)p = v;
#endif
}
__device__ __forceinline__ void st16f(void* p, f32x4 v) { st16(p, __builtin_bit_cast(u32x4, v)); }
__device__ __forceinline__ float clamp_f8(float v) { return __builtin_amdgcn_fmed3f(v, -416.f, 416.f); }
__device__ __forceinline__ unsigned cvt4_fp8(float a, float b, float c, float d) {
    int w = 0; w = __builtin_amdgcn_cvt_pk_fp8_f32(clamp_f8(a), clamp_f8(b), w, false); w = __builtin_amdgcn_cvt_pk_fp8_f32(clamp_f8(c), clamp_f8(d), w, true); return (unsigned)w;
}
constexpr float F8_SU = 4.f, F8_SW13 = 512.f, F8_SH = 2.f, F8_SW2 = 4096.f;
__device__ __forceinline__ unsigned cvtpk(float lo, float hi) { f32x2 v = {lo, hi}; bf16x2_t b = __builtin_convertvector(v, bf16x2_t); return __builtin_bit_cast(unsigned, b); }
__device__ __forceinline__ float bf2f(unsigned short x) { return __uint_as_float(((unsigned)x) << 16); }
__device__ __forceinline__ float bflo(unsigned w) { return __uint_as_float(w << 16); }
__device__ __forceinline__ float bfhi(unsigned w) { return __uint_as_float(w & 0xffff0000u); }
#define WS_DPP(v_, ctrl_) __uint_as_float((unsigned)__builtin_amdgcn_update_dpp(0, (int)__float_as_uint(v_), (ctrl_), 0xF, 0xF, true))
__device__ __forceinline__ float wave_sum(float v) {
    v += WS_DPP(v, 0xB1);
    v += WS_DPP(v, 0x4E);
    v += WS_DPP(v, 0x141);
    v += WS_DPP(v, 0x140);
    { auto rr = __builtin_amdgcn_permlane16_swap(__float_as_uint(v), __float_as_uint(v), false, false); v = __uint_as_float(rr[0]) + __uint_as_float(rr[1]); }
    { auto rr = __builtin_amdgcn_permlane32_swap(__float_as_uint(v), __float_as_uint(v), false, false); v = __uint_as_float(rr[0]) + __uint_as_float(rr[1]); }
    return v;
}
__device__ __forceinline__ float fast_exp2(float x) { return __builtin_amdgcn_exp2f(x); }
__device__ __forceinline__ float fast_rcp(float x) { return __builtin_amdgcn_rcpf(x); }
__device__ __forceinline__ float sigmoid_f(float x) { return fast_rcp(1.f + fast_exp2(-LOG2E * x)); }
__device__ __forceinline__ float silu_f(float x) { return x * sigmoid_f(x); }
__device__ __forceinline__ float gelu_tanh_f(float x) {
    const float z = 0.7978845608028654f * (x + 0.044715f * x * x * x);
    return x * sigmoid_f(2.f * z);
}

#define RLX_AGENT __ATOMIC_RELAXED, __HIP_MEMORY_SCOPE_AGENT
__device__ __forceinline__ void ho_signal(unsigned* cnt, int wv) {
    asm volatile("s_waitcnt vmcnt(0)" ::: "memory"); __syncthreads();
    if (wv == 0 && lane_id() == 0) __hip_atomic_fetch_add((GAS unsigned*)cnt, 1u, RLX_AGENT);
}
__device__ __forceinline__ void ho_wait(unsigned* cnt, unsigned target, int wv) {
    if (wv == 0) { unsigned sp = 0u; while (__hip_atomic_load((const GAS unsigned*)cnt, RLX_AGENT) < target) { __builtin_amdgcn_s_sleep(4); if (++sp > (1u << 22)) break; } }
    __syncthreads();
}
__device__ __forceinline__ void st_sc1(float* p, float v) { __hip_atomic_store((GAS unsigned*)p, __float_as_uint(v), RLX_AGENT); }
__device__ __forceinline__ float ld_sc1(const float* p) { return __uint_as_float(__hip_atomic_load((const GAS unsigned*)p, RLX_AGENT)); }

namespace pg8 {
#define PG8_LAS __attribute__((address_space(3)))
constexpr int BM = 256, BK = 64, HALF = 128, HTB = HALF * BK * 2  , STAGE_BYTES = 8 * HTB, NXCD = 8, WGM = 8;
__host__ __device__ __forceinline__ int lds_byte(int r, int c) { const int st = (r >> 4) * 2 + (c >> 5), rr = r & 15, cc = c & 31, ob = rr * 64 + cc * 2; return st * 1024 + (ob ^ (((ob >> 9) & 1) << 5)); }
__host__ __device__ __forceinline__ void stage_rc(int b, int& R, int& C) { const int st = b / 1024, sb = b % 1024, swz = sb ^ (((sb >> 9) & 1) << 5); R = (st >> 1) * 16 + swz / 64; C = (st & 1) * 32 + (swz % 64) / 2; }
__host__ __device__ __forceinline__ int perm32(int rho) { const int n = rho >> 4, i = rho & 15; return 8 * (i >> 2) + 4 * n + (i & 3); }

struct Unit { int pm, pn, pb, sp, nk, kofs, hf, pa; };
struct Gemm { const void* A; const void* Bt; int ld; };

constexpr int UNIT_LIST_OFF = RING_BYTES + 1024, UNIT_LIST_MAX = 64;
struct TileSched {
    PG8_LAS unsigned* ul; int nk_full, nk_piece;
    __device__ __forceinline__ void build(PG8_LAS unsigned char* lds, int wv, int nM, int nN, int G, int c, int nNb, const int (&ts)[9], int nkf, int nMs = 0, int nsplit = 1, int nkp = 0, bool halves = false, int gatherT = 0) {
        ul = (PG8_LAS unsigned*)(lds + UNIT_LIST_OFF); nk_full = nkf; nk_piece = nkp;
        const int t = opaque_tid(wv);
        if (t < 2 * UNIT_LIST_MAX) {
            const int i = t & (UNIT_LIST_MAX - 1); const bool listB = t >= UNIT_LIST_MAX;
            const int nwg = nM * nN; int nfullU = nwg; if (halves) { const int f = (nwg / G) * G; if (2 * (nwg - f) <= G) nfullU = f; }
            long L = (long)i * G + c; unsigned w = 0xffffffffu; unsigned hf = 0u; bool whole = false; unsigned wa = 0u;
            if (!listB) { whole = L < nfullU; }
            else { if (L < 2 * (long)(nwg - nfullU)) { hf = (unsigned)(L & 1); L = nfullU + (L >> 1); whole = true; } }
            if (whole) {
                int wgid = (int)L; { const int q = nwg / NXCD, r = nwg % NXCD, xcd = wgid % NXCD, off = wgid / NXCD; wgid = (xcd < r ? xcd * (q + 1) : r * (q + 1) + (xcd - r) * q) + off; }
                const int nig = WGM * nN, gid = wgid / nig, fm = gid * WGM, gsz = (nM - fm) < WGM ? (nM - fm) : WGM;
                const int pm = fm + ((wgid % nig) % gsz), pn = (wgid % nig) / gsz;
                int e = 0, tse = 0;
#pragma unroll
                for (int k = 1; k < 8; ++k) { const bool ge = pm >= ts[k]; e += ge ? 1 : 0; tse = ge ? ts[k] : tse; }
                w = (unsigned)pm | ((unsigned)pn << 10) | ((unsigned)(e * nNb + pn) << 16) | (hf << 29);
                wa = gatherT ? (unsigned)(e * gatherT + (pm - tse)) : (unsigned)pm;
            } else if (!listB && L >= nwg && L - nwg < (long)nMs * nN * nsplit) {
                const int Ls = (int)(L - nwg), per = nN * nsplit, pm = nM + Ls / per, rem = Ls % per, pn = rem / nsplit, sp = rem % nsplit + 1;
                w = (unsigned)pm | ((unsigned)pn << 10) | ((unsigned)pn << 16) | ((unsigned)sp << 24);
                wa = (unsigned)pm;
            }
            ul[t] = w; ul[t + 2 * UNIT_LIST_MAX] = wa;
        }
        __syncthreads();
    }
    __device__ __forceinline__ TileSched listB() const { TileSched s = *this; s.ul = ul + UNIT_LIST_MAX; return s; }
    __device__ __forceinline__ bool next(int i, Unit& u) const {
        if (i >= UNIT_LIST_MAX) return false;
        const unsigned w = (unsigned)__builtin_amdgcn_readfirstlane((int)ul[i]);
        if (w == 0xffffffffu) return false;
        u.pm = (int)(w & 1023u); u.pn = (int)((w >> 10) & 63u); u.pb = (int)((w >> 16) & 255u); u.sp = (int)((w >> 24) & 31u); u.hf = (int)((w >> 29) & 1u); u.pa = __builtin_amdgcn_readfirstlane((int)ul[i + 2 * UNIT_LIST_MAX]);
        u.nk = u.sp ? nk_piece : nk_full; u.kofs = u.sp ? (u.sp - 1) * nk_piece * 128 : 0; return true;
    }
    __device__ __forceinline__ void a_ready(const Unit&) const {}
    __device__ __forceinline__ void done(const Unit&) const {}
};

struct EpiPlain {
    static constexpr bool PERM = true, AFTER_DRAIN = false;
    bf16_t* O; int ldc; float* PART; int prow0; float scale;
    template <bool HN> __device__ __forceinline__ void run(const f32x4 (&acc)[2][2][4][2], const Unit& u, int wr, int wc, int fr_, int fq_) const {
        int ln_ = lane_id(); asm volatile("" : "+v"(ln_)); const int fr = ln_ & 15, fq = ln_ >> 4; (void)fr_; (void)fq_;
        int lrow = wr * 64 + fr, lcol = wc * 32 + 8 * fq; asm volatile("" : "+v"(lrow), "+v"(lcol));
        const int row0 = u.pm * BM + lrow, col0 = u.pn * BM + lcol + (HN ? u.hf * HALF : 0);
        if (!HN && u.sp) {
            bf16_t* P = (bf16_t*)PART + ((size_t)(u.sp - 1) * 1024 + (row0 - prow0)) * ldc + col0;
#pragma unroll
            for (int ai = 0; ai < 2; ++ai)
#pragma unroll
                for (int m = 0; m < 4; ++m) { bf16_t* rowp = P + (size_t)(ai * HALF + m * 16) * ldc;
#pragma unroll
                    for (int bj = 0; bj < 2; ++bj) { const f32x4 a0 = acc[ai][bj][m][0] * scale, a1 = acc[ai][bj][m][1] * scale;
                        u32x4 w; w.x = cvtpk(a0[0], a0[1]); w.y = cvtpk(a0[2], a0[3]); w.z = cvtpk(a1[0], a1[1]); w.w = cvtpk(a1[2], a1[3]); st16(rowp + bj * HALF, w); } }
            return;
        }
#pragma unroll
        for (int ai = 0; ai < 2; ++ai)
#pragma unroll
            for (int m = 0; m < 4; ++m) { bf16_t* rowp = O + (size_t)(row0 + ai * HALF + m * 16) * ldc + col0;
#pragma unroll
                for (int bj = 0; bj < (HN ? 1 : 2); ++bj) { const f32x4 v0 = acc[ai][bj][m][0] * scale, v1 = acc[ai][bj][m][1] * scale;
                    u32x4 w; w.x = cvtpk(v0[0], v0[1]); w.y = cvtpk(v0[2], v0[3]); w.z = cvtpk(v1[0], v1[1]); w.w = cvtpk(v1[2], v1[3]);
                    st16(rowp + bj * HALF, w); } }
    }
};
struct EpiSwiGLU {
    static constexpr bool PERM = true, AFTER_DRAIN = false;
    bf16_t* O; int ldc;
    template <bool HN> __device__ __forceinline__ void run(const f32x4 (&acc)[2][2][4][2], const Unit& u, int wr, int wc, int fr_, int fq_) const {
        int ln_ = lane_id(); asm volatile("" : "+v"(ln_)); const int fr = ln_ & 15, fq = ln_ >> 4; (void)fr_; (void)fq_;
        static_assert(!HN, "SwiGLU tiles pair the two column halves");
        int lrow = wr * 64 + fr, lcol = wc * 32 + 8 * fq; asm volatile("" : "+v"(lrow), "+v"(lcol));
        const int row0 = u.pm * BM + lrow, col0 = u.pn * HALF + lcol;
#pragma unroll
        for (int ai = 0; ai < 2; ++ai)
#pragma unroll
            for (int m = 0; m < 4; ++m) { bf16_t* rowp = O + (size_t)(row0 + ai * HALF + m * 16) * ldc + col0;
                float h[8];
#pragma unroll
                for (int n = 0; n < 2; ++n)
#pragma unroll
                    for (int j = 0; j < 4; ++j) h[4 * n + j] = silu_f(acc[ai][0][m][n][j]) * acc[ai][1][m][n][j];
                u32x4 w; w.x = cvtpk(h[0], h[1]); w.y = cvtpk(h[2], h[3]); w.z = cvtpk(h[4], h[5]); w.w = cvtpk(h[6], h[7]);
                st16(rowp, w); }
    }
};
struct EpiSwiGLU8 {
    static constexpr bool PERM = true, AFTER_DRAIN = false;
    unsigned char* O8; int ldc;
    template <bool HN> __device__ __forceinline__ void run(const f32x4 (&acc)[2][2][4][2], const Unit& u, int wr, int wc, int fr_, int fq_) const {
        int ln_ = lane_id(); asm volatile("" : "+v"(ln_)); const int fr = ln_ & 15, fq = ln_ >> 4; (void)fr_; (void)fq_;
        static_assert(!HN, "SwiGLU tiles pair the two column halves");
        int lrow = wr * 64 + fr, lcol = wc * 32 + 8 * fq; asm volatile("" : "+v"(lrow), "+v"(lcol));
        const int row0 = u.pm * BM + lrow, col0 = u.pn * HALF + lcol;
        const unsigned off0 = (unsigned)row0 * (unsigned)FF + (unsigned)col0;
        constexpr float si = 1.f / (F8_SU * F8_SW13);
        constexpr float KINV = (F8_SU * F8_SW13) * (F8_SU * F8_SW13) / F8_SH, KL2 = 21.f;
        static_assert(F8_SU * F8_SW13 == 2048.f && F8_SH == 2.f, "K = 2^-21");
#pragma unroll
        for (int ai = 0; ai < 2; ++ai)
#pragma unroll
            for (int m = 0; m < 4; ++m) { unsigned char* rowp = O8 + (off0 + (unsigned)((ai * HALF + m * 16) * FF));
                float h[8];
#pragma unroll
                for (int n = 0; n < 2; ++n)
#pragma unroll
                    for (int j = 0; j < 4; ++j) {
                        const float a0 = acc[ai][0][m][n][j], a1 = acc[ai][1][m][n][j];
                        h[4 * n + j] = (a0 * a1) * fast_rcp(KINV + fast_exp2(__builtin_fmaf(a0, -LOG2E * si, KL2))); }
                u32x2 w; w.x = cvt4_fp8(h[0], h[1], h[2], h[3]); w.y = cvt4_fp8(h[4], h[5], h[6], h[7]);
                *(GAS u32x2*)rowp = w; }
    }
};
struct EpiIn {
    static constexpr bool PERM = true, AFTER_DRAIN = false;
    bf16_t *LRUX, *GATE, *QS, *KS, *VS, *QD, *KD, *VD; const float *c64, *s64, *c32, *s32;
    template <bool HN> __device__ __forceinline__ void run(const f32x4 (&acc)[2][2][4][2], const Unit& u, int wr, int wc, int fr_, int fq_) const {
        int ln_ = lane_id(); asm volatile("" : "+v"(ln_)); const int fr = ln_ & 15, fq = ln_ >> 4; (void)fr_; (void)fq_;
        const int pm = u.pm, pn = u.pn;
        const bool lat = pm < 64;
        const int b = lat ? (pm >> 4) : (pm - 64);
        const int kr0 = lat ? CTX + (pm & 15) * 256 : 0;
        const int s0 = (pm & 15) * 256;
        const int lr0 = wr * 64 + fr;
        int cw = wc * 32 + 8 * fq;
        asm volatile("" : "+v"(cw));
#pragma unroll
        for (int bjl = 0; bjl < (HN ? 1 : 2); ++bjl) {
            const int bj = HN ? u.hf : bjl;
            const int ct = bj * HALF + cw;
            bf16_t* base; int stride; int mode = 0; float scale = 1.f; int pidx = 0; bool gel = false;
            if (pn == 0) { base = LRUX + (size_t)pm * 256 * 256 + ct; stride = 256; }
            else if (pn == 1) { base = GATE + (size_t)pm * 256 * 256 + ct; stride = 256; gel = true; }
            else if (pn == 2 || pn == 3) { const int col = (pn - 2) * 256 + ct; base = QS + (size_t)pm * 256 * 512 + col; stride = 512; mode = 1; pidx = (col & 63) >> 1; scale = 0.125f * LOG2E; }
            else if (pn == 4) { const int hk = (ct & 127) >> 6; bf16_t* kv = bj == 0 ? KS : VS; base = kv + ((size_t)(b * 2 + hk) * KEYS + kr0) * 64 + (ct & 63); stride = 64; mode = bj == 0 ? 1 : 0; pidx = (ct & 63) >> 1; }
            else if (pn == 5) { base = QD + (size_t)pm * 256 * 256 + ct; stride = 256; mode = 2; pidx = (ct & 31) >> 1; scale = 0.17677669529663687f * LOG2E; }
            else { const int h = ct >> 6; bf16_t* kv = pn == 6 ? KD : VD; base = kv + ((size_t)(b * 4 + h) * KEYS + kr0) * 64 + (ct & 63); stride = 64; mode = pn == 6 ? 2 : 0; pidx = (ct & 31) >> 1; }
            if (!lat) mode = 0;
            const bool colb = mode == 1 ? (pidx >= 16) : (pidx >= 8);
            f32x4 ce[4], se[4];
            if (mode != 0) {
#pragma unroll
                for (int k = 0; k < 4; ++k) { const int sk = s0 + lr0 + (colb ? 16 * k : 128 * (k & 1));
                    const float* ct_ = mode == 1 ? c64 + (size_t)sk * 32 + pidx : c32 + (size_t)sk * 16 + pidx;
                    const float* st_ = mode == 1 ? s64 + (size_t)sk * 32 + pidx : s32 + (size_t)sk * 16 + pidx;
                    ce[k] = *(const GAS f32x4*)ct_; se[k] = *(const GAS f32x4*)st_; }
            }
#pragma unroll
            for (int ai = 0; ai < 2; ++ai)
#pragma unroll
                for (int m = 0; m < 4; ++m) {
                    const int lr = lr0 + ai * HALF + m * 16;
                    f32x4 v0 = acc[ai][bjl][m][0], v1 = acc[ai][bjl][m][1];
                    if (mode != 0) {
                        f32x4 cs, sn;
#pragma unroll
                        for (int j = 0; j < 4; ++j) { cs[j] = colb ? ce[m][j] : ce[ai][j]; sn[j] = colb ? se[m][j] : se[ai][j]; }
                        f32x4 r0, r1;
                        r0[0] = v0[0] * cs[0] - v0[1] * sn[0]; r0[1] = v0[1] * cs[0] + v0[0] * sn[0];
                        r0[2] = v0[2] * cs[1] - v0[3] * sn[1]; r0[3] = v0[3] * cs[1] + v0[2] * sn[1];
                        r1[0] = v1[0] * cs[2] - v1[1] * sn[2]; r1[1] = v1[1] * cs[2] + v1[0] * sn[2];
                        r1[2] = v1[2] * cs[3] - v1[3] * sn[3]; r1[3] = v1[3] * cs[3] + v1[2] * sn[3];
                        v0 = r0; v1 = r1;
                    }
                    if (gel) {
#pragma unroll
                        for (int j = 0; j < 4; ++j) { v0[j] = gelu_tanh_f(v0[j]); v1[j] = gelu_tanh_f(v1[j]); }
                    }
                    v0 = v0 * scale; v1 = v1 * scale;
                    u32x4 w; w.x = cvtpk(v0[0], v0[1]); w.y = cvtpk(v0[2], v0[3]); w.z = cvtpk(v1[0], v1[1]); w.w = cvtpk(v1[2], v1[3]);
                    st16(base + (size_t)lr * stride, w);
                }
            asm volatile("" ::: "memory");
        }
    }
};

template <class Epi, class Sched, bool ALIGN_EPI = false, bool SP2 = false, bool HN = false, bool F8 = false>
__device__ __forceinline__ void gemm_phase(PG8_LAS unsigned char* lds, const int wv, const Gemm g, const Sched& S, const Epi& E) {
    const int tid = opaque_tid(wv), wid = __builtin_amdgcn_readfirstlane(tid >> 6), lane = tid & 63, wr = wid >> 2, wc = wid & 3, fr = lane & 15, fq = lane >> 4;
    constexpr int ESZ = F8 ? 1 : 2;
    const int K = g.ld;
    unsigned voffA[2], voffB[2];
#pragma unroll
    for (int i = 0; i < 2; ++i) { int R, C; stage_rc(tid * 16 + i * 8192, R, C); const int Rb = Epi::PERM ? ((R & ~31) + perm32(R & 31)) : R;
        voffA[i] = (unsigned)(R * K * ESZ + C * 2); voffB[i] = (unsigned)(Rb * K * ESZ + C * 2); }
    const size_t kstep = (size_t)(BK * 2);
    const size_t hstep = (size_t)HALF * K * ESZ;
    const size_t tstep = 2 * hstep;
    const unsigned ldsbase = (unsigned)(uintptr_t)lds + (unsigned)wid * 1024u;
    const unsigned ldsw = (unsigned)wid * 1024u;
    const int aoff = lds_byte(wr * 64 + fr, fq * 8), boff = lds_byte(wc * 32 + fr, fq * 8);
#define PG8_SA(b, h) (((b) * 2 + (h)) * HTB)
#define PG8_SB(b, h) ((4 + (b) * 2 + (h)) * HTB)
#define PG8_STAGE(bufoff, gbase, voff) do { _Pragma("unroll") for (int _i = 0; _i < 2; ++_i) { unsigned keep_; \
        asm volatile("s_mov_b32 %0, m0\n\ts_mov_b32 m0, %3\n\ts_nop 0\n\tglobal_load_lds_dwordx4 %1, %2\n\ts_mov_b32 m0, %0" \
                     : "=&s"(keep_) : "v"((voff)[_i]), "s"((const char*)(gbase)), "s"(ldsbase + (unsigned)((bufoff) + _i * 8192)) : "memory"); } } while (0)
#define PG8_LDA(dst, b, h) do { _Pragma("unroll") for (int m = 0; m < 4; ++m) { if constexpr (F8) { dst##8[m].lo = *(const PG8_LAS v4i_t*)(lds + PG8_SA(b, h) + aoff + m * 2048); dst##8[m].hi = *(const PG8_LAS v4i_t*)(lds + PG8_SA(b, h) + aoff + m * 2048 + 1024); } \
        else { _Pragma("unroll") for (int k = 0; k < 2; ++k) dst[m][k] = *(const PG8_LAS bf16x8*)(lds + PG8_SA(b, h) + aoff + m * 2048 + k * 1024); } } } while (0)
#define PG8_LDB(dst, b, h) do { _Pragma("unroll") for (int n = 0; n < 2; ++n) { if constexpr (F8) { dst##8[n].lo = *(const PG8_LAS v4i_t*)(lds + PG8_SB(b, h) + boff + n * 2048); dst##8[n].hi = *(const PG8_LAS v4i_t*)(lds + PG8_SB(b, h) + boff + n * 2048 + 1024); } \
        else { _Pragma("unroll") for (int k = 0; k < 2; ++k) dst[n][k] = *(const PG8_LAS bf16x8*)(lds + PG8_SB(b, h) + boff + n * 2048 + k * 1024); } } } while (0)
#define PG8_MMA(ai, bj, At, Bt) do { __builtin_amdgcn_s_setprio(1); _Pragma("unroll") for (int m = 0; m < 4; ++m) _Pragma("unroll") for (int n = 0; n < 2; ++n) { \
        if constexpr (F8) acc[ai][bj][m][n] = __builtin_amdgcn_mfma_scale_f32_16x16x128_f8f6f4(Bt##8[n], At##8[m], acc[ai][bj][m][n], 0, 0, 0, f8one, 0, f8one); \
        else { _Pragma("unroll") for (int k = 0; k < 2; ++k) acc[ai][bj][m][n] = __builtin_amdgcn_mfma_f32_16x16x32_bf16(Bt[n][k], At[m][k], acc[ai][bj][m][n], 0, 0, 0); } } \
        __builtin_amdgcn_s_setprio(0); } while (0)
#define PG8_MMAZ(ai, bj, At, Bt) do { __builtin_amdgcn_s_setprio(1); _Pragma("unroll") for (int m = 0; m < 4; ++m) _Pragma("unroll") for (int n = 0; n < 2; ++n) { \
        if constexpr (F8) acc[ai][bj][m][n] = __builtin_amdgcn_mfma_scale_f32_16x16x128_f8f6f4(Bt##8[n], At##8[m], (f32x4){0.f, 0.f, 0.f, 0.f}, 0, 0, 0, f8one, 0, f8one); \
        else { acc[ai][bj][m][n] = __builtin_amdgcn_mfma_f32_16x16x32_bf16(Bt[n][0], At[m][0], (f32x4){0.f, 0.f, 0.f, 0.f}, 0, 0, 0); acc[ai][bj][m][n] = __builtin_amdgcn_mfma_f32_16x16x32_bf16(Bt[n][1], At[m][1], acc[ai][bj][m][n], 0, 0, 0); } } \
        __builtin_amdgcn_s_setprio(0); } while (0)
#define PG8_MMAF(ai, bj, At, Bt) do { if constexpr (F8) PG8_MMA(ai, bj, At, Bt); else { if (t == 0) PG8_MMAZ(ai, bj, At, Bt); else PG8_MMA(ai, bj, At, Bt); } } while (0)
#define PG8_WAIT_V(n) asm volatile("s_waitcnt vmcnt(" #n ")" ::: "memory")
#define PG8_WAIT_L(n) asm volatile("s_waitcnt lgkmcnt(" #n ")" ::: "memory")
#define PG8_BAR __builtin_amdgcn_s_barrier()
#define PG8_SCHED __builtin_amdgcn_sched_barrier(0)
    typedef unsigned long long pg8_u64x2 __attribute__((ext_vector_type(2)));
#define PG8_ZERO4(x_) do { unsigned long long lo_, hi_; asm volatile("v_mov_b64 %0, 0" : "=v"(lo_)); asm volatile("v_mov_b64 %0, 0" : "=v"(hi_)); x_ = __builtin_bit_cast(f32x4, (pg8_u64x2){lo_, hi_}); } while (0)
    Unit cur, nxt; int ui = 0;
    if (!S.next(0, cur)) return;
    f32x4 acc[2][2][4][2];
    if constexpr (!SP2 || F8) {
#pragma unroll
    for (int a = 0; a < 2; ++a)
#pragma unroll
        for (int b = 0; b < 2; ++b)
#pragma unroll
            for (int m = 0; m < 4; ++m)
#pragma unroll
                for (int n = 0; n < 2; ++n) PG8_ZERO4(acc[a][b][m][n]);
    }
    int f8one; asm volatile("s_mov_b32 %0, 0x7f7f7f7f" : "=s"(f8one));
    typedef int v4i_t __attribute__((ext_vector_type(4))); typedef int v8i_t __attribute__((ext_vector_type(8)));
    bf16x8 At[4][2], B0[2][2], B1[2][2]; v8i_t At8[4], B08[2], B18[2];
    const char* cA = (const char*)g.A + (size_t)cur.pa * tstep + (size_t)cur.kofs; const char* cB = (const char*)g.Bt + (size_t)cur.pb * tstep + (size_t)cur.hf * hstep + (size_t)cur.kofs;
    int nt = cur.nk;
    S.a_ready(cur);
    if constexpr (SP2 && HN) {
        static_assert(!HN || SP2, "HN needs SP2");
        PG8_STAGE(PG8_SB(0, 0), cB, voffB); PG8_STAGE(PG8_SA(0, 0), cA, voffA); PG8_STAGE(PG8_SA(0, 1), cA + hstep, voffA);
        if (wr == 1) PG8_BAR;
        PG8_WAIT_V(2); PG8_BAR;
        PG8_STAGE(PG8_SB(1, 0), cB + kstep, voffB); PG8_STAGE(PG8_SA(1, 0), cA + kstep, voffA);
        PG8_WAIT_V(4); PG8_BAR;
    } else if constexpr (SP2) {
        PG8_STAGE(PG8_SB(0, 0), cB, voffB); PG8_STAGE(PG8_SB(0, 1), cB + hstep, voffB); PG8_STAGE(PG8_SA(0, 0), cA, voffA); PG8_STAGE(PG8_SA(0, 1), cA + hstep, voffA);
        if (wr == 1) PG8_BAR;
        PG8_WAIT_V(2); PG8_BAR;
        PG8_STAGE(PG8_SB(1, 0), cB + kstep, voffB); PG8_STAGE(PG8_SA(1, 0), cA + kstep, voffA); PG8_STAGE(PG8_SB(1, 1), cB + hstep + kstep, voffB);
        PG8_WAIT_V(6); PG8_BAR;
    } else {
        PG8_STAGE(PG8_SB(0, 0), cB, voffB); PG8_STAGE(PG8_SA(0, 0), cA, voffA); PG8_STAGE(PG8_SB(0, 1), cB + hstep, voffB); PG8_STAGE(PG8_SA(0, 1), cA + hstep, voffA);
        if (wr == 1) PG8_BAR;
        PG8_WAIT_V(4); PG8_BAR;
        PG8_STAGE(PG8_SB(1, 0), cB + kstep, voffB); PG8_STAGE(PG8_SA(1, 0), cA + kstep, voffA); PG8_STAGE(PG8_SB(1, 1), cB + hstep + kstep, voffB);
        PG8_WAIT_V(6); PG8_BAR;
    }
    for (;;) {
        const bool has_next = S.next(ui + 1, nxt);
        const char* nA = has_next ? (const char*)g.A + (size_t)nxt.pa * tstep + (size_t)nxt.kofs : cA; const char* nB = has_next ? (const char*)g.Bt + (size_t)nxt.pb * tstep + (size_t)nxt.hf * hstep + (size_t)nxt.kofs : cB;
        for (int t = 0; t < nt; t += 2) {
            const bool last = (t == nt - 2);
            const char* a1 = cA + (size_t)(t + 1) * kstep;
            const char* a2 = last ? nA : cA + (size_t)(t + 2) * kstep; const char* b2 = last ? nB : cB + (size_t)(t + 2) * kstep;
            const char* a3 = a2 + kstep; const char* b3 = b2 + kstep;
            if (last && has_next) S.a_ready(nxt);
            if constexpr (SP2 && HN) {
            PG8_LDB(B0, 0, 0); PG8_SCHED; PG8_LDA(At, 0, 0); PG8_STAGE(PG8_SA(1, 1), a1 + hstep, voffA);
            PG8_WAIT_V(6); PG8_WAIT_L(0); PG8_BAR; PG8_MMAF(0, 0, At, B0); PG8_BAR; PG8_SCHED;
            PG8_LDA(At, 0, 1); PG8_STAGE(PG8_SB(0, 0), b2, voffB); PG8_STAGE(PG8_SA(0, 0), a2, voffA);
            PG8_WAIT_V(6); PG8_WAIT_L(0); PG8_BAR; PG8_MMAF(1, 0, At, B0); PG8_BAR; PG8_SCHED;
            PG8_LDB(B0, 1, 0); PG8_SCHED; PG8_LDA(At, 1, 0); PG8_STAGE(PG8_SA(0, 1), a2 + hstep, voffA);
            PG8_WAIT_V(6); PG8_WAIT_L(0); PG8_BAR; PG8_MMA(0, 0, At, B0); PG8_BAR; PG8_SCHED;
            PG8_LDA(At, 1, 1); PG8_STAGE(PG8_SB(1, 0), b3, voffB); PG8_STAGE(PG8_SA(1, 0), a3, voffA);
            PG8_WAIT_V(6); PG8_WAIT_L(0); PG8_BAR; PG8_MMA(1, 0, At, B0); PG8_BAR; PG8_SCHED;
            } else if constexpr (SP2) {
            PG8_LDB(B0, 0, 0); PG8_LDB(B1, 0, 1); PG8_SCHED; PG8_LDA(At, 0, 0); PG8_STAGE(PG8_SA(1, 1), a1 + hstep, voffA);
            PG8_WAIT_V(8); PG8_WAIT_L(0); PG8_BAR; PG8_MMAF(0, 0, At, B0); PG8_MMAF(0, 1, At, B1); PG8_BAR; PG8_SCHED;
            PG8_LDA(At, 0, 1); PG8_STAGE(PG8_SB(0, 0), b2, voffB); PG8_STAGE(PG8_SB(0, 1), b2 + hstep, voffB); PG8_STAGE(PG8_SA(0, 0), a2, voffA);
            PG8_WAIT_V(8); PG8_WAIT_L(0); PG8_BAR; PG8_MMAF(1, 0, At, B0); PG8_MMAF(1, 1, At, B1); PG8_BAR; PG8_SCHED;
            PG8_LDB(B0, 1, 0); PG8_LDB(B1, 1, 1); PG8_SCHED; PG8_LDA(At, 1, 0); PG8_STAGE(PG8_SA(0, 1), a2 + hstep, voffA);
            PG8_WAIT_V(8); PG8_WAIT_L(0); PG8_BAR; PG8_MMA(0, 0, At, B0); PG8_MMA(0, 1, At, B1); PG8_BAR; PG8_SCHED;
            PG8_LDA(At, 1, 1); PG8_STAGE(PG8_SB(1, 0), b3, voffB); PG8_STAGE(PG8_SB(1, 1), b3 + hstep, voffB); PG8_STAGE(PG8_SA(1, 0), a3, voffA);
            PG8_WAIT_V(8); PG8_WAIT_L(0); PG8_BAR; PG8_MMA(1, 0, At, B0); PG8_MMA(1, 1, At, B1); PG8_BAR; PG8_SCHED;
            } else {
            PG8_LDB(B0, 0, 0); PG8_SCHED; PG8_LDA(At, 0, 0); PG8_STAGE(PG8_SA(1, 1), a1 + hstep, voffA);
            PG8_WAIT_L(8); PG8_BAR; PG8_WAIT_L(0); PG8_MMA(0, 0, At, B0); PG8_BAR; PG8_SCHED;
            PG8_LDB(B1, 0, 1); PG8_STAGE(PG8_SB(0, 0), b2, voffB);
            PG8_BAR; PG8_WAIT_L(0); PG8_MMA(0, 1, At, B1); PG8_BAR;
            PG8_LDA(At, 0, 1); PG8_STAGE(PG8_SA(0, 0), a2, voffA);
            PG8_BAR; PG8_WAIT_L(0); PG8_MMA(1, 0, At, B0); PG8_BAR; PG8_SCHED;
            PG8_STAGE(PG8_SB(0, 1), b2 + hstep, voffB);
            PG8_WAIT_V(6); PG8_BAR; PG8_MMA(1, 1, At, B1); PG8_BAR;
            PG8_LDB(B0, 1, 0); PG8_SCHED; PG8_LDA(At, 1, 0); PG8_STAGE(PG8_SA(0, 1), a2 + hstep, voffA);
            PG8_WAIT_L(8); PG8_BAR; PG8_WAIT_L(0); PG8_MMA(0, 0, At, B0); PG8_BAR; PG8_SCHED;
            PG8_LDB(B1, 1, 1); PG8_STAGE(PG8_SB(1, 0), b3, voffB);
            PG8_BAR; PG8_WAIT_L(0); PG8_MMA(0, 1, At, B1); PG8_BAR;
            PG8_LDA(At, 1, 1); PG8_STAGE(PG8_SA(1, 0), a3, voffA);
            PG8_BAR; PG8_WAIT_L(0); PG8_MMA(1, 0, At, B0); PG8_BAR; PG8_SCHED;
            PG8_STAGE(PG8_SB(1, 1), b3 + hstep, voffB);
            PG8_WAIT_V(6); PG8_BAR; PG8_MMA(1, 1, At, B1); PG8_BAR;
            }
        }
        if constexpr (ALIGN_EPI) { if (wr == 0) PG8_BAR; }
        if constexpr (!Epi::AFTER_DRAIN) { E.template run<HN>(acc, cur, wr, wc, fr, fq); S.done(cur); }
        if (!has_next) break;
        if constexpr (!SP2 || F8) {
#pragma unroll
        for (int a = 0; a < 2; ++a)
#pragma unroll
            for (int b = 0; b < 2; ++b)
#pragma unroll
                for (int m = 0; m < 4; ++m)
#pragma unroll
                    for (int n = 0; n < 2; ++n) PG8_ZERO4(acc[a][b][m][n]);
        }
        cur = nxt; cA = nA; cB = nB; ++ui; nt = cur.nk;
        if constexpr (ALIGN_EPI) { if (wr == 1) PG8_BAR; }
    }
    PG8_WAIT_V(0);
    if constexpr (!ALIGN_EPI) { if (wr == 0) PG8_BAR; }
    PG8_BAR;
    if constexpr (Epi::AFTER_DRAIN) { E.fused(acc, cur, wr, wc, fr, fq, lds, wid, lane); S.done(cur); }
#undef PG8_SA
#undef PG8_SB
#undef PG8_STAGE
#undef PG8_LDA
#undef PG8_LDB
#undef PG8_MMA
#undef PG8_ZERO4
#undef PG8_MMAZ
#undef PG8_MMAF
#undef PG8_WAIT_V
#undef PG8_WAIT_L
#undef PG8_BAR
#undef PG8_SCHED
}
}

#define XB_TMO      128
#define XB_XCNT(j)  (256  + 64 * (j))
#define XB_XSUB(j)  (1280 + 64 * (j))
#define XB_XGEN(j)  (2304 + 64 * (j))
#define XB_TOP      3328
#define XB_TOPGEN   3392
#define XCD_BAR_WORDS 3456
#define XB_SPIN_CAP (1u << 18)
#ifndef XB_EARLY_WB
#define XB_EARLY_WB 0
#endif

__device__ __forceinline__ unsigned xb_ld(unsigned* p)              { return __hip_atomic_load(p, __ATOMIC_RELAXED, __HIP_MEMORY_SCOPE_AGENT); }
__device__ __forceinline__ unsigned xb_add(unsigned* p, unsigned v) { return __hip_atomic_fetch_add(p, v, __ATOMIC_RELAXED, __HIP_MEMORY_SCOPE_AGENT); }
__device__ __forceinline__ unsigned xb_xcc_id() { return (unsigned)__builtin_amdgcn_s_getreg((3 << 11) | 20) & 0xFu; }
#define XB_SPIN(cond, bar) do { unsigned _sp = 0; while (cond) { __builtin_amdgcn_s_sleep(1); \
    if ((++_sp & 255u) == 0u) { if (xb_ld(&(bar)[XB_TMO])) break; if (_sp > XB_SPIN_CAP) { atomicAdd(&(bar)[XB_TMO], 1u); break; } } } } while (0)

struct XcdBarrier {
    unsigned* bar; unsigned x; int wv;
    volatile LAS unsigned* st;
};

__device__ __forceinline__ XcdBarrier xcd_barrier_post(unsigned* bar, volatile LAS unsigned* st, int wv) {
    XcdBarrier b; b.bar = bar; b.x = xb_xcc_id(); b.st = st; b.wv = wv;
    if (wv == 0 && lane_id() == 0) (void)xb_add(&bar[XB_XCNT(b.x)], 1u);
    return b;
}
__device__ __forceinline__ void xcd_barrier_complete(unsigned* bar, unsigned x, unsigned& nloc, unsigned& nx) {
    const unsigned G = gridDim.x * gridDim.y * gridDim.z;
    unsigned sum, cnt, mine, sp = 0u;
    for (;;) {
        sum = 0u; cnt = 0u; mine = 0u;
#pragma unroll
        for (unsigned j = 0; j < 16; ++j) { const unsigned c = xb_ld(&bar[XB_XCNT(j)]); sum += c; cnt += (c > 0u) ? 1u : 0u; mine = (j == x) ? c : mine; }
        if (sum == G) break;
        __builtin_amdgcn_s_sleep(1);
        if ((++sp & 255u) == 0u) { if (xb_ld(&bar[XB_TMO])) break; if (sp > XB_SPIN_CAP) { atomicAdd(&bar[XB_TMO], 1u); break; } }
    }
    nloc = mine > 0u ? mine : 1u; nx = cnt > 0u ? cnt : 1u;
}

__device__ __forceinline__ void xcd_barrier(const XcdBarrier& b) {
    asm volatile("s_waitcnt vmcnt(0)" ::: "memory");
    __syncthreads();
    if (b.wv == 0 && lane_id() == 0) {
        unsigned* bar = b.bar;
        __builtin_amdgcn_s_waitcnt(0);
        unsigned nloc = b.st[0], nx = b.st[1];
        if (nloc == 0u) { xcd_barrier_complete(bar, b.x, nloc, nx); b.st[0] = nloc; b.st[1] = nx; }
#if XB_EARLY_WB
        __builtin_amdgcn_fence(__ATOMIC_RELEASE, "agent");
#endif
        const unsigned old = xb_add(&bar[XB_XSUB(b.x)], 1u);
        const unsigned gen = old / nloc;
        if (old + 1u == (gen + 1u) * nloc) {
            __builtin_amdgcn_fence(__ATOMIC_RELEASE, "agent");
            asm volatile("s_waitcnt vmcnt(0)" ::: "memory");
            const unsigned og = xb_add(&bar[XB_TOP], 1u);
            const unsigned tg = og / nx;
            if (og + 1u == (tg + 1u) * nx) xb_add(&bar[XB_TOPGEN], 1u);
            else XB_SPIN(xb_ld(&bar[XB_TOPGEN]) == tg, bar);
            __builtin_amdgcn_fence(__ATOMIC_ACQUIRE, "agent");
            xb_add(&bar[XB_XGEN(b.x)], 1u);
            asm volatile("s_waitcnt vmcnt(0)" ::: "memory");
        } else {
            XB_SPIN(xb_ld(&bar[XB_XGEN(b.x)]) == gen, bar);
            __builtin_amdgcn_fence(__ATOMIC_ACQUIRE, "agent");
            asm volatile("s_waitcnt vmcnt(0)" ::: "memory");
        }
    }
    __syncthreads();
}

#ifndef SWA_FIXM
#define SWA_FIXM 1
#endif
#ifndef FD_SPREAD
#define FD_SPREAD 1
#endif
#ifndef DIFF_GRPB
#define DIFF_GRPB 1
#endif
#ifndef DIFF_STAG
#define DIFF_STAG 1
#endif
__device__ __forceinline__ int crow(int e, int h) { return (e & 3) + 8 * (e >> 2) + 4 * h; }
__device__ __forceinline__ float xhalf_max(float m) { auto rr = __builtin_amdgcn_permlane32_swap(__float_as_uint(m), __float_as_uint(m), false, false); return fmaxf(__uint_as_float(rr[0]), __uint_as_float(rr[1])); }
__device__ __forceinline__ float xhalf_sum(float m) { auto rr = __builtin_amdgcn_permlane32_swap(__float_as_uint(m), __float_as_uint(m), false, false); return __uint_as_float(rr[0]) + __uint_as_float(rr[1]); }
typedef short v4i16_t __attribute__((ext_vector_type(4)));
__device__ __forceinline__ void glds16(const void* gsrc, unsigned lds_dst) { unsigned keep;
    asm volatile("s_mov_b32 %0, m0\n\ts_mov_b32 m0, %2\n\ts_nop 0\n\tglobal_load_lds_dwordx4 %1, off\n\ts_mov_b32 m0, %0" : "=&s"(keep) : "v"(gsrc), "s"(lds_dst) : "memory"); }
__device__ __forceinline__ s16x4 vtr(LAS unsigned char* p) { return __builtin_bit_cast(s16x4, __builtin_amdgcn_ds_read_tr16_b64_v4i16((LAS v4i16_t*)p)); }

__device__ __forceinline__ f32x16 mfma_from_c(bf16x8 a, bf16x8 b, const f32x16& c) {
    f32x16 d; asm("s_nop 1\n\tv_mfma_f32_32x32x16_bf16 %0, %1, %2, %3" : "=&v"(d) : "v"(a), "v"(b), "v"(c)); return d;
}

struct TrJob { const float* W; unsigned char* WT; int N, K, kind, k0, n0; float f8s; };
struct NoJobs { __device__ __forceinline__ bool operator()(int, TrJob&) const { return false; } };
__device__ __forceinline__ int rowmap(int kind, int n);
__device__ __forceinline__ void tr_issue(const TrJob& J, int lane, f32x4 (&v)[8]) {
    const float* wp = J.W + (size_t)(J.k0 + (lane >> 3)) * J.N + J.n0 + 4 * (lane & 7);
#pragma unroll
    for (int i = 0; i < 8; ++i) v[i] = *(const GAS f32x4*)(wp + (size_t)(8 * i) * J.N);
}
__device__ __forceinline__ void tr_finish(const TrJob& J, LAS float* scr, int lane, const f32x4 (&v)[8]) {
#pragma unroll
    for (int i = 0; i < 8; ++i) { LAS float* d = scr + (8 * i + (lane >> 3)) * 33 + 4 * (lane & 7); d[0] = v[i][0]; d[1] = v[i][1]; d[2] = v[i][2]; d[3] = v[i][3]; }
    asm volatile("s_waitcnt lgkmcnt(0)" ::: "memory");
    const int c = lane & 7; const float f8s = J.f8s;
#pragma unroll
    for (int j = 0; j < 4; ++j) { const int n = (lane >> 3) + 8 * j; const LAS float* s = scr + (8 * c) * 33 + n;
        u32x2 o; o.x = cvt4_fp8(s[0 * 33] * f8s, s[1 * 33] * f8s, s[2 * 33] * f8s, s[3 * 33] * f8s); o.y = cvt4_fp8(s[4 * 33] * f8s, s[5 * 33] * f8s, s[6 * 33] * f8s, s[7 * 33] * f8s);
        *(GAS u32x2*)(J.WT + (size_t)rowmap(J.kind, J.n0 + n) * J.K + J.k0 + 8 * c) = o; }
    asm volatile("s_waitcnt lgkmcnt(0)" ::: "memory");
}
template <int NCOMP, int KSTEPS, bool MASK, bool FIXM, class JF = NoJobs>
__device__ __forceinline__ void flash_unit(LAS unsigned char* lds, const int wv, const bf16_t* qrow, const bf16_t* Kb, const bf16_t* Vb, int ntiles, int kb0, int qabs,
                                           float m0, float l0, const float* kmax, f32x16 (&o)[NCOMP][2], float (&lsum)[NCOMP], JF jf = JF(), int kord = 0) {
    const int tid = opaque_tid(wv), lane = tid & 63, r = lane & 31, h = lane >> 5;
    constexpr bool JOBS = !__is_same(JF, NoJobs);
    f32x4 tv[8]; TrJob TJ; TJ.W = nullptr; TJ.WT = nullptr; TJ.N = 0; TJ.K = 0; TJ.kind = 0; TJ.k0 = 0; TJ.n0 = 0; TJ.f8s = 0.f; bool tpend = false;
#pragma unroll
    for (int i = 0; i < 8; ++i) tv[i] = f32x4{0.f, 0.f, 0.f, 0.f};
    bf16x8 q[NCOMP][KSTEPS];
#pragma unroll
    for (int m = 0; m < NCOMP; ++m)
#pragma unroll
        for (int s = 0; s < KSTEPS; ++s) q[m][s] = *(const GAS bf16x8*)(qrow + m * 32 + 16 * s + 8 * h);
    float mrun[NCOMP], lrun[NCOMP];
    f32x16 negm;
    if (FIXM) {
        float bmax = 0.f;
#pragma unroll
        for (int m = 0; m < NCOMP; ++m) { float qq = 0.f;
#pragma unroll
            for (int s = 0; s < KSTEPS; ++s)
#pragma unroll
                for (int j = 0; j < 8; ++j) { const float x = bf2f((unsigned short)q[m][s][j]); qq += x * x; }
            qq = xhalf_sum(qq);
            bmax = fmaxf(bmax, __builtin_amdgcn_sqrtf(qq) * kmax[m]); }
        const float ref = fmaxf(bmax * 1.001f + 1e-3f, m0);
        l0 = l0 * fast_exp2(m0 - ref);
#pragma unroll
        for (int e = 0; e < 16; ++e) negm[e] = -ref;
    }
#pragma unroll
    for (int m = 0; m < NCOMP; ++m) { mrun[m] = m0; lrun[m] = (h == 0) ? l0 : 0.f; o[m][0] = f32x16{}; o[m][1] = f32x16{}; }
    bf16x8 onesA; f32x4 lacc[NCOMP];
    { const int g_ = lane >> 4, mr_ = lane & 15; const short v_ = ((mr_ == 0 && !(g_ & 1)) || (mr_ == 1 && (g_ & 1))) ? (short)0x3F80 : (short)0;
      onesA = (bf16x8){v_, v_, v_, v_, v_, v_, v_, v_}; }
#pragma unroll
    for (int m = 0; m < NCOMP; ++m) lacc[m] = f32x4{0.f, 0.f, 0.f, 0.f};
    const int wid_u = __builtin_amdgcn_readfirstlane(tid >> 6);
    const int srow = tid >> 3, scl = tid & 7;
    const size_t ksoff = (size_t)srow * 64 + ((scl ^ ((srow >> 1) & 7)) << 3);
    const size_t vsoff = (size_t)srow * 64 + ((scl ^ (((srow >> 1) & 1) << 2)) << 3);
    const unsigned lds0 = (unsigned)(uintptr_t)lds + (unsigned)wid_u * 1024u;
#define FA_STAGE(bufsel, krow_) do { const size_t g0_ = (size_t)(krow_) * 64; const unsigned d_ = (unsigned)__builtin_amdgcn_readfirstlane((int)(lds0 + (unsigned)(bufsel) * 16384u)); \
        glds16(Kb + g0_ + ksoff, d_); glds16(Vb + g0_ + vsoff, d_ + 8192u); } while (0)
    const int kswz = (r >> 1) & 7, kro = r * 128;
    const int q4 = (lane & 15) >> 2, p4 = lane & 3, grp = (lane >> 4) & 1;
    const int vro = 8192 + (4 * h + q4) * 128, vcol = grp * 32 + p4 * 8, vswz = ((q4 >> 1) & 1) << 6;
    FA_STAGE(0, 0);
    asm volatile("s_waitcnt vmcnt(0)" ::: "memory"); __syncthreads();
#pragma nounroll
    for (int it = 0; it < ntiles; ++it) {
        LAS unsigned char* buf = lds + (it & 1) * 16384;
        const bool more = it + 1 < ntiles;
        if (more) { const int kn = (it + 1 < 4) ? 64 * (it + 1) : kb0 + 64 * (it + 1 - 4); FA_STAGE((it + 1) & 1, kn); }
        bool tnew = false;
        if (JOBS && (it == 1 || it == 3 || it == 5)) { tnew = jf(kord + it - 1, TJ); if (tnew) tr_issue(TJ, lane, tv); }
        const int ktile = (it < 4) ? 64 * it : kb0 + 64 * (it - 4);
        bf16x8 pk[NCOMP][4];
        bf16x8 ka[NCOMP][KSTEPS][2];
#pragma unroll
        for (int m = 0; m < NCOMP; ++m)
#pragma unroll
            for (int s = 0; s < KSTEPS; ++s) { const int c = m * 4 + 2 * s + h;
                ka[m][s][0] = *(LAS bf16x8*)(buf + kro + ((c ^ kswz) << 4)); ka[m][s][1] = *(LAS bf16x8*)(buf + 4096 + kro + ((c ^ kswz) << 4)); }
        f32x16 sc[NCOMP][2];
#pragma unroll
        for (int m = 0; m < NCOMP; ++m) {
            if (FIXM) { sc[m][0] = mfma_from_c(ka[m][0][0], q[m][0], negm); sc[m][1] = mfma_from_c(ka[m][0][1], q[m][0], negm); }
            else { sc[m][0] = __builtin_amdgcn_mfma_f32_32x32x16_bf16(ka[m][0][0], q[m][0], f32x16{}, 0, 0, 0); sc[m][1] = __builtin_amdgcn_mfma_f32_32x32x16_bf16(ka[m][0][1], q[m][0], f32x16{}, 0, 0, 0); }
#pragma unroll
            for (int s = 1; s < KSTEPS; ++s) {
                sc[m][0] = __builtin_amdgcn_mfma_f32_32x32x16_bf16(ka[m][s][0], q[m][s], sc[m][0], 0, 0, 0);
                sc[m][1] = __builtin_amdgcn_mfma_f32_32x32x16_bf16(ka[m][s][1], q[m][s], sc[m][1], 0, 0, 0);
            }
        }
        bf16x8 vf[2][4];
#pragma unroll
        for (int db = 0; db < 2; ++db)
#pragma unroll
            for (int ks = 0; ks < 4; ++ks) { LAS unsigned char* vp = buf + vro + ks * 2048 + ((db * 64 + vcol) ^ vswz);
                const s16x4 lo = vtr(vp), hi = vtr(vp + 1024);
                vf[db][ks] = (bf16x8){lo[0], lo[1], lo[2], lo[3], hi[0], hi[1], hi[2], hi[3]}; }
#pragma unroll
        for (int m = 0; m < NCOMP; ++m) {
            f32x16 s0 = sc[m][0], s1 = sc[m][1];
            if (MASK && (it == 4 || it == ntiles - 1)) {
                const int kt0 = ktile - CTX - qabs + 4 * h;
#pragma unroll
                for (int e = 0; e < 16; ++e) { const int d0 = kt0 + (e & 3) + 8 * (e >> 2), d1 = d0 + 32;
                    if (d0 > 128 || d0 < -128) s0[e] = -1e30f;
                    if (d1 > 128 || d1 < -128) s1[e] = -1e30f; }
            }
            if (FIXM) {
#pragma unroll
                for (int e = 0; e < 16; ++e) { s0[e] = fast_exp2(s0[e]); s1[e] = fast_exp2(s1[e]); }
            } else {
            float mx = fmaxf(s0[0], s1[0]);
#pragma unroll
            for (int e = 1; e < 16; ++e) mx = fmaxf(mx, fmaxf(s0[e], s1[e]));
            mx = xhalf_max(mx);
            const float mn = fmaxf(mrun[m], mx), alpha = fast_exp2(mrun[m] - mn); mrun[m] = mn;
            float ps = 0.f;
#pragma unroll
            for (int e = 0; e < 16; ++e) { s0[e] = fast_exp2(s0[e] - mn); s1[e] = fast_exp2(s1[e] - mn); ps += s0[e] + s1[e]; }
            lrun[m] = lrun[m] * alpha + ps;
            if (__any(alpha != 1.f)) { o[m][0] = o[m][0] * alpha; o[m][1] = o[m][1] * alpha; }
            }
            u32x4 w;
            w.x = cvtpk(s0[0], s0[1]); w.y = cvtpk(s0[2], s0[3]); w.z = cvtpk(s0[4], s0[5]); w.w = cvtpk(s0[6], s0[7]); pk[m][0] = __builtin_bit_cast(bf16x8, w);
            w.x = cvtpk(s0[8], s0[9]); w.y = cvtpk(s0[10], s0[11]); w.z = cvtpk(s0[12], s0[13]); w.w = cvtpk(s0[14], s0[15]); pk[m][1] = __builtin_bit_cast(bf16x8, w);
            w.x = cvtpk(s1[0], s1[1]); w.y = cvtpk(s1[2], s1[3]); w.z = cvtpk(s1[4], s1[5]); w.w = cvtpk(s1[6], s1[7]); pk[m][2] = __builtin_bit_cast(bf16x8, w);
            w.x = cvtpk(s1[8], s1[9]); w.y = cvtpk(s1[10], s1[11]); w.z = cvtpk(s1[12], s1[13]); w.w = cvtpk(s1[14], s1[15]); pk[m][3] = __builtin_bit_cast(bf16x8, w);
#pragma unroll
            for (int db = 0; db < 2; ++db)
#pragma unroll
                for (int ks = 0; ks < 4; ++ks) o[m][db] = __builtin_amdgcn_mfma_f32_32x32x16_bf16(vf[db][ks], pk[m][ks], o[m][db], 0, 0, 0);
            if (FIXM) {
#pragma unroll
                for (int ks = 0; ks < 4; ++ks) lacc[m] = __builtin_amdgcn_mfma_f32_16x16x32_bf16(onesA, pk[m][ks], lacc[m], 0, 0, 0);
            }
        }
        if (JOBS && tpend) tr_finish(TJ, (LAS float*)(lds + 32768 + wid_u * 8448), lane, tv);
        tpend = tnew;
        if (JOBS && tnew) asm volatile("s_waitcnt vmcnt(8)" ::: "memory"); else asm volatile("s_waitcnt vmcnt(0)" ::: "memory");
        __syncthreads();
    }
#pragma unroll
    for (int m = 0; m < NCOMP; ++m) {
        if (FIXM) { const float a0 = __shfl(lacc[m][0], r & 15), a1 = __shfl(lacc[m][1], r & 15); lsum[m] = ((r >> 4) ? a1 : a0) + l0; }
        else lsum[m] = xhalf_sum(lrun[m]);
    }
#undef FA_STAGE
}

#define FD_SB() __builtin_amdgcn_sched_barrier(0)
#ifndef FD_DUM3
#define FD_DUM3 0
#endif
#ifndef FD_DUM4
#define FD_DUM4 0
#endif
#ifndef FD_DUMOP
#define FD_DUMOP "v_exp_f32 %0, %1"
#endif
#define FD_DUMMY(n_) do { _Pragma("unroll") for (int d_ = 0; d_ < (n_); ++d_) { float dd_; asm volatile(FD_DUMOP : "=v"(dd_) : "v"(negm[0])); } } while (0)
template <bool GRPB>
__device__ __forceinline__ void flash_diff(LAS unsigned char* lds, const int wv, const bf16_t* qrow, const bf16_t* Kb, const bf16_t* Vb, int ntiles, int kb0, const float* kmax,
                                           f32x16 (&o)[2][2], float (&lsum)[2]) {
    const int tid = opaque_tid(wv), lane = tid & 63, r = lane & 31, h = lane >> 5;
    bf16x8 q[2][2];
#pragma unroll
    for (int m = 0; m < 2; ++m)
#pragma unroll
        for (int s = 0; s < 2; ++s) q[m][s] = *(const GAS bf16x8*)(qrow + m * 32 + 16 * s + 8 * h);
    f32x16 negm;
    { float bmax = 0.f;
#pragma unroll
      for (int m = 0; m < 2; ++m) { float qq = 0.f;
#pragma unroll
          for (int s = 0; s < 2; ++s)
#pragma unroll
              for (int j = 0; j < 8; ++j) { const float x = bf2f((unsigned short)q[m][s][j]); qq += x * x; }
          qq = xhalf_sum(qq);
          bmax = fmaxf(bmax, __builtin_amdgcn_sqrtf(qq) * kmax[m]); }
      const float ref = bmax * 1.001f + 1e-3f;
#pragma unroll
      for (int e = 0; e < 16; ++e) negm[e] = -ref; }
    bf16x8 onesA; f32x4 lacc[2];
    { const int g_ = lane >> 4, mr_ = lane & 15; const short v_ = ((mr_ == 0 && !(g_ & 1)) || (mr_ == 1 && (g_ & 1))) ? (short)0x3F80 : (short)0;
      onesA = (bf16x8){v_, v_, v_, v_, v_, v_, v_, v_}; }
#pragma unroll
    for (int m = 0; m < 2; ++m) { lacc[m] = f32x4{0.f, 0.f, 0.f, 0.f}; o[m][0] = f32x16{}; o[m][1] = f32x16{}; }
    const int wid_u = __builtin_amdgcn_readfirstlane(tid >> 6);
    const int srow = tid >> 3, scl = tid & 7;
    const size_t ksoff = (size_t)srow * 64 + ((scl ^ ((srow >> 1) & 7)) << 3);
    const size_t vsoff = (size_t)srow * 64 + ((scl ^ (((srow >> 1) & 1) << 2)) << 3);
    const unsigned lds0 = (unsigned)(uintptr_t)lds + (unsigned)wid_u * 1024u;
#define FD_STAGE(bufsel, krow_) do { const size_t g0_ = (size_t)(krow_) * 64; const unsigned d_ = (unsigned)__builtin_amdgcn_readfirstlane((int)(lds0 + (unsigned)(bufsel) * 16384u)); \
        glds16(Kb + g0_ + ksoff, d_); glds16(Vb + g0_ + vsoff, d_ + 8192u); } while (0)
#define FD_KROW(t_) (((t_) < 4) ? 64 * (t_) : kb0 + 64 * ((t_) - 4))
#define FD_SYNC(it_) do { asm volatile("s_waitcnt vmcnt(0)" ::: "memory"); __syncthreads(); const int tn_ = ((it_) + 2 < ntiles) ? (it_) + 2 : ntiles - 1; FD_STAGE((it_) & 1, FD_KROW(tn_)); } while (0)
#define FD_EXP4(v_, e0_) do { _Pragma("unroll") for (int e_ = (e0_); e_ < (e0_) + 4; ++e_) v_[e_] = fast_exp2(v_[e_]); } while (0)
#define FD_PACK(dst_, v_, e0_) do { u32x4 w_; w_.x = cvtpk(v_[(e0_)], v_[(e0_) + 1]); w_.y = cvtpk(v_[(e0_) + 2], v_[(e0_) + 3]); w_.z = cvtpk(v_[(e0_) + 4], v_[(e0_) + 5]); w_.w = cvtpk(v_[(e0_) + 6], v_[(e0_) + 7]); \
        dst_ = __builtin_bit_cast(bf16x8, w_); } while (0)
#define FD_MFMA(a_, b_, c_) __builtin_amdgcn_mfma_f32_32x32x16_bf16(a_, b_, c_, 0, 0, 0)
#define FD_SUM(m_, b_) lacc[m_] = __builtin_amdgcn_mfma_f32_16x16x32_bf16(onesA, b_, lacc[m_], 0, 0, 0)
    const int kswz = (r >> 1) & 7, kro = r * 128;
    const int q4 = (lane & 15) >> 2, p4 = lane & 3, grp = (lane >> 4) & 1;
    const int vro = 8192 + (4 * h + q4) * 128, vcol = grp * 32 + p4 * 8, vswz = ((q4 >> 1) & 1) << 6;
    FD_STAGE(0, 0);
    asm volatile("s_waitcnt vmcnt(0)" ::: "memory"); __syncthreads();
    FD_STAGE(1, FD_KROW(1));
#pragma nounroll
    for (int it = 0; it < ntiles; ++it) {
        LAS unsigned char* buf = lds + (it & 1) * 16384;
        bf16x8 ka[2][2][2];
#pragma unroll
        for (int m = 0; m < 2; ++m)
#pragma unroll
            for (int s = 0; s < 2; ++s) { const int c = m * 4 + 2 * s + h;
                ka[m][s][0] = *(LAS bf16x8*)(buf + kro + ((c ^ kswz) << 4)); ka[m][s][1] = *(LAS bf16x8*)(buf + 4096 + kro + ((c ^ kswz) << 4)); }
#if FD_SPREAD == 3
        f32x16 s00 = mfma_from_c(ka[0][0][0], q[0][0], negm); s00 = FD_MFMA(ka[0][1][0], q[0][1], s00);
        bf16x8 vf[2][4];
#pragma unroll
        for (int db = 0; db < 2; ++db)
#pragma unroll
            for (int ks = 0; ks < 4; ++ks) { LAS unsigned char* vp = buf + vro + ks * 2048 + ((db * 64 + vcol) ^ vswz);
                const s16x4 lo = vtr(vp), hi = vtr(vp + 1024);
                vf[db][ks] = (bf16x8){lo[0], lo[1], lo[2], lo[3], hi[0], hi[1], hi[2], hi[3]}; }
        FD_SB();
        f32x16 s01 = mfma_from_c(ka[0][0][1], q[0][0], negm); FD_EXP4(s00, 0); FD_SB();
        s01 = FD_MFMA(ka[0][1][1], q[0][1], s01); FD_EXP4(s00, 4); FD_SB();
        f32x16 s10 = mfma_from_c(ka[1][0][0], q[1][0], negm); FD_EXP4(s00, 8); FD_SB();
        f32x16 s11 = mfma_from_c(ka[1][0][1], q[1][0], negm); FD_EXP4(s00, 12); FD_SB();
        bf16x8 pk0[4], pk1[4];
        s10 = FD_MFMA(ka[1][1][0], q[1][1], s10); FD_PACK(pk0[0], s00, 0); FD_EXP4(s01, 0); FD_SB();
        s11 = FD_MFMA(ka[1][1][1], q[1][1], s11); FD_PACK(pk0[1], s00, 8); FD_EXP4(s01, 4); FD_SB();
        o[0][0] = FD_MFMA(vf[0][0], pk0[0], o[0][0]); FD_EXP4(s01, 8); FD_PACK(pk0[2], s01, 0); FD_SB();
        o[0][1] = FD_MFMA(vf[1][0], pk0[0], o[0][1]); FD_EXP4(s01, 12); FD_SB();
        o[0][0] = FD_MFMA(vf[0][1], pk0[1], o[0][0]); FD_PACK(pk0[3], s01, 8); FD_EXP4(s10, 0); FD_SB();
        o[0][1] = FD_MFMA(vf[1][1], pk0[1], o[0][1]); FD_EXP4(s10, 4); FD_SUM(0, pk0[0]); FD_SB();
        o[0][0] = FD_MFMA(vf[0][2], pk0[2], o[0][0]); FD_EXP4(s10, 8); FD_PACK(pk1[0], s10, 0); FD_SB();
        o[0][1] = FD_MFMA(vf[1][2], pk0[2], o[0][1]); FD_EXP4(s10, 12); FD_SUM(0, pk0[1]); FD_SB();
        o[0][0] = FD_MFMA(vf[0][3], pk0[3], o[0][0]); FD_PACK(pk1[1], s10, 8); FD_EXP4(s11, 0); FD_SUM(0, pk0[2]); FD_SB();
        o[0][1] = FD_MFMA(vf[1][3], pk0[3], o[0][1]); FD_EXP4(s11, 4); FD_SUM(0, pk0[3]); FD_SB();
        o[1][0] = FD_MFMA(vf[0][0], pk1[0], o[1][0]); FD_EXP4(s11, 8); FD_PACK(pk1[2], s11, 0); FD_SB();
        o[1][1] = FD_MFMA(vf[1][0], pk1[0], o[1][1]); FD_EXP4(s11, 12); FD_SUM(1, pk1[0]); FD_SB();
        o[1][0] = FD_MFMA(vf[0][1], pk1[1], o[1][0]); FD_PACK(pk1[3], s11, 8); FD_SB();
        o[1][1] = FD_MFMA(vf[1][1], pk1[1], o[1][1]); FD_SUM(1, pk1[1]); FD_SB();
        o[1][0] = FD_MFMA(vf[0][2], pk1[2], o[1][0]); FD_SB(); o[1][1] = FD_MFMA(vf[1][2], pk1[2], o[1][1]); FD_SUM(1, pk1[2]); FD_SB();
        o[1][0] = FD_MFMA(vf[0][3], pk1[3], o[1][0]); FD_SB(); o[1][1] = FD_MFMA(vf[1][3], pk1[3], o[1][1]); FD_SUM(1, pk1[3]); FD_SB();
#else
        f32x16 s00 = mfma_from_c(ka[0][0][0], q[0][0], negm), s01 = mfma_from_c(ka[0][0][1], q[0][0], negm);
        s00 = FD_MFMA(ka[0][1][0], q[0][1], s00); s01 = FD_MFMA(ka[0][1][1], q[0][1], s01);
        bf16x8 vf[2][4];
#pragma unroll
        for (int db = 0; db < 2; ++db)
#pragma unroll
            for (int ks = 0; ks < 4; ++ks) { LAS unsigned char* vp = buf + vro + ks * 2048 + ((db * 64 + vcol) ^ vswz);
                const s16x4 lo = vtr(vp), hi = vtr(vp + 1024);
                vf[db][ks] = (bf16x8){lo[0], lo[1], lo[2], lo[3], hi[0], hi[1], hi[2], hi[3]}; }
        FD_SB();
        f32x16 s10 = mfma_from_c(ka[1][0][0], q[1][0], negm); FD_EXP4(s00, 0); FD_SB();
        f32x16 s11 = mfma_from_c(ka[1][0][1], q[1][0], negm); FD_EXP4(s00, 4); FD_SB();
        s10 = FD_MFMA(ka[1][1][0], q[1][1], s10); FD_EXP4(s00, 8); FD_SB();
        s11 = FD_MFMA(ka[1][1][1], q[1][1], s11); FD_EXP4(s00, 12); FD_SB();
#if FD_SPREAD
        bf16x8 pk0[4], pk1[4];
        FD_PACK(pk0[0], s00, 0); FD_PACK(pk0[1], s00, 8);
        FD_SB();
        if (GRPB) { FD_SYNC(it); FD_SB(); }
        o[0][0] = FD_MFMA(vf[0][0], pk0[0], o[0][0]); FD_EXP4(s01, 0); FD_SB();
        o[0][1] = FD_MFMA(vf[1][0], pk0[0], o[0][1]); FD_EXP4(s01, 4); FD_PACK(pk0[2], s01, 0); FD_SB();
        o[0][0] = FD_MFMA(vf[0][1], pk0[1], o[0][0]); FD_EXP4(s01, 8); FD_SB();
        o[0][1] = FD_MFMA(vf[1][1], pk0[1], o[0][1]); FD_EXP4(s01, 12); FD_PACK(pk0[3], s01, 8); FD_SUM(0, pk0[0]); FD_SB();
        o[0][0] = FD_MFMA(vf[0][2], pk0[2], o[0][0]); FD_EXP4(s10, 0); FD_SB();
        o[0][1] = FD_MFMA(vf[1][2], pk0[2], o[0][1]); FD_EXP4(s10, 4); FD_PACK(pk1[0], s10, 0); FD_SUM(0, pk0[1]); FD_SB();
        o[0][0] = FD_MFMA(vf[0][3], pk0[3], o[0][0]); FD_EXP4(s10, 8); FD_SUM(0, pk0[2]); FD_SB();
        o[0][1] = FD_MFMA(vf[1][3], pk0[3], o[0][1]); FD_EXP4(s10, 12); FD_PACK(pk1[1], s10, 8); FD_SUM(0, pk0[3]); FD_SB();
        o[1][0] = FD_MFMA(vf[0][0], pk1[0], o[1][0]); FD_EXP4(s11, 0); FD_SB();
        o[1][1] = FD_MFMA(vf[1][0], pk1[0], o[1][1]); FD_EXP4(s11, 4); FD_PACK(pk1[2], s11, 0); FD_SUM(1, pk1[0]); FD_SB();
        o[1][0] = FD_MFMA(vf[0][1], pk1[1], o[1][0]); FD_EXP4(s11, 8); FD_SB();
        o[1][1] = FD_MFMA(vf[1][1], pk1[1], o[1][1]); FD_EXP4(s11, 12); FD_PACK(pk1[3], s11, 8); FD_SUM(1, pk1[1]); FD_SB();
        o[1][0] = FD_MFMA(vf[0][2], pk1[2], o[1][0]); FD_SB(); o[1][1] = FD_MFMA(vf[1][2], pk1[2], o[1][1]); FD_SUM(1, pk1[2]); FD_SB();
        o[1][0] = FD_MFMA(vf[0][3], pk1[3], o[1][0]); FD_SB(); o[1][1] = FD_MFMA(vf[1][3], pk1[3], o[1][1]); FD_SUM(1, pk1[3]); FD_SB();
#else
        bf16x8 pk0[4], pk1[4];
        FD_PACK(pk0[0], s00, 0); FD_PACK(pk0[1], s00, 8);
        FD_EXP4(s01, 0); FD_EXP4(s01, 4); FD_EXP4(s01, 8); FD_EXP4(s01, 12);
        FD_PACK(pk0[2], s01, 0); FD_PACK(pk0[3], s01, 8);
        FD_SB();
        if (GRPB) { FD_SYNC(it); FD_SB(); }
        o[0][0] = FD_MFMA(vf[0][0], pk0[0], o[0][0]); FD_EXP4(s10, 0); FD_DUMMY(FD_DUM3); FD_SB();
        o[0][1] = FD_MFMA(vf[1][0], pk0[0], o[0][1]); FD_EXP4(s10, 4); FD_DUMMY(FD_DUM3); FD_SB();
        o[0][0] = FD_MFMA(vf[0][1], pk0[1], o[0][0]); FD_EXP4(s10, 8); FD_PACK(pk1[0], s10, 0); FD_DUMMY(FD_DUM3); FD_SB();
        o[0][1] = FD_MFMA(vf[1][1], pk0[1], o[0][1]); FD_EXP4(s10, 12); FD_SUM(0, pk0[0]); FD_DUMMY(FD_DUM3); FD_SB();
        o[0][0] = FD_MFMA(vf[0][2], pk0[2], o[0][0]); FD_EXP4(s11, 0); FD_PACK(pk1[1], s10, 8); FD_DUMMY(FD_DUM3); FD_SB();
        o[0][1] = FD_MFMA(vf[1][2], pk0[2], o[0][1]); FD_EXP4(s11, 4); FD_SUM(0, pk0[1]); FD_DUMMY(FD_DUM3); FD_SB();
        o[0][0] = FD_MFMA(vf[0][3], pk0[3], o[0][0]); FD_EXP4(s11, 8); FD_PACK(pk1[2], s11, 0); FD_SUM(0, pk0[2]); FD_DUMMY(FD_DUM3); FD_SB();
        o[0][1] = FD_MFMA(vf[1][3], pk0[3], o[0][1]); FD_EXP4(s11, 12); FD_PACK(pk1[3], s11, 8); FD_SUM(0, pk0[3]); FD_DUMMY(FD_DUM3); FD_SB();
#pragma unroll
        for (int ks = 0; ks < 4; ++ks) { o[1][0] = FD_MFMA(vf[0][ks], pk1[ks], o[1][0]); FD_DUMMY(FD_DUM4); FD_SB(); o[1][1] = FD_MFMA(vf[1][ks], pk1[ks], o[1][1]); FD_DUMMY(FD_DUM4); FD_SUM(1, pk1[ks]); FD_SB(); }
#endif
#endif
        FD_SB();
        if (!GRPB) FD_SYNC(it);
    }
    asm volatile("s_waitcnt vmcnt(0)" ::: "memory"); __syncthreads();
#pragma unroll
    for (int m = 0; m < 2; ++m) { const float a0 = __shfl(lacc[m][0], r & 15), a1 = __shfl(lacc[m][1], r & 15); lsum[m] = (r >> 4) ? a1 : a0; }
#undef FD_STAGE
#undef FD_KROW
#undef FD_SYNC
#undef FD_EXP4
#undef FD_PACK
#undef FD_MFMA
#undef FD_SUM
}

__device__ __forceinline__ void store_ot(bf16_t* dst, const f32x16 (&v)[2], int h) {
#pragma unroll
    for (int db = 0; db < 2; ++db)
#pragma unroll
        for (int e4 = 0; e4 < 4; ++e4) { u32x2 w; w.x = cvtpk(v[db][4 * e4], v[db][4 * e4 + 1]); w.y = cvtpk(v[db][4 * e4 + 2], v[db][4 * e4 + 3]);
            *(GAS u32x2*)(dst + 32 * db + 8 * e4 + 4 * h) = w; }
}

struct AttnArgs { const bf16_t *QS, *KS, *VS, *QD, *KD, *VD; bf16_t* MIX; const float *sink, *dlam, *dng; float lam_init; const float* kmax; };

template <class JF = NoJobs>
__device__ __forceinline__ void swa_unit(LAS unsigned char* lds, const int wv, const AttnArgs& A, int b, int hk, int jq, bool ctxq, JF jf = JF(), int kord = 0) {
    const int tid = opaque_tid(wv), lane = tid & 63, wid = tid >> 6, r = lane & 31, h = lane >> 5;
    const int head = hk * 4 + (wid >> 1), qpos = 64 * jq + 32 * (wid & 1) + r;
    const int row = ctxq ? TL + b * CTX + qpos : b * SEQ + qpos;
    const bf16_t* qrow = A.QS + (size_t)row * 512 + head * 64;
    const bf16_t* Kb = A.KS + (size_t)(b * 2 + hk) * KEYS * 64; const bf16_t* Vb = A.VS + (size_t)(b * 2 + hk) * KEYS * 64;
    int ntiles = 4, kb0 = CTX;
    if (!ctxq) { const int q0 = 64 * jq; int lo = q0 - 128; if (lo < 0) lo = 0; int hi = q0 + 64 + 128; if (hi > SEQ) hi = SEQ; kb0 = CTX + lo; ntiles = 4 + (hi - lo) / 64; }
    f32x16 o[1][2]; float ls[1];
    const float m0 = A.sink[head] * LOG2E;
    float km[1];
#if SWA_FIXM
    { const float* kp = A.kmax + 128 + (size_t)(b * 2 + hk) * 8;
      km[0] = sqrtf(fmaxf(fmaxf(ld_sc1(kp + 0), ld_sc1(kp + 2)), fmaxf(ld_sc1(kp + 4), ld_sc1(kp + 6))) + fmaxf(fmaxf(ld_sc1(kp + 1), ld_sc1(kp + 3)), fmaxf(ld_sc1(kp + 5), ld_sc1(kp + 7)))); }
    if (ctxq) flash_unit<1, 4, false, true>(lds, wv, qrow, Kb, Vb, ntiles, kb0, 0, m0, 1.f, km, o, ls);
    else flash_unit<1, 4, true, true, JF>(lds, wv, qrow, Kb, Vb, ntiles, kb0, qpos, m0, 1.f, km, o, ls, jf, kord);
#else
    km[0] = 0.f;
    if (ctxq) flash_unit<1, 4, false, false>(lds, wv, qrow, Kb, Vb, ntiles, kb0, 0, m0, 1.f, km, o, ls);
    else flash_unit<1, 4, true, false>(lds, wv, qrow, Kb, Vb, ntiles, kb0, qpos, m0, 1.f, km, o, ls);
#endif
    const float inv = 1.f / ls[0];
    o[0][0] = o[0][0] * inv; o[0][1] = o[0][1] * inv;
    store_ot(A.MIX + (size_t)row * 1024 + 256 + head * 64, o[0], h);
}

__device__ __forceinline__ void kmax_unit(LAS unsigned char* lds, const int wv, const bf16_t* KD, float* KMAXP, int b, int hd, int qt, int nh = 4) {
    const int tid = opaque_tid(wv), lane = tid & 63, wid = tid >> 6;
    const bf16_t* Kb = KD + (size_t)(b * nh + hd) * KEYS * 64;
    float m1 = 0.f, m2 = 0.f;
    for (int key = qt * (KEYS / 4) + tid; key < (qt + 1) * (KEYS / 4); key += 512) {
        float n1 = 0.f, n2 = 0.f;
#pragma unroll
        for (int c = 0; c < 8; ++c) { const u32x4 w = *(const GAS u32x4*)(Kb + (size_t)key * 64 + c * 8);
            const float s = bflo(w.x) * bflo(w.x) + bfhi(w.x) * bfhi(w.x) + bflo(w.y) * bflo(w.y) + bfhi(w.y) * bfhi(w.y) + bflo(w.z) * bflo(w.z) + bfhi(w.z) * bfhi(w.z) + bflo(w.w) * bflo(w.w) + bfhi(w.w) * bfhi(w.w);
            if (c < 4) n1 += s; else n2 += s; }
        m1 = fmaxf(m1, n1); m2 = fmaxf(m2, n2);
    }
#pragma unroll
    for (int o = 1; o < 64; o <<= 1) { m1 = fmaxf(m1, __shfl_xor(m1, o)); m2 = fmaxf(m2, __shfl_xor(m2, o)); }
    LAS float* R = (LAS float*)lds;
    if (lane == 0) { R[wid * 2] = m1; R[wid * 2 + 1] = m2; }
    __syncthreads();
    if (tid < 2) { float m = 0.f;
#pragma unroll
        for (int w = 0; w < 8; ++w) m = fmaxf(m, R[w * 2 + tid]);
        st_sc1(KMAXP + ((b * nh + hd) * 4 + qt) * 2 + tid, m); }
    __syncthreads();
}

__device__ __forceinline__ void diff_unit(LAS unsigned char* lds, const int wv, const AttnArgs& A, int b, int hd, int jq, bool ctxq, float lam) {
    const int tid = opaque_tid(wv), lane = tid & 63, wid = tid >> 6, r = lane & 31, h = lane >> 5;
    const int qpos = 256 * jq + 32 * wid + r;
    const int row = ctxq ? TL + b * CTX + qpos : b * SEQ + qpos;
    const bf16_t* qrow = A.QD + (size_t)row * 256 + hd * 64;
    const bf16_t* Kb = A.KD + (size_t)(b * 4 + hd) * KEYS * 64; const bf16_t* Vb = A.VD + (size_t)(b * 4 + hd) * KEYS * 64;
    const int ntiles = ctxq ? 4 : KEYS / 64;
    f32x16 o[2][2]; float ls[2];
    float km[2];
    { const float* kp = A.kmax + (size_t)(b * 4 + hd) * 8; km[0] = sqrtf(fmaxf(fmaxf(ld_sc1(kp + 0), ld_sc1(kp + 2)), fmaxf(ld_sc1(kp + 4), ld_sc1(kp + 6)))); km[1] = sqrtf(fmaxf(fmaxf(ld_sc1(kp + 1), ld_sc1(kp + 3)), fmaxf(ld_sc1(kp + 5), ld_sc1(kp + 7)))); }
#if DIFF_STAG
    if (DIFF_GRPB && __builtin_amdgcn_readfirstlane(wid) >= 4) flash_diff<true>(lds, wv, qrow, Kb, Vb, ntiles, CTX, km, o, ls);
    else flash_diff<false>(lds, wv, qrow, Kb, Vb, ntiles, CTX, km, o, ls);
#else
    flash_unit<2, 2, false, true>(lds, wv, qrow, Kb, Vb, ntiles, CTX, 0, -1e30f, 0.f, km, o, ls);
#endif
    const float i1 = 1.f / ls[0], i2 = lam / ls[1];
    f32x16 v[2]; float ss = 0.f;
#pragma unroll
    for (int db = 0; db < 2; ++db)
#pragma unroll
        for (int e = 0; e < 16; ++e) { const float x = o[0][db][e] * i1 - o[1][db][e] * i2; v[db][e] = x; ss += x * x; }
    ss = xhalf_sum(ss);
    const float rn = rsqrtf(ss * (1.f / 64.f) + LN_EPS) * (1.f - A.lam_init);
#pragma unroll
    for (int db = 0; db < 2; ++db)
#pragma unroll
        for (int e4 = 0; e4 < 4; ++e4) { const f32x4 g = *(const GAS f32x4*)(A.dng + 32 * db + 8 * e4 + 4 * h);
#pragma unroll
            for (int j = 0; j < 4; ++j) v[db][4 * e4 + j] *= rn * g[j]; }
    store_ot(A.MIX + (size_t)row * 1024 + 768 + hd * 64, v, h);
}
__device__ __forceinline__ unsigned cvtpk_h(float lo, float hi) { unsigned r; asm("v_cvt_pk_f16_f32 %0, %1, %2" : "=v"(r) : "v"(lo), "v"(hi)); return r; }
__device__ __forceinline__ float h_lo(unsigned w) { float r; asm("v_cvt_f32_f16 %0, %1" : "=v"(r) : "v"(w)); return r; }
__device__ __forceinline__ float h_hi(unsigned w) { float r; const unsigned s = w >> 16; asm("v_cvt_f32_f16 %0, %1" : "=v"(r) : "v"(s)); return r; }
__device__ __forceinline__ f32x4 h4_to_f4(u32x2 w) { return (f32x4){h_lo(w.x), h_hi(w.x), h_lo(w.y), h_hi(w.y)}; }

struct LruArgs { const bf16_t* LRUX; const bf16_t* GATE; bf16_t* MIX; const bf16_t* GWT; const float *conv_w, *conv_b, *gate_b, *lam; float* CM; float* CARRY; float* AB; };
constexpr int LRU_AA = 0, LRU_BX = 32768, LRU_UF = 65536, LRU_UB = 81920, LRU_UBP = 272, LRU_C8 = LRU_UB + 32 * LRU_UBP, LRU_CAR = LRU_C8 + 1024, LRU_END = LRU_CAR + 1024;
static_assert(LRU_END <= RING_BYTES, "LRU LDS map");

template <int PASS>
__device__ __forceinline__ void lru_phase(LAS unsigned char* lds, const int wv, const LruArgs& A, int bx, int G, int reps) {
    const int tid = opaque_tid(wv), lane = tid & 63, wid = __builtin_amdgcn_readfirstlane(tid >> 6), r = lane & 31, h = lane >> 5;
    LAS float* AA = (LAS float*)(lds + LRU_AA); LAS float* BX = (LAS float*)(lds + LRU_BX); LAS float* UF = (LAS float*)(lds + LRU_UF);
    LAS unsigned char* UB = lds + LRU_UB; LAS unsigned char* XS = lds + LRU_AA;
    LAS float* C8 = (LAS float*)(lds + LRU_C8); LAS float* CAR = (LAS float*)(lds + LRU_CAR);
    const int chh = bx & 1, ch0 = 128 * chh;
    const int k2 = wid & 1, nb = (wid >> 1) & 1, wd = wid >> 2;
    bf16x8 gw0[4], gw1[4];
    {   const bf16_t* g0 = A.GWT + ((size_t)((wd * 2 + 0) * 4 + 2 * chh + k2) * 64 + 32 * nb + r) * 64 + 8 * h;
        const bf16_t* g1 = A.GWT + ((size_t)((wd * 2 + 1) * 4 + 2 * chh + k2) * 64 + 32 * nb + r) * 64 + 8 * h;
#pragma unroll
        for (int s = 0; s < 4; ++s) { gw0[s] = *(const GAS bf16x8*)(g0 + 16 * s); gw1[s] = *(const GAS bf16x8*)(g1 + 16 * s); } }
    if (tid < 256) {
        const int d = tid >> 7, ch = ch0 + (tid & 127);
        {
            const float e = fast_exp2(-LOG2E * A.lam[d * 256 + ch]);
            const float sp = e < 0.0625f ? e * (1.f + e * (-0.5f + e * (0.33333334f + e * (-0.25f + e * 0.2f)))) : 0.6931471805599453f * __builtin_amdgcn_logf(1.f + e);
            C8[tid] = -8.f * sp; }
    }
    const float cw0_ = A.conv_w[ch0 + (tid & 127)], cw1_ = A.conv_w[256 + ch0 + (tid & 127)], cw2_ = A.conv_w[512 + ch0 + (tid & 127)], cw3_ = A.conv_w[768 + ch0 + (tid & 127)], ccb_ = A.conv_b[ch0 + (tid & 127)];
    const float gba_ = A.gate_b[(wd * 2 + 0) * 256 + ch0 + 64 * k2 + 32 * nb + r], gbi_ = A.gate_b[(wd * 2 + 1) * 256 + ch0 + 64 * k2 + 32 * nb + r];
    for (int rep_ = 0; rep_ < reps; ++rep_) {
    u32x4 xr0 = {0u, 0u, 0u, 0u}, xr1 = {0u, 0u, 0u, 0u}; float cnx = 0.f;
#define LRU_FETCH(P) do { const int pb_ = (P) / LRU_NCH, pc_ = (P) % LRU_NCH; const bool ic_ = pc_ < 8; \
        const int sg_ = ic_ ? TL + pb_ * CTX : pb_ * SEQ, sl_ = ic_ ? CTX : SEQ, tt_ = ic_ ? 32 * pc_ : 32 * (pc_ - 8); \
        { const int rr = tid >> 4, c16 = tid & 15, t = tt_ - 1 + rr; xr0 = (u32x4){0u, 0u, 0u, 0u}; if (t >= 0 && t < sl_) xr0 = *(const GAS u32x4*)(A.LRUX + (size_t)(sg_ + t) * 256 + ch0 + c16 * 8); } \
        if (tid < 48) { const int rr = (tid + 512) >> 4, c16 = tid & 15, t = tt_ - 1 + rr; xr1 = (u32x4){0u, 0u, 0u, 0u}; if (t >= 0 && t < sl_) xr1 = *(const GAS u32x4*)(A.LRUX + (size_t)(sg_ + t) * 256 + ch0 + c16 * 8); } \
        if (PASS == 2 && tid < 256) { const int d = tid >> 7, ch = ch0 + (tid & 127); cnx = ld_sc1(A.CARRY + ((size_t)(pb_ * LRU_NCH + pc_) * 2 + d) * 256 + ch); } } while (0)
    const bool active = bx < 2 * (G >> 1);
    if (active && (bx >> 1) < NB * LRU_NCH) LRU_FETCH(bx >> 1);
    for (int p = (bx >> 1); p < NB * LRU_NCH && active; p += (G >> 1)) {
    const int b = p / LRU_NCH, ci = p % LRU_NCH;
    const bool isctx = ci < 8;
    const int seg0 = isctx ? TL + b * CTX : b * SEQ, t0 = isctx ? 32 * ci : 32 * (ci - 8);
    if (PASS == 2 && tid < 256) CAR[tid] = cnx;
    *(LAS u32x4*)(XS + (tid >> 4) * 256 + (tid & 15) * 16) = xr0;
    if (tid < 48) *(LAS u32x4*)(XS + ((tid + 512) >> 4) * 256 + (tid & 15) * 16) = xr1;
    __syncthreads();
    if (p + (G >> 1) < NB * LRU_NCH) LRU_FETCH(p + (G >> 1));
    {
        const int cl = tid & 127, tq = tid >> 7, ch = ch0 + cl;
        const float w0 = cw0_, w1 = cw1_, w2 = cw2_, w3 = cw3_, cb = ccb_; (void)ch;
        const LAS unsigned short* xs = (const LAS unsigned short*)XS + (tq * 8) * 128 + cl;
        float x0 = bf2f(xs[0]), x1 = bf2f(xs[128]), x2 = bf2f(xs[256]);
#pragma unroll
        for (int t = 0; t < 8; ++t) { const float x3 = bf2f(xs[(t + 3) * 128]); const float u = cb + w0 * x0 + w1 * x1 + w2 * x2 + w3 * x3; x0 = x1; x1 = x2; x2 = x3;
            const int tok = tq * 8 + t; UF[tok * 128 + cl] = u; *(LAS unsigned short*)(UB + tok * LRU_UBP + cl * 2) = (unsigned short)(cvtpk(u, 0.f) & 0xffffu); }
    }
    __syncthreads();
    {
        f32x16 acc0 = f32x16{}, acc1 = f32x16{};
#pragma unroll
        for (int s = 0; s < 4; ++s) {
            const bf16x8 a = *(LAS bf16x8*)(UB + r * LRU_UBP + (64 * k2 + 16 * s + 8 * h) * 2);
            acc0 = __builtin_amdgcn_mfma_f32_32x32x16_bf16(a, gw0[s], acc0, 0, 0, 0);
            acc1 = __builtin_amdgcn_mfma_f32_32x32x16_bf16(a, gw1[s], acc1, 0, 0, 0);
        }
        const int cl = 64 * k2 + 32 * nb + r, ch = ch0 + cl;
        const float ba = gba_, bi = gbi_, c8 = C8[wd * 128 + cl]; (void)ch;
        LAS float* aa = AA + wd * 4096; LAS float* bx = BX + wd * 4096;
#pragma unroll
        for (int e = 0; e < 16; ++e) { const int tok = crow(e, h);
            const float rr = sigmoid_f(acc0[e] + ba), ii = sigmoid_f(acc1[e] + bi), la = c8 * rr;
            const float av = fast_exp2(LOG2E * la), x2 = 2.f * la;
            const float ser = -x2 * (1.f + x2 * (0.5f + x2 * (0.16666667f + x2 * (0.041666668f + x2 * 0.0083333338f))));
            const float om = x2 > -0.125f ? ser : 1.f - av * av;
            const float bxv = __builtin_amdgcn_sqrtf(om) * ii * UF[tok * 128 + cl];
            aa[tok * 128 + cl] = av; bx[tok * 128 + cl] = bxv;
            if (PASS == 1) { GAS unsigned* ab = (GAS unsigned*)A.AB + ((size_t)(b * LRU_NCH + ci) * 2 + chh) * 8192 + wd * 4096 + tok * 128 + cl; ab[0] = cvtpk_h(om * fast_rcp(1.f + av), bxv); } }
    }
    __syncthreads();
    if (tid < 256) {
        const int d = tid >> 7, cl = tid & 127;
        LAS float* aa = AA + d * 4096 + cl; LAS float* bx = BX + d * 4096 + cl;
        if (PASS == 1) {
            float ap = 1.f, hh = 0.f;
            if (d == 0) {
#pragma unroll
                for (int t = 0; t < 32; ++t) { const float av = aa[t * 128]; hh = av * hh + bx[t * 128]; ap *= av; }
            } else {
#pragma unroll
                for (int t = 31; t >= 0; --t) { const float av = aa[t * 128]; hh = av * hh + bx[t * 128]; ap *= av; }
            }
            float* cm = A.CM + ((size_t)(b * LRU_NCH + ci) * 2 + d) * 512 + ch0 + cl; st_sc1(cm, ap); st_sc1(cm + 256, hh);
        } else {
            float hh = CAR[tid];
            float av[32], bv[32];
#pragma unroll
            for (int t = 0; t < 32; ++t) { av[t] = aa[t * 128]; bv[t] = bx[t * 128]; }
            if (d == 0) {
#pragma unroll
                for (int t = 0; t < 32; ++t) { hh = av[t] * hh + bv[t]; bv[t] = hh; }
            } else {
#pragma unroll
                for (int t = 31; t >= 0; --t) { hh = av[t] * hh + bv[t]; bv[t] = hh; }
            }
#pragma unroll
            for (int t = 0; t < 32; ++t) bx[t * 128] = bv[t];
        }
    }
    if (PASS == 2) {
        __syncthreads();
        const int t = tid >> 4, cg = tid & 15;
        const size_t row = (size_t)(seg0 + t0 + t);
        const u32x4 gv = *(const GAS u32x4*)(A.GATE + row * 256 + ch0 + cg * 8);
        const f32x4 f0 = *(LAS f32x4*)(BX + t * 128 + cg * 8), f1 = *(LAS f32x4*)(BX + t * 128 + cg * 8 + 4);
        const f32x4 r0 = *(LAS f32x4*)(BX + 4096 + t * 128 + cg * 8), r1 = *(LAS f32x4*)(BX + 4096 + t * 128 + cg * 8 + 4);
        u32x4 w;
        w.x = cvtpk((f0[0] + r0[0]) * bflo(gv.x), (f0[1] + r0[1]) * bfhi(gv.x)); w.y = cvtpk((f0[2] + r0[2]) * bflo(gv.y), (f0[3] + r0[3]) * bfhi(gv.y));
        w.z = cvtpk((f1[0] + r1[0]) * bflo(gv.z), (f1[1] + r1[1]) * bfhi(gv.z)); w.w = cvtpk((f1[2] + r1[2]) * bflo(gv.w), (f1[3] + r1[3]) * bfhi(gv.w));
        *(GAS u32x4*)(A.MIX + row * 1024 + ch0 + cg * 8) = w;
    }
    __syncthreads();
    }
    }
#undef LRU_FETCH
}

__device__ __forceinline__ void lru_phase2c(LAS unsigned char* lds, const int wv, const LruArgs& A, int bx, int G) {
    const int tid = opaque_tid(wv);
    LAS float* BX = (LAS float*)(lds + LRU_BX);
    const int chh = bx & 1, ch0 = 128 * chh;
    const bool active = bx < 2 * (G >> 1);
    unsigned rw[32]; float cn = 0.f; u32x4 gvn = {0u, 0u, 0u, 0u};
#pragma unroll
    for (int t = 0; t < 32; ++t) rw[t] = 0u;
#define LRU2_FETCH(P) do { const int pb_ = (P) / LRU_NCH, pc_ = (P) % LRU_NCH; const bool ic_ = pc_ < 8; const int sg_ = ic_ ? TL + pb_ * CTX : pb_ * SEQ, tt_ = ic_ ? 32 * pc_ : 32 * (pc_ - 8); \
        if (tid < 256) { const int d_ = tid >> 7, cl_ = tid & 127; const float* ab_ = A.AB + ((size_t)(pb_ * LRU_NCH + pc_) * 2 + chh) * 8192 + d_ * 4096 + cl_; \
            cn = ld_sc1(A.CARRY + ((size_t)(pb_ * LRU_NCH + pc_) * 2 + d_) * 256 + ch0 + cl_); \
            _Pragma("unroll") for (int t = 0; t < 32; ++t) rw[t] = __float_as_uint(ld_sc1(ab_ + t * 128)); } \
        gvn = *(const GAS u32x4*)(A.GATE + (size_t)(sg_ + tt_ + (tid >> 4)) * 256 + ch0 + (tid & 15) * 8); } while (0)
    if (active && (bx >> 1) < NB * LRU_NCH) LRU2_FETCH(bx >> 1);
    for (int p = (bx >> 1); p < NB * LRU_NCH && active; p += (G >> 1)) {
        const int b = p / LRU_NCH, ci = p % LRU_NCH;
        const bool isctx = ci < 8;
        const int seg0 = isctx ? TL + b * CTX : b * SEQ, t0 = isctx ? 32 * ci : 32 * (ci - 8);
        float av[32], bv[32]; float hh = cn;
#pragma unroll
        for (int t = 0; t < 32; ++t) { av[t] = 1.f - h_lo(rw[t]); bv[t] = h_hi(rw[t]); }
        const u32x4 gv = gvn;
        if (p + (G >> 1) < NB * LRU_NCH) LRU2_FETCH(p + (G >> 1));
        if (tid < 256) {
            const int d = tid >> 7, cl = tid & 127;
            LAS float* bxl = BX + d * 4096 + cl;
            if (d == 0) {
#pragma unroll
                for (int t = 0; t < 32; ++t) { hh = av[t] * hh + bv[t]; bxl[t * 128] = hh; }
            } else {
#pragma unroll
                for (int t = 31; t >= 0; --t) { hh = av[t] * hh + bv[t]; bxl[t * 128] = hh; }
            }
        }
        __syncthreads();
        {
            const int t = tid >> 4, cg = tid & 15;
            const size_t row = (size_t)(seg0 + t0 + t);
            const f32x4 f0 = *(LAS f32x4*)(BX + t * 128 + cg * 8), f1 = *(LAS f32x4*)(BX + t * 128 + cg * 8 + 4);
            const f32x4 r0 = *(LAS f32x4*)(BX + 4096 + t * 128 + cg * 8), r1 = *(LAS f32x4*)(BX + 4096 + t * 128 + cg * 8 + 4);
            u32x4 w;
            w.x = cvtpk((f0[0] + r0[0]) * bflo(gv.x), (f0[1] + r0[1]) * bfhi(gv.x)); w.y = cvtpk((f0[2] + r0[2]) * bflo(gv.y), (f0[3] + r0[3]) * bfhi(gv.y));
            w.z = cvtpk((f1[0] + r1[0]) * bflo(gv.z), (f1[1] + r1[1]) * bfhi(gv.z)); w.w = cvtpk((f1[2] + r1[2]) * bflo(gv.w), (f1[3] + r1[3]) * bfhi(gv.w));
            *(GAS u32x4*)(A.MIX + row * 1024 + ch0 + cg * 8) = w;
        }
        __syncthreads();
    }
#undef LRU2_FETCH
}

__device__ __forceinline__ void lru_scan_unit(LAS unsigned char* lds, const int wv, const float* CMp, float* CARRY, int b, int d, int cg) {
    const int tid = opaque_tid(wv), c = tid & 31, part = tid >> 5;
    LAS float* PT = (LAS float*)lds;
    float a[9], bb[9];
#pragma unroll
    for (int j = 0; j < 9; ++j) { const int p = part * 9 + j; const int ci = d == 0 ? p : (p < 8 ? 7 - p : 143 - p);
        if (p < LRU_NCH) { const float* cm = CMp + ((size_t)(b * LRU_NCH + ci) * 2 + d) * 512 + cg * 32 + c; a[j] = ld_sc1(cm); bb[j] = ld_sc1(cm + 256); } else { a[j] = 1.f; bb[j] = 0.f; } }
    float ap = 1.f, hp = 0.f;
#pragma unroll
    for (int j = 0; j < 9; ++j) { hp = a[j] * hp + bb[j]; ap *= a[j]; }
    PT[(part * 2 + 0) * 32 + c] = ap; PT[(part * 2 + 1) * 32 + c] = hp;
    __syncthreads();
    float h = 0.f;
    for (int q = 0; q < part; ++q) h = PT[(q * 2 + 0) * 32 + c] * h + PT[(q * 2 + 1) * 32 + c];
#pragma unroll
    for (int j = 0; j < 9; ++j) { const int p = part * 9 + j; const int ci = d == 0 ? p : (p < 8 ? 7 - p : 143 - p);
        if (p < LRU_NCH) st_sc1(CARRY + ((size_t)(b * LRU_NCH + ci) * 2 + d) * 256 + cg * 32 + c, h);
        h = a[j] * h + bb[j]; }
    __syncthreads();
}

struct LnArgs {
    const float *hl, *hc; float *ol, *oc;
    const bf16_t* BR; const int* slot; const float* gts;
    const float* mod; int gate_idx;
    const float* modn; int sh_idx, sc_idx;
    const float *lng, *lnb; bf16_t* U; int nrows;
    const float *rw, *rb; int* toke; float* tokg; int* tokr; unsigned* cnt;
    int u8;
    const float* part; int nsplit;
    unsigned char* ybx;
    int ts[8];
};
constexpr int LN_STASH = 36864;
constexpr int ROWS_PER_WAVE = 9;
__device__ __forceinline__ int wave_row(int gw, int ri, int nrows) { return ri < 8 ? gw * 8 + ri : ((nrows > TL && gw < TC) ? TL + gw : -1); }

template <bool MOE_BR, bool ROUTER, bool HIN16 = false, bool HOUT16 = false, int NSPLIT = 11>
__device__ __forceinline__ void ln_pass(LAS unsigned char* lds, const int wv, const LnArgs& A, int gw) {
    const int tid = opaque_tid(wv), lane = tid & 63, wid = __builtin_amdgcn_readfirstlane(tid >> 6);
    LAS float* RWT = (LAS float*)lds;
    LAS int* WC = (LAS int*)(lds + 32768);
    if (ROUTER) { for (int i = tid; i < 8192; i += 512) { const int k = i >> 3, e = i & 7; RWT[e * 1024 + k] = A.rw[i]; } __syncthreads(); }
    f32x4 g4[4], b4[4];
#pragma unroll
    for (int j = 0; j < 4; ++j) { g4[j] = *(const GAS f32x4*)(A.lng + 4 * lane + 256 * j); b4[j] = *(const GAS f32x4*)(A.lnb + 4 * lane + 256 * j); }
    f32x4 gt[4], sc[4], sh[4]; int curcb = -1;
    int cw0 = 0, cw1 = 0, cw2 = 0, cw3 = 0, cw4 = 0, cw5 = 0, cw6 = 0, cw7 = 0; unsigned long long packed = 0ull;
    const int rbeg = gw * ROWS_PER_WAVE;
    f32x4 nh[4]; u32x2 nh16[4]; u32x2 nb0[4], nb1[4]; float nq0 = 0.f, nq1 = 0.f;
#define LN_LOADROW(R) do { const int r_ = (R); \
        if (HIN16) { const unsigned short* hin_ = r_ < TL ? (const unsigned short*)A.hl + (size_t)r_ * 1024 : (const unsigned short*)A.hc + (size_t)(r_ - TL) * 1024; \
            _Pragma("unroll") for (int j = 0; j < 4; ++j) nh16[j] = *(const GAS u32x2*)(hin_ + 4 * lane + 256 * j); } \
        else { const float* hin_ = r_ < TL ? A.hl + (size_t)r_ * 1024 : A.hc + (size_t)(r_ - TL) * 1024; \
            _Pragma("unroll") for (int j = 0; j < 4; ++j) nh[j] = *(const GAS f32x4*)(hin_ + 4 * lane + 256 * j); } \
        if (MOE_BR) { const int e0_ = ((const GAS int*)A.toke)[r_ * 2], e1_ = ((const GAS int*)A.toke)[r_ * 2 + 1]; int b0_ = 0, b1_ = 0; _Pragma("unroll") for (int e_ = 1; e_ < 8; ++e_) { b0_ = (e0_ == e_) ? A.ts[e_] : b0_; b1_ = (e1_ == e_) ? A.ts[e_] : b1_; } \
            const int s0_ = b0_ * 256 + ((const GAS int*)A.tokr)[r_ * 2], s1_ = b1_ * 256 + ((const GAS int*)A.tokr)[r_ * 2 + 1]; nq0 = ((const GAS float*)A.gts)[r_ * 2]; nq1 = ((const GAS float*)A.gts)[r_ * 2 + 1]; \
            _Pragma("unroll") for (int j = 0; j < 4; ++j) { nb0[j] = *(const GAS u32x2*)(A.BR + (size_t)s0_ * 1024 + 4 * lane + 256 * j); nb1[j] = *(const GAS u32x2*)(A.BR + (size_t)s1_ * 1024 + 4 * lane + 256 * j); } } \
        else { _Pragma("unroll") for (int j = 0; j < 4; ++j) nb0[j] = *(const GAS u32x2*)(A.BR + (size_t)r_ * 1024 + 4 * lane + 256 * j); } } while (0)
    if (wave_row(gw, 0, A.nrows) >= 0 && wave_row(gw, 0, A.nrows) < A.nrows) LN_LOADROW(wave_row(gw, 0, A.nrows));
    for (int ri = 0; ri < ROWS_PER_WAVE; ++ri) {
        const int row = wave_row(gw, ri, A.nrows); if (row < 0 || row >= A.nrows) break;
        const bool lat = row < TL; const int cb = lat ? (row >> 12) : 4;
        if (cb != curcb) { curcb = cb;
#pragma unroll
            for (int j = 0; j < 4; ++j) { gt[j] = *(const GAS f32x4*)(A.mod + (size_t)(cb * 6 + A.gate_idx) * 1024 + 4 * lane + 256 * j);
                if (A.modn) { sc[j] = *(const GAS f32x4*)(A.modn + (size_t)(cb * 6 + A.sc_idx) * 1024 + 4 * lane + 256 * j); sh[j] = *(const GAS f32x4*)(A.modn + (size_t)(cb * 6 + A.sh_idx) * 1024 + 4 * lane + 256 * j); } } }
        unsigned char* hout = lat ? (unsigned char*)A.ol + (size_t)row * (HOUT16 ? 2048 : 4096) : (unsigned char*)A.oc + (size_t)(row - TL) * (HOUT16 ? 2048 : 4096);
        f32x4 v[4];
        if (HIN16) {
#pragma unroll
            for (int j = 0; j < 4; ++j) nh[j] = h4_to_f4(nh16[j]);
        }
        if (MOE_BR) {
#pragma unroll
            for (int j = 0; j < 4; ++j) { const u32x2 w0 = nb0[j], w1 = nb1[j]; const float q0 = nq0, q1 = nq1;
                f32x4 f; f[0] = q0 * bflo(w0.x) + q1 * bflo(w1.x); f[1] = q0 * bfhi(w0.x) + q1 * bfhi(w1.x); f[2] = q0 * bflo(w0.y) + q1 * bflo(w1.y); f[3] = q0 * bfhi(w0.y) + q1 * bfhi(w1.y);
                v[j] = nh[j] * ALPHA + gt[j] * f; }
        } else if (A.part != nullptr && !lat) {
#pragma unroll
            for (int j = 0; j < 4; ++j) { u32x2 pv[NSPLIT];
#pragma unroll
                for (int s = 0; s < NSPLIT; ++s) pv[s] = *(const GAS u32x2*)((const bf16_t*)A.part + ((size_t)s * 1024 + (row - TL)) * 1024 + 4 * lane + 256 * j);
                f32x4 f = (f32x4){bflo(pv[0].x), bfhi(pv[0].x), bflo(pv[0].y), bfhi(pv[0].y)};
#pragma unroll
                for (int s = 1; s < NSPLIT; ++s) f = f + (f32x4){bflo(pv[s].x), bfhi(pv[s].x), bflo(pv[s].y), bfhi(pv[s].y)};
                v[j] = nh[j] * ALPHA + gt[j] * f; }
        } else {
#pragma unroll
            for (int j = 0; j < 4; ++j) { const u32x2 w0 = nb0[j];
                f32x4 f; f[0] = bflo(w0.x); f[1] = bfhi(w0.x); f[2] = bflo(w0.y); f[3] = bfhi(w0.y);
                v[j] = nh[j] * ALPHA + gt[j] * f; }
        }
        { const int nr_ = ri + 1 < ROWS_PER_WAVE ? wave_row(gw, ri + 1, A.nrows) : -1; if (nr_ >= 0 && nr_ < A.nrows) LN_LOADROW(nr_); }
        float s = 0.f;
#pragma unroll
        for (int j = 0; j < 4; ++j) s += (v[j][0] + v[j][1]) + (v[j][2] + v[j][3]);
        const float mean = wave_sum(s) * (1.f / 1024.f); float s2 = 0.f;
#pragma unroll
        for (int j = 0; j < 4; ++j) { v[j] = v[j] - mean; s2 += (v[j][0] * v[j][0] + v[j][1] * v[j][1]) + (v[j][2] * v[j][2] + v[j][3] * v[j][3]); }
        const float rstd = rsqrtf(wave_sum(s2) * (1.f / 1024.f) + LN_EPS);
#pragma unroll
        for (int j = 0; j < 4; ++j) { v[j] = v[j] * rstd * g4[j] + b4[j];
            if (HOUT16) { u32x2 w; w.x = cvtpk_h(v[j][0], v[j][1]); w.y = cvtpk_h(v[j][2], v[j][3]); *(GAS u32x2*)(hout + 8 * lane + 512 * j) = w; }
            else st16f(hout + 16 * lane + 1024 * j, v[j]); }
        if (A.modn) {
#pragma unroll
            for (int j = 0; j < 4; ++j) { v[j] = v[j] * (sc[j] + 1.f) + sh[j];
                if (ROUTER) *(LAS unsigned*)(lds + LN_STASH + (wid * ROWS_PER_WAVE + ri) * 1024 + 4 * lane + 256 * j) = cvt4_fp8(v[j][0] * F8_SU, v[j][1] * F8_SU, v[j][2] * F8_SU, v[j][3] * F8_SU);
                else if (A.u8) *(GAS unsigned*)((unsigned char*)A.U + (size_t)row * 1024 + 4 * lane + 256 * j) = cvt4_fp8(v[j][0] * F8_SU, v[j][1] * F8_SU, v[j][2] * F8_SU, v[j][3] * F8_SU);
                else { u32x2 w; w.x = cvtpk(v[j][0], v[j][1]); w.y = cvtpk(v[j][2], v[j][3]); *(GAS u32x2*)(A.U + (size_t)row * 1024 + 4 * lane + 256 * j) = w; } }
        }
        if (ROUTER) {
            float lg[8];
#pragma unroll
            for (int e = 0; e < 8; ++e) { float p = 0.f;
#pragma unroll
                for (int j = 0; j < 4; ++j) { const f32x4 w = *(LAS f32x4*)(RWT + e * 1024 + 4 * lane + 256 * j); p += (v[j][0] * w[0] + v[j][1] * w[1]) + (v[j][2] * w[2] + v[j][3] * w[3]); }
                lg[e] = wave_sum(p) + A.rb[e]; }
            float v1 = lg[0]; int i1 = 0;
#pragma unroll
            for (int e = 1; e < 8; ++e) if (lg[e] > v1) { v1 = lg[e]; i1 = e; }
            float v2 = -3.0e38f; int i2 = 0;
#pragma unroll
            for (int e = 0; e < 8; ++e) if (e != i1 && lg[e] > v2) { v2 = lg[e]; i2 = e; }
            const float q1 = fast_rcp(1.f + fast_exp2(LOG2E * (v2 - v1))), q2 = 1.f - q1;
            if (lane == 0) { ((GAS int*)A.toke)[row * 2] = i1; ((GAS int*)A.toke)[row * 2 + 1] = i2; ((GAS float*)A.tokg)[row * 2] = q1; ((GAS float*)A.tokg)[row * 2 + 1] = q2; }
            i1 = __builtin_amdgcn_readfirstlane(i1); i2 = __builtin_amdgcn_readfirstlane(i2);
            cw0 += (i1 == 0) + (i2 == 0); cw1 += (i1 == 1) + (i2 == 1); cw2 += (i1 == 2) + (i2 == 2); cw3 += (i1 == 3) + (i2 == 3);
            cw4 += (i1 == 4) + (i2 == 4); cw5 += (i1 == 5) + (i2 == 5); cw6 += (i1 == 6) + (i2 == 6); cw7 += (i1 == 7) + (i2 == 7);
            packed |= (unsigned long long)(i1 | (i2 << 3)) << (6 * ri);
        }
    }
    if (ROUTER) {
        if (lane < 8) { const int c = lane == 0 ? cw0 : lane == 1 ? cw1 : lane == 2 ? cw2 : lane == 3 ? cw3 : lane == 4 ? cw4 : lane == 5 ? cw5 : lane == 6 ? cw6 : cw7; WC[wid * 8 + lane] = c; }
        __syncthreads();
        if (tid < 8) { int tot = 0;
#pragma unroll
            for (int w = 0; w < 8; ++w) tot += WC[w * 8 + tid];
            WC[64 + tid] = tot ? (int)atomicAdd(A.cnt + tid, (unsigned)tot) : 0; }
        __syncthreads();
        int off[8];
#pragma unroll
        for (int e = 0; e < 8; ++e) { int o = WC[64 + e];
#pragma unroll
            for (int w = 0; w < 8; ++w) o += (w < wid) ? WC[w * 8 + e] : 0;
            off[e] = __builtin_amdgcn_readfirstlane(o); }
        for (int ri = 0; ri < ROWS_PER_WAVE; ++ri) {
            const int row = wave_row(gw, ri, A.nrows); if (row < 0 || row >= A.nrows) break;
            const int pr = (int)((packed >> (6 * ri)) & 63ull), i1 = pr & 7, i2 = pr >> 3; int r1 = 0, r2 = 0;
#pragma unroll
            for (int e = 0; e < 8; ++e) { if (i1 == e) { r1 = off[e]; off[e] += 1; } }
#pragma unroll
            for (int e = 0; e < 8; ++e) { if (i2 == e) { r2 = off[e]; off[e] += 1; } }
            if (lane == 0) { ((GAS int*)A.tokr)[row * 2] = r1; ((GAS int*)A.tokr)[row * 2 + 1] = r2; }
            const u32x4 sr = *(LAS u32x4*)(lds + LN_STASH + (wid * ROWS_PER_WAVE + ri) * 1024 + 16 * lane);
            *(GAS u32x4*)(A.ybx + ((size_t)i1 * T + r1) * 1024 + 16 * lane) = sr; *(GAS u32x4*)(A.ybx + ((size_t)i2 * T + r2) * 1024 + 16 * lane) = sr;
        }
    }
}

struct ExpTab { int ts[9]; };
__device__ __forceinline__ void exp_table(const unsigned* cnt, int (&ts)[9]) {
    int acc = 0;
#pragma unroll
    for (int e = 0; e < 8; ++e) { ts[e] = acc; const int c = __builtin_amdgcn_readfirstlane((int)__hip_atomic_load(cnt + e, __ATOMIC_RELAXED, __HIP_MEMORY_SCOPE_AGENT)); acc += (c + 255) >> 8; }
    ts[8] = acc;
}
__device__ __forceinline__ void route_gather(const int wv, const unsigned* cnt, const int* toke, const int* tokr, int* toks, const bf16_t* U, bf16_t* YB, int nrows, int gw) {
    const int lane = opaque_tid(wv) & 63;
    int ts[9]; exp_table(cnt, ts);
    const int rbeg = gw * ROWS_PER_WAVE;
#pragma unroll 3
    for (int ri = 0; ri < ROWS_PER_WAVE; ++ri) {
        const int row = wave_row(gw, ri, nrows); if (row < 0 || row >= nrows) break;
        const int e0 = toke[row * 2], e1 = toke[row * 2 + 1]; int b0 = 0, b1 = 0;
#pragma unroll
        for (int e = 0; e < 8; ++e) { if (e0 == e) b0 = ts[e]; if (e1 == e) b1 = ts[e]; }
        const int s0 = b0 * 256 + tokr[row * 2], s1 = b1 * 256 + tokr[row * 2 + 1];
        if (lane == 0) { toks[row * 2] = s0; toks[row * 2 + 1] = s1; }
        const u32x4 a = *(const GAS u32x4*)(U + (size_t)row * 1024 + lane * 8), c = *(const GAS u32x4*)(U + (size_t)row * 1024 + 512 + lane * 8);
        u32x2 a8, c8;
        a8.x = cvt4_fp8(bflo(a.x) * F8_SU, bfhi(a.x) * F8_SU, bflo(a.y) * F8_SU, bfhi(a.y) * F8_SU); a8.y = cvt4_fp8(bflo(a.z) * F8_SU, bfhi(a.z) * F8_SU, bflo(a.w) * F8_SU, bfhi(a.w) * F8_SU);
        c8.x = cvt4_fp8(bflo(c.x) * F8_SU, bfhi(c.x) * F8_SU, bflo(c.y) * F8_SU, bfhi(c.y) * F8_SU); c8.y = cvt4_fp8(bflo(c.z) * F8_SU, bfhi(c.z) * F8_SU, bflo(c.w) * F8_SU, bfhi(c.w) * F8_SU);
        unsigned char* Y8 = (unsigned char*)YB;
        *(GAS u32x2*)(Y8 + (size_t)s0 * 1024 + lane * 8) = a8; *(GAS u32x2*)(Y8 + (size_t)s0 * 1024 + 512 + lane * 8) = c8;
        *(GAS u32x2*)(Y8 + (size_t)s1 * 1024 + lane * 8) = a8; *(GAS u32x2*)(Y8 + (size_t)s1 * 1024 + 512 + lane * 8) = c8;
    }
}

__device__ __forceinline__ int rowmap(int kind, int n) {
    if (kind == 0) return n;
    if (kind == 2) return ((n >> 7) << 8) + (n & 127);
    if (kind == 3) return ((n >> 7) << 8) + 128 + (n & 127);
    if (n < 512) return n;
    if (n < 1152) { const int d = n & 63; return (n & ~63) + (d < 32 ? 2 * d : 2 * (d - 32) + 1); }
    if (n < 1280) return n;
    if (n < 1792) { const int d = n & 31; return (n & ~31) + (d < 16 ? 2 * d : 2 * (d - 16) + 1); }
    return n;
}
__device__ __forceinline__ void transpose_item(const float* W, int K, int N, bf16_t* WT, int kind, LAS float* scr, int item, int lane, float f8s = 0.f) {
    const int nblk = N / 32, kb = item / nblk, nb = item % nblk, k0 = 64 * kb, n0 = 32 * nb;
    {
        f32x4 v[8]; const float* wp = W + (size_t)(k0 + (lane >> 3)) * N + n0 + 4 * (lane & 7);
#pragma unroll
        for (int i = 0; i < 8; ++i) v[i] = *(const GAS f32x4*)(wp + (size_t)(8 * i) * N);
#pragma unroll
        for (int i = 0; i < 8; ++i) { LAS float* d = scr + (8 * i + (lane >> 3)) * 33 + 4 * (lane & 7); d[0] = v[i][0]; d[1] = v[i][1]; d[2] = v[i][2]; d[3] = v[i][3]; }
    }
    asm volatile("s_waitcnt lgkmcnt(0)" ::: "memory");
    const int c = lane & 7;
#pragma unroll
    for (int j = 0; j < 4; ++j) { const int n = (lane >> 3) + 8 * j; const LAS float* s = scr + (8 * c) * 33 + n;
        if (f8s != 0.f) { u32x2 o; o.x = cvt4_fp8(s[0 * 33] * f8s, s[1 * 33] * f8s, s[2 * 33] * f8s, s[3 * 33] * f8s); o.y = cvt4_fp8(s[4 * 33] * f8s, s[5 * 33] * f8s, s[6 * 33] * f8s, s[7 * 33] * f8s);
            *(GAS u32x2*)((unsigned char*)WT + (size_t)rowmap(kind, n0 + n) * K + k0 + 8 * c) = o; }
        else {
        u32x4 o; o.x = cvtpk(s[0 * 33], s[1 * 33]); o.y = cvtpk(s[2 * 33], s[3 * 33]); o.z = cvtpk(s[4 * 33], s[5 * 33]); o.w = cvtpk(s[6 * 33], s[7 * 33]);
        *(GAS u32x4*)(WT + (size_t)rowmap(kind, n0 + n) * K + k0 + 8 * c) = o; } }
    asm volatile("s_waitcnt lgkmcnt(0)" ::: "memory");
}

#ifndef PHMASK
#define PHMASK 0xFFFFF
#endif
#define PHON(n) (((PHMASK) >> (n)) & 1)
#ifndef REP_G
#define REP_G 1
#endif
#ifndef REP_DIFF
#define REP_DIFF 1
#endif
#ifndef REP_SWA
#define REP_SWA 1
#endif
#ifndef REP_LRU
#define REP_LRU 1
#endif
#ifndef REP_P0
#define REP_P0 1
#endif
#ifndef REP_G1
#define REP_G1 REP_G
#endif
#ifndef REP_G2
#define REP_G2 REP_G
#endif
#ifndef REP_G3
#define REP_G3 REP_G
#endif
#ifndef REP_G4
#define REP_G4 REP_G
#endif
#ifndef G3_ALIGN
#define G3_ALIGN true
#endif
#ifndef REP_MISC
#define REP_MISC 1
#endif
#ifndef REP_N1L0
#define REP_N1L0 1
#endif
struct Args { const float* in[26]; float* out; unsigned char* ws; int ph_lo, ph_hi; };
constexpr int PH_P0 = 0, PH_P0B = 1, PH_LAYER0 = 2, PH_PER_LAYER = 8, N_PHASES = PH_LAYER0 + DEPTH * PH_PER_LAYER;
enum { LP_G1 = 0, LP_AT, LP_G2, LP_N1, LP_R1, LP_G3, LP_G4, LP_N2 };
enum { I_X = 0, I_C, I_CTX, I_CCTX, I_ADAW, I_ADAB, I_WIN, I_WOUT, I_CONVW, I_CONVB, I_GATEW, I_GATEB, I_LAM, I_SINK, I_DLAM, I_DNG, I_LNG, I_LNB, I_F1, I_F3, I_F2, I_RW, I_RB, I_M1, I_M3, I_M2 };

#define MOD ((float*)(wsp + WS_MOD))
#define COS64 ((float*)(wsp + WS_COS64))
#define SIN64 ((float*)(wsp + WS_SIN64))
#define COS32 ((float*)(wsp + WS_COS32))
#define SIN32 ((float*)(wsp + WS_SIN32))
#define GWT ((bf16_t*)(wsp + WS_GWT))
#define CM ((float*)(wsp + WS_CM))
#define CARRY ((float*)(wsp + WS_CARRY))
#define LRUAB ((float*)(wsp + WS_AB))
#define KMAX ((float*)(wsp + WS_KMAX))
#define TOKE ((int*)(wsp + WS_TOKE))
#define TOKG ((float*)(wsp + WS_TOKG))
#define TOKR ((int*)(wsp + WS_TOKR))
#define TOKS ((int*)(wsp + WS_TOKS))
#define WIN ((bf16_t*)(wsp + WS_WIN))
#define WOUT ((bf16_t*)(wsp + WS_WOUT))
#define F13 ((bf16_t*)(wsp + WS_F13))
#define F2 ((bf16_t*)(wsp + WS_F2))
#define M13 ((bf16_t*)(wsp + WS_M13))
#define M2 ((bf16_t*)(wsp + WS_M2))
#define H ((float*)(wsp + WS_H))
#ifndef RES16
#define RES16 1
#endif
#define H16C ((float*)(wsp + WS_H + (size_t)TL * 1024 * (RES16 == 1 ? 2 : 4)))
#define HX ((float*)(wsp + ((size_t)740 << 20)))
#define HXC ((float*)(wsp + ((size_t)740 << 20) + (size_t)TL * 2048))
#define U ((bf16_t*)(wsp + WS_U))
#define LRUX ((bf16_t*)(wsp + WS_LRUX))
#define GATE ((bf16_t*)(wsp + WS_GATE))
#define QS ((bf16_t*)(wsp + WS_QS))
#define KS ((bf16_t*)(wsp + WS_KS))
#define VS ((bf16_t*)(wsp + WS_VS))
#define QD ((bf16_t*)(wsp + WS_QD))
#define KD ((bf16_t*)(wsp + WS_KD))
#define VD ((bf16_t*)(wsp + WS_VD))
#define MIX ((bf16_t*)(wsp + WS_MIX))
#define MB ((bf16_t*)(wsp + WS_MB))
#define YB ((bf16_t*)(wsp + WS_YB))
#define YBX ((unsigned char*)(wsp + WS_YBX))
#define HID ((bf16_t*)(wsp + WS_HID))
#define PART2 ((float*)(wsp + WS_PART2))
#define PART4 ((float*)(wsp + WS_PART4))
#define CTLW ((unsigned*)(wsp + WS_CTL))
#define LAUNDER_WS() unsigned char* wsp = ws; asm volatile("" : "+s"(wsp))
#define IN(k) (lo <= (k) && (k) < hi)
#ifndef REP_BAR
#define REP_BAR 1
#endif
#define SEAM(k) do { if (IN(k) && IN((k) + 1)) for (int rb_ = 0; rb_ < REP_BAR; ++rb_) xcd_barrier(bar); } while (0)
#ifndef DEFER_W
#define DEFER_W 1
#endif
#ifndef DEFER_M
#define DEFER_M 6
#endif
__device__ __forceinline__ void ffn_item(const Args& args, unsigned char* wsp, int mi, int item, LAS float* scr, int lane) {
    const int grp = mi / 3, which = mi % 3;
    const float* src; unsigned char* dst;
    if (grp < 2) { src = args.in[which == 0 ? I_F1 : which == 1 ? I_F3 : I_F2] + (size_t)grp * 1024 * FF; dst = (unsigned char*)(which == 2 ? F2 : F13) + (size_t)grp * (which == 2 ? 1 : 2) * FF * 1024; }
    else { const int je = grp - 2; src = args.in[which == 0 ? I_M1 : which == 1 ? I_M3 : I_M2] + (size_t)je * 1024 * FF; dst = (unsigned char*)(which == 2 ? M2 : M13) + (size_t)je * (which == 2 ? 1 : 2) * FF * 1024; }
    const float f8s = which == 2 ? F8_SW2 : F8_SW13;
    if (which == 2) transpose_item(src, FF, 1024, (bf16_t*)dst, 0, scr, item, lane, f8s);
    else transpose_item(src, 1024, FF, (bf16_t*)dst, which == 0 ? 2 : 3, scr, item, lane, f8s);
}
constexpr int I_FFI = 16 * 88;
template <int layer>
__device__ __forceinline__ void layer_body(LAS unsigned char* lds, const int wv, const Args& args, unsigned char* ws, const int G, const int bx, const int gw, const int lo, const int hi, const XcdBarrier& bar) {
        const int pb = PH_LAYER0 + layer * PH_PER_LAYER;
        if (hi <= pb || lo >= pb + PH_PER_LAYER) return;
        const bool last = layer == DEPTH - 1, moe = (layer & 1) != 0; const int j2 = layer >> 1;
        const int nrows = last ? TL : T, nMt = nrows / 256;
#define modl (MOD + (size_t)layer * 5 * 6144)
#define cnt (CTLW + CW_CNT + j2 * 64)
#define hl_in (layer == 0 ? args.in[I_X] : H)
#define hc_in (layer == 0 ? args.in[I_CTX] : H16C)

        if (PHON(2) && IN(pb + LP_G1)) { LAUNDER_WS();
            pg8::Gemm g{U, WIN + (size_t)layer * INC * 1024, 1024}; int tsd[9] = {0, 0x7fffffff, 0x7fffffff, 0x7fffffff, 0x7fffffff, 0x7fffffff, 0x7fffffff, 0x7fffffff, 0}; pg8::TileSched S; S.build(lds, wv, T / 256, INC / 256, G, bx, INC / 256, tsd, 16, 0, 1, 0, true);
            pg8::EpiIn E{LRUX, GATE, QS, KS, VS, QD, KD, VD, COS64, SIN64, COS32, SIN32};
            for (int rep_ = 0; rep_ < REP_G1; ++rep_) { pg8::gemm_phase<pg8::EpiIn, pg8::TileSched, true, true>(lds, wv, g, S, E);
                const pg8::TileSched SH = S.listB(); pg8::gemm_phase<pg8::EpiIn, pg8::TileSched, true, true, true>(lds, wv, g, SH, E); }
#if DEFER_W
            {
                const int nb = (G == 256) ? 64 : 0;
                if (bx >= nb) { __syncthreads(); LAS float* scr = (LAS float*)(lds + wv * 16384); const int ln = opaque_tid(wv) & 63;
                    const int mi0 = (layer < 2 ? 6 : 30) + (layer & 1) * DEFER_M;
                    for (int it = (bx - nb) * 8 + wv; it < DEFER_M * I_FFI; it += (G - nb) * 8) ffn_item(args, wsp, mi0 + it / I_FFI, it % I_FFI, scr, ln); }
            }
#endif
        }
        SEAM(pb + LP_G1);
#define LRU_BX(b_) (b_)
#define LRU_ARGS LruArgs LA{LRUX, GATE, MIX, GWT + (size_t)layer * 16 * 4096, args.in[I_CONVW] + layer * 1024, args.in[I_CONVB] + layer * 256, args.in[I_GATEB] + layer * 1024, args.in[I_LAM] + layer * 512, CM, CARRY, LRUAB}
        if (IN(pb + LP_AT)) { LAUNDER_WS(); LRU_ARGS;
            unsigned* ho = CTLW + CW_HO + layer * 3 * 64;
            { bool did = false; for (int u = G - 1 - bx; u < 64 + 32 * SWA_FIXM; u += G) { if (u < 64) kmax_unit(lds, wv, KD, KMAX, u >> 4, (u >> 2) & 3, u & 3); else kmax_unit(lds, wv, KS, KMAX + 128, (u - 64) >> 3, ((u - 64) >> 2) & 1, u & 3, 2); did = true; }
              if (did) ho_signal(ho + 0, wv); }
            if (PHON(3)) lru_phase<1>(lds, wv, LA, LRU_BX(bx), G, REP_LRU);
            ho_signal(ho + 64, wv);
            const float lam_init = layer == 0 ? 0.2f : layer == 1 ? 0.35550906759096926f : layer == 2 ? 0.47071301834358416f : 0.5560582041556405f;
            AttnArgs AA{QS, KS, VS, QD, KD, VD, MIX, args.in[I_SINK] + layer * 8, args.in[I_DLAM] + layer * 128, args.in[I_DNG] + layer * 64, lam_init, KMAX};
            float lam;
            { const int ln = opaque_tid(wv) & 63; const float* dl = AA.dlam; float p = 0.f, q = 0.f; if (ln < 32) { p = dl[ln] * dl[32 + ln]; q = dl[64 + ln] * dl[96 + ln]; }
              p = wave_sum(p); q = wave_sum(q); lam = __uint_as_float(__builtin_amdgcn_readfirstlane(__float_as_uint(fast_exp2(LOG2E * p) - fast_exp2(LOG2E * q) + lam_init))); }
            ho_wait(ho + 0, (unsigned)(G >= 64 + 32 * SWA_FIXM ? 64 + 32 * SWA_FIXM : G), wv);
            if (PHON(5)) for (int rep_ = 0; rep_ < REP_DIFF; ++rep_) for (int u = bx; u < 256; u += G) { const int x8 = u & 7, idx = u >> 3, bh = 2 * x8 + (idx >> 4), jq = idx & 15; diff_unit(lds, wv, AA, bh >> 2, bh & 3, jq, false, lam); }
            { bool did = false; for (int u = bx; u < NB * 2 * 8; u += G) { if (!did) ho_wait(ho + 64, (unsigned)G, wv); lru_scan_unit(lds, wv, CM, CARRY, u >> 4, (u >> 3) & 1, u & 7); did = true; }
              if (did) ho_signal(ho + 128, wv); }
#if DEFER_W
            auto swajob = [&](int slot, TrJob& J) -> bool {
                constexpr int NMAT = (layer == 3) ? 3 : 6;
                const int j = slot * 2048 + bx * 8 + wv; if (G != 256 || j >= NMAT * I_FFI) return false;
                const int q_ = j / I_FFI, item = j - q_ * I_FFI;
                const int mi = layer == 0 ? 18 + q_ : layer == 1 ? 24 + q_ : layer == 2 ? (q_ < 3 ? 3 + q_ : 45 + q_) : 51 + q_;
                const int grp = mi / 3, which = mi - grp * 3;
                if (grp < 2) { J.W = args.in[which == 0 ? I_F1 : which == 1 ? I_F3 : I_F2] + (size_t)grp * 1024 * FF; J.WT = (unsigned char*)(which == 2 ? F2 : F13) + (size_t)grp * (which == 2 ? 1 : 2) * FF * 1024; }
                else { const int je = grp - 2; J.W = args.in[which == 0 ? I_M1 : which == 1 ? I_M3 : I_M2] + (size_t)je * 1024 * FF; J.WT = (unsigned char*)(which == 2 ? M2 : M13) + (size_t)je * (which == 2 ? 1 : 2) * FF * 1024; }
                if (which == 2) { J.K = FF; J.N = 1024; J.kind = 0; J.f8s = F8_SW2; const int kb = item >> 5, nb = item & 31; J.k0 = 64 * kb; J.n0 = 32 * nb; }
                else { J.K = 1024; J.N = FF; J.kind = which == 0 ? 2 : 3; J.f8s = F8_SW13; const int kb = item / 88, nb = item - kb * 88; J.k0 = 64 * kb; J.n0 = 32 * nb; }
                return true; };
            if (PHON(6)) for (int u = bx; u < 512; u += G) { const int bhk = u & 7, jq = u >> 3; swa_unit(lds, wv, AA, bhk >> 1, bhk & 1, jq, false, swajob, (u - bx) / G); }
            if (G != 256) {
                __syncthreads(); LAS float* scr_ = (LAS float*)(lds + wv * 16384); const int ln_ = opaque_tid(wv) & 63; constexpr int NMAT = (layer == 3) ? 3 : 6;
                for (int it = bx * 8 + wv; it < NMAT * I_FFI; it += G * 8) { const int q_ = it / I_FFI; const int mi = layer == 0 ? 18 + q_ : layer == 1 ? 24 + q_ : layer == 2 ? (q_ < 3 ? 3 + q_ : 45 + q_) : 51 + q_; ffn_item(args, wsp, mi, it - q_ * I_FFI, scr_, ln_); }
                __syncthreads(); }
#else
            if (PHON(6)) for (int rep_ = 0; rep_ < REP_SWA; ++rep_) for (int u = bx; u < 512; u += G) { const int bhk = u & 7, jq = u >> 3; swa_unit(lds, wv, AA, bhk >> 1, bhk & 1, jq, false); }
#endif
            if (!last) {
                if (PHON(6)) for (int u = G - 1 - bx; u < 32; u += G) { const int bhk = u & 7, jq = u >> 3; swa_unit(lds, wv, AA, bhk >> 1, bhk & 1, jq, true); }
                if (PHON(5)) for (int u = G - 33 - bx; u < 16; u += G) { if (u >= 0) diff_unit(lds, wv, AA, u >> 2, u & 3, 0, true, lam); }
            }
            ho_wait(ho + 128, 64u, wv);
            if (PHON(4)) lru_phase2c(lds, wv, LA, LRU_BX(bx), G);
        }
        SEAM(pb + LP_AT);
        if (PHON(7) && IN(pb + LP_G2)) { LAUNDER_WS();
            pg8::Gemm g{MIX, WOUT + (size_t)layer * 1024 * 1024, 1024}; int tsd[9] = {0, 0x7fffffff, 0x7fffffff, 0x7fffffff, 0x7fffffff, 0x7fffffff, 0x7fffffff, 0x7fffffff, 0}; pg8::TileSched S; S.build(lds, wv, TL / 256, 4, G, bx, 4, tsd, 16, nMt - TL / 256, 8, 2);
            pg8::EpiPlain E{MB, 1024, PART2, TL, 1.f};
            for (int rep_ = 0; rep_ < REP_G2; ++rep_) pg8::gemm_phase<pg8::EpiPlain, pg8::TileSched, true, true>(lds, wv, g, S, E);
        }
        SEAM(pb + LP_G2);
        if (PHON(8) && IN(pb + LP_N1)) { LAUNDER_WS();
            LnArgs N{hl_in, hc_in, (RES16 == 2 && layer == 0) ? HX : H, (RES16 == 2 && layer == 0) ? HXC : H16C, MB, nullptr, nullptr, modl, 2, modl, 3, 4,
                     args.in[I_LNG] + (layer * 2 + 0) * 1024, args.in[I_LNB] + (layer * 2 + 0) * 1024, U, nrows,
                     args.in[I_RW] + (size_t)j2 * 8192, args.in[I_RB] + j2 * 8, TOKE, TOKG, TOKR, cnt, moe ? 0 : 1, PART2, 8, YBX, {0, 0, 0, 0, 0, 0, 0, 0}};
            if (moe) ln_pass<false, true, (RES16 == 1 && layer != 0), (RES16 == 1), 8>(lds, wv, N, gw); else ln_pass<false, false, (RES16 == 1 && layer != 0), (RES16 == 1 || (RES16 == 2 && layer == 0)), 8>(lds, wv, N, gw);
        }
        SEAM(pb + LP_N1);
#define MAKE_TS() int ts[9]; if (moe) exp_table(cnt, ts); else { ts[0] = 0; _Pragma("unroll") for (int e = 1; e < 9; ++e) ts[e] = 0x7fffffff; ts[8] = nMt; } const int nT = ts[8]
        if (PHON(10) && IN(pb + LP_G3)) { LAUNDER_WS(); MAKE_TS();
            pg8::TileSched S;
            if (moe) {
                pg8::Gemm g{(const unsigned char*)YBX, (const unsigned char*)M13 + (size_t)j2 * 8 * 2 * FF * 1024, 1024}; S.build(lds, wv, nT, 22, G, bx, 22, ts, 8, 0, 1, 0, false, T / 256);
                pg8::EpiSwiGLU8 E{(unsigned char*)HID, FF};
                for (int rep_ = 0; rep_ < REP_G3; ++rep_) pg8::gemm_phase<pg8::EpiSwiGLU8, pg8::TileSched, G3_ALIGN, true, false, true>(lds, wv, g, S, E);
            }
            else {
                pg8::Gemm g{(const unsigned char*)U, (const unsigned char*)F13 + (size_t)j2 * 2 * FF * 1024, 1024}; S.build(lds, wv, nT, 22, G, bx, 22, ts, 8);
                pg8::EpiSwiGLU8 E{(unsigned char*)HID, FF};
                for (int rep_ = 0; rep_ < REP_G3; ++rep_) pg8::gemm_phase<pg8::EpiSwiGLU8, pg8::TileSched, G3_ALIGN, true, false, true>(lds, wv, g, S, E);
            }
        }
        SEAM(pb + LP_G3);
        if (PHON(11) && IN(pb + LP_G4)) { LAUNDER_WS(); MAKE_TS();
            pg8::TileSched S;
            if (moe) {
                pg8::Gemm g{(const unsigned char*)HID, (const unsigned char*)M2 + (size_t)j2 * 8 * 1024 * FF, FF}; S.build(lds, wv, nT, 4, G, bx, 4, ts, 22, 0, 1, 0, true);
                pg8::EpiPlain E{YB, 1024, PART4, TL, 1.f / (F8_SH * F8_SW2)};
                for (int rep_ = 0; rep_ < REP_G4; ++rep_) { pg8::gemm_phase<pg8::EpiPlain, pg8::TileSched, true, true, false, true>(lds, wv, g, S, E);
                    const pg8::TileSched SH = S.listB(); pg8::gemm_phase<pg8::EpiPlain, pg8::TileSched, true, true, true, true>(lds, wv, g, SH, E); }
#if DEFER_W
                if (layer == 1) {
                    const int nwg_ = nT * 4, rem_ = nwg_ - (nwg_ / G) * G, busy_ = (2 * rem_ <= G) ? 2 * rem_ : rem_; const int nb = (G - busy_ >= 64) ? busy_ : 0;
                    if (bx >= nb) { __syncthreads(); LAS float* scr = (LAS float*)(lds + wv * 16384); const int ln = opaque_tid(wv) & 63;
                        for (int it = (bx - nb) * 8 + wv; it < 6 * I_FFI; it += (G - nb) * 8) ffn_item(args, wsp, 30 + 2 * DEFER_M + it / I_FFI, it % I_FFI, scr, ln); }
                }
#endif
            } else {
                pg8::Gemm g{(const unsigned char*)HID, (const unsigned char*)F2 + (size_t)j2 * 1024 * FF, FF}; S.build(lds, wv, TL / 256, 4, G, bx, 4, ts, 22, nT - TL / 256, 11, 2);
                pg8::EpiPlain E{YB, 1024, PART4, TL, 1.f / (F8_SH * F8_SW2)};
                for (int rep_ = 0; rep_ < REP_G4; ++rep_) pg8::gemm_phase<pg8::EpiPlain, pg8::TileSched, true, true, false, true>(lds, wv, g, S, E);
            }
        }
        SEAM(pb + LP_G4);
        if (PHON(12) && IN(pb + LP_N2)) { LAUNDER_WS();
            const float* modn = last ? nullptr : MOD + (size_t)(layer + 1) * 5 * 6144;
            LnArgs N{(RES16 == 2 && layer == 0) ? HX : H, (RES16 == 2 && layer == 0) ? HXC : H16C, last ? args.out : H, H16C, YB, nullptr, TOKG, modl, 5, modn, 0, 1,
                     args.in[I_LNG] + (layer * 2 + 1) * 1024, args.in[I_LNB] + (layer * 2 + 1) * 1024, U, nrows,
                     nullptr, nullptr, TOKE, nullptr, TOKR, nullptr, 0, moe ? nullptr : PART4, 11, nullptr, {0, 0, 0, 0, 0, 0, 0, 0}};
            if (moe) { int tsn[9]; exp_table(cnt, tsn); _Pragma("unroll") for (int e = 0; e < 8; ++e) N.ts[e] = tsn[e]; }
            if (moe) ln_pass<true, false, (RES16 == 1), (RES16 == 1 && !last)>(lds, wv, N, gw); else ln_pass<false, false, (RES16 == 1 || (RES16 == 2 && layer == 0)), (RES16 == 1 && !last)>(lds, wv, N, gw);
        }
        SEAM(pb + LP_N2);
}

__global__ void __launch_bounds__(512, 2) hymba_fwd(Args args) {
    extern __shared__ __attribute__((aligned(16))) unsigned char lds_raw[];
    LAS unsigned char* lds = (LAS unsigned char*)lds_raw;
    volatile LAS unsigned* MISC = (volatile LAS unsigned*)(lds + MISC_OFF);
    const int wv = __builtin_amdgcn_readfirstlane((int)(threadIdx.x >> 6));
    const int wid = wv, tid = opaque_tid(wv), lane = tid & 63;
    const int G = gridDim.x, bx = blockIdx.x;
    const int gw = bx * 8 + wid, NGW = G * 8;
    unsigned char* ws = args.ws;
    unsigned* ctl = (unsigned*)(ws + WS_CTL);
    for (int u = tid; u < (LDS_BYTES - LDSCTL_OFF) / 4; u += 512) ((LAS unsigned*)(lds + LDSCTL_OFF))[u] = 0u;
    __syncthreads();
    const int lo = args.ph_lo, hi = args.ph_hi;
    XcdBarrier bar; bar.bar = ctl + CW_BAR; bar.x = 0; bar.st = nullptr; bar.wv = wv;
    if (hi - lo > 1) bar = xcd_barrier_post(ctl + CW_BAR, MISC + 8, wv);

    unsigned char* wsp = ws;

    if (PHON(0) && IN(PH_P0)) for (int rep_ = 0; rep_ < REP_P0; ++rep_) {
        if (rep_) __syncthreads();
        {
            LAS float* SC = (LAS float*)lds;
            LAS float* RED = (LAS float*)(lds + 20480);
            for (int i = tid; i < 5 * 1024; i += 512) { const int cb = i >> 10, k = i & 1023; const float x = cb < 4 ? args.in[I_C][cb * 1024 + k] : args.in[I_CCTX][k]; SC[i] = x / (1.f + expf(-x)); }
            __syncthreads();
            for (int it = bx; it < DEPTH * 48; it += G) {
                const int layer = it / 48, cg = it % 48;
                const float* w = args.in[I_ADAW] + (size_t)layer * 1024 * 6144 + cg * 128 + 2 * lane;
                float a[5][2];
#pragma unroll
                for (int cb = 0; cb < 5; ++cb) { a[cb][0] = 0.f; a[cb][1] = 0.f; }
#pragma unroll 32
                for (int kk = 0; kk < 128; ++kk) { const int k = wid * 128 + kk; const f32x2 wv = *(const GAS f32x2*)(w + (size_t)k * 6144);
#pragma unroll
                    for (int cb = 0; cb < 5; ++cb) { const float s = SC[cb * 1024 + k]; a[cb][0] += s * wv[0]; a[cb][1] += s * wv[1]; } }
#pragma unroll
                for (int cb = 0; cb < 5; ++cb) { RED[(wid * 5 + cb) * 128 + 2 * lane] = a[cb][0]; RED[(wid * 5 + cb) * 128 + 2 * lane + 1] = a[cb][1]; }
                __syncthreads();
                for (int i = tid; i < 5 * 128; i += 512) { const int cb = i >> 7, c = i & 127; float s = 0.f;
#pragma unroll
                    for (int w8 = 0; w8 < 8; ++w8) s += RED[(w8 * 5 + cb) * 128 + c];
                    st_sc1(MOD + ((size_t)layer * 5 + cb) * 6144 + cg * 128 + c, s + args.in[I_ADAB][layer * 6144 + cg * 128 + c]); }
                __syncthreads();
            }
            ho_signal(ctl + CW_HOP, wv);
        }
        {
            for (int i = bx * 512 + tid; i < 4096 * 32; i += G * 512) { const int s = i >> 5, j = i & 31; const float inv = powf(10000.f, -(float)(j & 15) / 16.f);
                const float ang = (j < 16 ? (float)(s >> 6) : (float)(s & 63)) * inv; COS64[i] = cosf(ang); SIN64[i] = sinf(ang); }
            for (int i = bx * 512 + tid; i < 4096 * 16; i += G * 512) { const int s = i >> 4, j = i & 15; const float inv = powf(10000.f, -(float)(j & 7) / 8.f);
                const float ang = (j < 8 ? (float)(s >> 6) : (float)(s & 63)) * inv; COS32[i] = cosf(ang); SIN32[i] = sinf(ang); }
        }
        {
            LAS float* scr = (LAS float*)(lds + wid * 16384);
            constexpr int I_WINI = 16 * 64, I_WOUTI = 16 * 32, I_FF = 16 * 88  , I_GW = 2;
            constexpr int NFFM = DEFER_W ? 3 : 54;
            constexpr int N0 = DEPTH * I_WINI, N1 = N0 + DEPTH * I_WOUTI, N2 = N1 + NFFM * I_FF, N3 = N2 + 64 * I_GW;
            for (int it = gw; it < N3; it += NGW) {
                if (it < N0) { const int l = it / I_WINI; transpose_item(args.in[I_WIN] + (size_t)l * 1024 * INC, 1024, INC, WIN + (size_t)l * INC * 1024, 1, scr, it % I_WINI, lane); }
                else if (it < N1) { const int r = it - N0, l = r / I_WOUTI; transpose_item(args.in[I_WOUT] + (size_t)l * 1024 * 1024, 1024, 1024, WOUT + (size_t)l * 1024 * 1024, 0, scr, r % I_WOUTI, lane); }
                else if (it < N2) { const int r = it - N1, k = r / I_FF, item = r % I_FF;
                    const int mi = k;
                    ffn_item(args, wsp, mi, item, scr, lane); }
                else { const int r = it - N2, mi = r / I_GW; transpose_item(args.in[I_GATEW] + (size_t)mi * 4096, 64, 64, GWT + (size_t)mi * 4096, 0, scr, r % I_GW, lane); }
            }
        }
        {
            ho_wait(ctl + CW_HOP, (unsigned)G, wv);
        int curcb = -1; f32x4 sc[4], sh[4];
        for (int ri = 0; ri < ROWS_PER_WAVE; ++ri) {
            const int row = wave_row(gw, ri, T); if (row < 0) break;
            const bool lat = row < TL; const int cb = lat ? (row >> 12) : 4;
            if (cb != curcb) { curcb = cb;
#pragma unroll
                for (int j = 0; j < 4; ++j) { const float* ps = MOD + (size_t)(cb * 6 + 0) * 1024 + 4 * lane + 256 * j; const float* pc = MOD + (size_t)(cb * 6 + 1) * 1024 + 4 * lane + 256 * j;
                    sh[j] = (f32x4){ld_sc1(ps), ld_sc1(ps + 1), ld_sc1(ps + 2), ld_sc1(ps + 3)}; sc[j] = (f32x4){ld_sc1(pc), ld_sc1(pc + 1), ld_sc1(pc + 2), ld_sc1(pc + 3)}; } }
            const float* hin = lat ? args.in[I_X] + (size_t)row * 1024 : args.in[I_CTX] + (size_t)(row - TL) * 1024;
#pragma unroll
            for (int j = 0; j < 4; ++j) { f32x4 v = *(const GAS f32x4*)(hin + 4 * lane + 256 * j); v = v * (sc[j] + 1.f) + sh[j];
                u32x2 w; w.x = cvtpk(v[0], v[1]); w.y = cvtpk(v[2], v[3]); *(GAS u32x2*)(U + (size_t)row * 1024 + 4 * lane + 256 * j) = w; }
        }
        }
    }
    SEAM(PH_P0B);

    layer_body<0>(lds, wv, args, ws, G, bx, gw, lo, hi, bar);
    layer_body<1>(lds, wv, args, ws, G, bx, gw, lo, hi, bar);
    layer_body<2>(lds, wv, args, ws, G, bx, gw, lo, hi, bar);
    layer_body<3>(lds, wv, args, ws, G, bx, gw, lo, hi, bar);
#undef IN
#undef SEAM
}

extern "C" void kernel_launch(void* const* d_in, const int* in_sizes, int n_in, void* d_out, int out_size, void* d_ws, size_t ws_size, hipStream_t stream) {
    static int grid = 0;
    if (grid == 0) {
        if (n_in != 26 || out_size != TL * D || ws_size < WS_END) { fprintf(stderr, "kernel_launch: unexpected shapes (n_in %d, out %d, ws %zu < %zu)\n", n_in, out_size, ws_size, (size_t)WS_END); grid = -1; return; }
        int dev = 0, cus = 0, per_cu = 0;
        if (hipGetDevice(&dev) != hipSuccess || hipDeviceGetAttribute(&cus, hipDeviceAttributeMultiprocessorCount, dev) != hipSuccess) { grid = -1; return; }
        if (hipFuncSetAttribute((const void*)hymba_fwd, hipFuncAttributeMaxDynamicSharedMemorySize, LDS_BYTES) != hipSuccess) { fprintf(stderr, "kernel_launch: hipFuncSetAttribute failed\n"); grid = -1; return; }
        if (hipOccupancyMaxActiveBlocksPerMultiprocessor(&per_cu, (const void*)hymba_fwd, 512, LDS_BYTES) != hipSuccess || per_cu < 1) { fprintf(stderr, "kernel_launch: occupancy query reports %d\n", per_cu); }
        (void)hipGetLastError();
        grid = cus;
        if (per_cu < 1) grid = -1;
    }
    if (grid < 0) return;
    if (hipMemsetAsync((char*)d_ws + WS_CTL, 0, CTL_ZERO_BYTES, stream) != hipSuccess) return;
    Args a{};
    for (int i = 0; i < 26; ++i) a.in[i] = (const float*)d_in[i];
    a.out = (float*)d_out; a.ws = (unsigned char*)d_ws;
#if MK_N_LAUNCHES == 1
    a.ph_lo = 0; a.ph_hi = N_PHASES;
    hipLaunchKernelGGL(hymba_fwd, dim3(grid), dim3(512), LDS_BYTES, stream, a);
#else
    for (int p = 0; p < N_PHASES; ++p) {
        const int lp = p - PH_LAYER0;
        if (lp >= 0 && (lp % PH_PER_LAYER) == LP_R1 && (((lp / PH_PER_LAYER) & 1) == 0)) continue;
        a.ph_lo = p; a.ph_hi = p + 1;
        hipLaunchKernelGGL(hymba_fwd, dim3(grid), dim3(512), LDS_BYTES, stream, a);
    }
#endif
}
```

```cpp
#define DIFF_GRPB 0
#include <hip/hip_runtime.h>
#include <cstdio>
#include <cstdint>

#ifndef MK_N_LAUNCHES
#define MK_N_LAUNCHES 1
#endif

#define LAS __attribute__((address_space(3)))
#define GAS __attribute__((address_space(1)))
typedef unsigned short bf16_t;
typedef short bf16x8 __attribute__((ext_vector_type(8)));
typedef float f32x2 __attribute__((ext_vector_type(2)));
typedef float f32x4 __attribute__((ext_vector_type(4)));
typedef float f32x16 __attribute__((ext_vector_type(16)));
typedef unsigned u32x2 __attribute__((ext_vector_type(2)));
typedef unsigned u32x4 __attribute__((ext_vector_type(4)));
typedef short s16x4 __attribute__((ext_vector_type(4)));
typedef __bf16 bf16x2_t __attribute__((ext_vector_type(2)));

constexpr int D = 1024, NB = 4, SEQ = 4096, CTX = 256, TL = NB * SEQ, TC = NB * CTX, T = TL + TC, KEYS = CTX + SEQ;
constexpr int DEPTH = 4, INC = 2048, FF = 2816, NE = 8, NCB = 5;
constexpr int LRU_CH = 256, LRU_CHUNK = 32, LRU_NCH = KEYS / LRU_CHUNK;
constexpr float ALPHA = 1.6817928305074290f;
constexpr float LN_EPS = 1e-5f;
constexpr float LOG2E = 1.4426950408889634f;
constexpr int MOE_ROWS = 36864;

constexpr size_t MiB = 1u << 20;
constexpr size_t WS_CTL = 0, CTL_ZERO_BYTES = 64 * 1024;
constexpr size_t WS_MOD = 1 * MiB;
constexpr size_t WS_COS64 = WS_MOD + 512 * 1024, WS_SIN64 = WS_COS64 + 512 * 1024;
constexpr size_t WS_COS32 = WS_SIN64 + 512 * 1024, WS_SIN32 = WS_COS32 + 256 * 1024;
constexpr size_t WS_GWT = 3 * MiB;
constexpr size_t WS_CM = WS_GWT + 512 * 1024;
constexpr size_t WS_CARRY = WS_CM + 2304 * 1024;
constexpr size_t WS_KMAX = WS_MOD + 500 * 1024;
constexpr size_t WS_TOKE = 7 * MiB, WS_TOKG = WS_TOKE + 144 * 1024, WS_TOKR = WS_TOKG + 144 * 1024, WS_TOKS = WS_TOKR + 144 * 1024;
constexpr size_t WS_WIN = 8 * MiB;
constexpr size_t WS_WOUT = 24 * MiB;
constexpr size_t WS_F13 = 32 * MiB;
constexpr size_t WS_F2 = 54 * MiB;
constexpr size_t WS_M13 = 65 * MiB;
constexpr size_t WS_M2 = 241 * MiB;
constexpr size_t WS_H = 329 * MiB;
constexpr size_t WS_U = 397 * MiB;
constexpr size_t WS_X = 431 * MiB;
constexpr size_t WS_LRUX = WS_X;
constexpr size_t WS_GATE = WS_LRUX + (size_t)T * 256 * 2;
constexpr size_t WS_QS = WS_GATE + (size_t)T * 256 * 2;
constexpr size_t WS_KS = WS_QS + (size_t)T * 512 * 2;
constexpr size_t WS_VS = WS_KS + (size_t)NB * 2 * KEYS * 64 * 2;
constexpr size_t WS_QD = WS_VS + (size_t)NB * 2 * KEYS * 64 * 2;
constexpr size_t WS_KD = WS_QD + (size_t)T * 256 * 2;
constexpr size_t WS_VD = WS_KD + (size_t)NB * 4 * KEYS * 64 * 2;
constexpr size_t WS_MIX = WS_VD + (size_t)NB * 4 * KEYS * 64 * 2;
constexpr size_t WS_MB = WS_MIX + (size_t)T * 1024 * 2;
constexpr size_t WS_YB = WS_X;
constexpr size_t WS_HID = WS_YB + (size_t)MOE_ROWS * 1024 * 2;
constexpr size_t WS_END = WS_HID + (size_t)MOE_ROWS * FF * 2;
constexpr size_t WS_AB = WS_MB + (size_t)T * 1024 * 2;
static_assert(WS_AB + (size_t)NB * LRU_NCH * 2 * 16384 * 4 <= WS_END, "AB");
constexpr size_t WS_YBX = (size_t)602 << 20;
static_assert(WS_YBX >= WS_HID + (size_t)(2 * T + 2048) * 2816, "YBX");
constexpr size_t WS_PART2 = WS_X;
constexpr size_t WS_PART4 = 600 * MiB;
static_assert(WS_PART2 + 8 * 4 * MiB <= WS_MIX && WS_PART4 >= WS_HID + (size_t)T * FF * 2 && WS_PART4 + 11 * 4 * MiB <= WS_END, "partial buffers");
static_assert(WS_MB + (size_t)T * 1024 * 2 <= WS_END && WS_CM + (size_t)NB * LRU_NCH * 1024 * 4 <= WS_CARRY && WS_CARRY + (size_t)NB * LRU_NCH * 512 * 4 <= WS_TOKE && (size_t)T * 8 <= 144 * 1024 && WS_TOKS + 144 * 1024 <= WS_WIN, "ws map");
static_assert(WS_HID >= WS_MIX, "HID must not overlay buffers live during the up GEMM inputs");
constexpr int CW_BAR = 4096;
constexpr int CW_CNT = 1024;
constexpr int CW_HO = 2048;
constexpr int CW_HOP = 3072;
static_assert((CW_BAR + 3456) * 4 <= (int)CTL_ZERO_BYTES, "control words inside the memset region");

constexpr int RING_BYTES = 131072;
constexpr int LDSCTL_OFF = RING_BYTES, MISC_OFF = LDSCTL_OFF + 320;
constexpr int LDS_BYTES = 147456;

__device__ __forceinline__ int lane_id() { return (int)__builtin_amdgcn_mbcnt_hi(~0u, __builtin_amdgcn_mbcnt_lo(~0u, 0u)); }
__device__ __forceinline__ int opaque_tid(int wv) { unsigned z = 0u; asm volatile("" : "+v"(z));
    int t = wv * 64 + (int)__builtin_amdgcn_mbcnt_hi(~0u, __builtin_amdgcn_mbcnt_lo(~0u, z)); asm volatile("" : "+v"(t)); return t; }
#ifndef WT_STORES
#define WT_STORES 0
#endif
__device__ __forceinline__ void st16(void* p, u32x4 v) {
#if WT_STORES
    asm volatile("global_store_dwordx4 %0, %1, off sc1\n\ts_nop 1" :: "v"(p), "v"(v) : "memory");
#else
    *(GAS u32x4*)p = v;
#endif
}
__device__ __forceinline__ void st16f(void* p, f32x4 v) { st16(p, __builtin_bit_cast(u32x4, v)); }
__device__ __forceinline__ float clamp_f8(float v) { return __builtin_amdgcn_fmed3f(v, -416.f, 416.f); }
__device__ __forceinline__ unsigned cvt4_fp8(float a, float b, float c, float d) {
    int w = 0; w = __builtin_amdgcn_cvt_pk_fp8_f32(clamp_f8(a), clamp_f8(b), w, false); w = __builtin_amdgcn_cvt_pk_fp8_f32(clamp_f8(c), clamp_f8(d), w, true); return (unsigned)w;
}
constexpr float F8_SU = 4.f, F8_SW13 = 512.f, F8_SH = 2.f, F8_SW2 = 4096.f;
__device__ __forceinline__ unsigned cvtpk(float lo, float hi) { f32x2 v = {lo, hi}; bf16x2_t b = __builtin_convertvector(v, bf16x2_t); return __builtin_bit_cast(unsigned, b); }
__device__ __forceinline__ float bf2f(unsigned short x) { return __uint_as_float(((unsigned)x) << 16); }
__device__ __forceinline__ float bflo(unsigned w) { return __uint_as_float(w << 16); }
__device__ __forceinline__ float bfhi(unsigned w) { return __uint_as_float(w & 0xffff0000u); }
#define WS_DPP(v_, ctrl_) __uint_as_float((unsigned)__builtin_amdgcn_update_dpp(0, (int)__float_as_uint(v_), (ctrl_), 0xF, 0xF, true))
__device__ __forceinline__ float wave_sum(float v) {
    v += WS_DPP(v, 0xB1);
    v += WS_DPP(v, 0x4E);
    v += WS_DPP(v, 0x141);
    v += WS_DPP(v, 0x140);
    { auto rr = __builtin_amdgcn_permlane16_swap(__float_as_uint(v), __float_as_uint(v), false, false); v = __uint_as_float(rr[0]) + __uint_as_float(rr[1]); }
    { auto rr = __builtin_amdgcn_permlane32_swap(__float_as_uint(v), __float_as_uint(v), false, false); v = __uint_as_float(rr[0]) + __uint_as_float(rr[1]); }
    return v;
}
__device__ __forceinline__ float fast_exp2(float x) { return __builtin_amdgcn_exp2f(x); }
__device__ __forceinline__ float fast_rcp(float x) { return __builtin_amdgcn_rcpf(x); }
__device__ __forceinline__ float sigmoid_f(float x) { return fast_rcp(1.f + fast_exp2(-LOG2E * x)); }
__device__ __forceinline__ float silu_f(float x) { return x * sigmoid_f(x); }
__device__ __forceinline__ float gelu_tanh_f(float x) {
    const float z = 0.7978845608028654f * (x + 0.044715f * x * x * x);
    return x * sigmoid_f(2.f * z);
}

#define RLX_AGENT __ATOMIC_RELAXED, __HIP_MEMORY_SCOPE_AGENT
__device__ __forceinline__ void ho_signal(unsigned* cnt, int wv) {
    asm volatile("s_waitcnt vmcnt(0)" ::: "memory"); __syncthreads();
    if (wv == 0 && lane_id() == 0) __hip_atomic_fetch_add((GAS unsigned*)cnt, 1u, RLX_AGENT);
}
__device__ __forceinline__ void ho_wait(unsigned* cnt, unsigned target, int wv) {
    if (wv == 0) { unsigned sp = 0u; while (__hip_atomic_load((const GAS unsigned*)cnt, RLX_AGENT) < target) { __builtin_amdgcn_s_sleep(4); if (++sp > (1u << 22)) break; } }
    __syncthreads();
}
__device__ __forceinline__ void st_sc1(float* p, float v) { __hip_atomic_store((GAS unsigned*)p, __float_as_uint(v), RLX_AGENT); }
__device__ __forceinline__ float ld_sc1(const float* p) { return __uint_as_float(__hip_atomic_load((const GAS unsigned*)p, RLX_AGENT)); }

namespace pg8 {
#define PG8_LAS __attribute__((address_space(3)))
constexpr int BM = 256, BK = 64, HALF = 128, HTB = HALF * BK * 2  , STAGE_BYTES = 8 * HTB, NXCD = 8, WGM = 8;
__host__ __device__ __forceinline__ int lds_byte(int r, int c) { const int st = (r >> 4) * 2 + (c >> 5), rr = r & 15, cc = c & 31, ob = rr * 64 + cc * 2; return st * 1024 + (ob ^ (((ob >> 9) & 1) << 5)); }
__host__ __device__ __forceinline__ void stage_rc(int b, int& R, int& C) { const int st = b / 1024, sb = b % 1024, swz = sb ^ (((sb >> 9) & 1) << 5); R = (st >> 1) * 16 + swz / 64; C = (st & 1) * 32 + (swz % 64) / 2; }
__host__ __device__ __forceinline__ int perm32(int rho) { const int n = rho >> 4, i = rho & 15; return 8 * (i >> 2) + 4 * n + (i & 3); }

struct Unit { int pm, pn, pb, sp, nk, kofs, hf, pa; };
struct Gemm { const void* A; const void* Bt; int ld; };

constexpr int UNIT_LIST_OFF = RING_BYTES + 1024, UNIT_LIST_MAX = 64;
struct TileSched {
    PG8_LAS unsigned* ul; int nk_full, nk_piece;
    __device__ __forceinline__ void build(PG8_LAS unsigned char* lds, int wv, int nM, int nN, int G, int c, int nNb, const int (&ts)[9], int nkf, int nMs = 0, int nsplit = 1, int nkp = 0, bool halves = false, int gatherT = 0) {
        ul = (PG8_LAS unsigned*)(lds + UNIT_LIST_OFF); nk_full = nkf; nk_piece = nkp;
        const int t = opaque_tid(wv);
        if (t < 2 * UNIT_LIST_MAX) {
            const int i = t & (UNIT_LIST_MAX - 1); const bool listB = t >= UNIT_LIST_MAX;
            const int nwg = nM * nN; int nfullU = nwg; if (halves) { const int f = (nwg / G) * G; if (2 * (nwg - f) <= G) nfullU = f; }
            long L = (long)i * G + c; unsigned w = 0xffffffffu; unsigned hf = 0u; bool whole = false; unsigned wa = 0u;
            if (!listB) { whole = L < nfullU; }
            else { if (L < 2 * (long)(nwg - nfullU)) { hf = (unsigned)(L & 1); L = nfullU + (L >> 1); whole = true; } }
            if (whole) {
                int wgid = (int)L; { const int q = nwg / NXCD, r = nwg % NXCD, xcd = wgid % NXCD, off = wgid / NXCD; wgid = (xcd < r ? xcd * (q + 1) : r * (q + 1) + (xcd - r) * q) + off; }
                const int nig = WGM * nN, gid = wgid / nig, fm = gid * WGM, gsz = (nM - fm) < WGM ? (nM - fm) : WGM;
                const int pm = fm + ((wgid % nig) % gsz), pn = (wgid % nig) / gsz;
                int e = 0, tse = 0;
#pragma unroll
                for (int k = 1; k < 8; ++k) { const bool ge = pm >= ts[k]; e += ge ? 1 : 0; tse = ge ? ts[k] : tse; }
                w = (unsigned)pm | ((unsigned)pn << 10) | ((unsigned)(e * nNb + pn) << 16) | (hf << 29);
                wa = gatherT ? (unsigned)(e * gatherT + (pm - tse)) : (unsigned)pm;
            } else if (!listB && L >= nwg && L - nwg < (long)nMs * nN * nsplit) {
                const int Ls = (int)(L - nwg), per = nN * nsplit, pm = nM + Ls / per, rem = Ls % per, pn = rem / nsplit, sp = rem % nsplit + 1;
                w = (unsigned)pm | ((unsigned)pn << 10) | ((unsigned)pn << 16) | ((unsigned)sp << 24);
                wa = (unsigned)pm;
            }
            ul[t] = w; ul[t + 2 * UNIT_LIST_MAX] = wa;
        }
        __syncthreads();
    }
    __device__ __forceinline__ TileSched listB() const { TileSched s = *this; s.ul = ul + UNIT_LIST_MAX; return s; }
    __device__ __forceinline__ bool next(int i, Unit& u) const {
        if (i >= UNIT_LIST_MAX) return false;
        const unsigned w = (unsigned)__builtin_amdgcn_readfirstlane((int)ul[i]);
        if (w == 0xffffffffu) return false;
        u.pm = (int)(w & 1023u); u.pn = (int)((w >> 10) & 63u); u.pb = (int)((w >> 16) & 255u); u.sp = (int)((w >> 24) & 31u); u.hf = (int)((w >> 29) & 1u); u.pa = __builtin_amdgcn_readfirstlane((int)ul[i + 2 * UNIT_LIST_MAX]);
        u.nk = u.sp ? nk_piece : nk_full; u.kofs = u.sp ? (u.sp - 1) * nk_piece * 128 : 0; return true;
    }
    __device__ __forceinline__ void a_ready(const Unit&) const {}
    __device__ __forceinline__ void done(const Unit&) const {}
};

struct EpiPlain {
    static constexpr bool PERM = true, AFTER_DRAIN = false;
    bf16_t* O; int ldc; float* PART; int prow0; float scale;
    template <bool HN> __device__ __forceinline__ void run(const f32x4 (&acc)[2][2][4][2], const Unit& u, int wr, int wc, int fr_, int fq_) const {
        int ln_ = lane_id(); asm volatile("" : "+v"(ln_)); const int fr = ln_ & 15, fq = ln_ >> 4; (void)fr_; (void)fq_;
        int lrow = wr * 64 + fr, lcol = wc * 32 + 8 * fq; asm volatile("" : "+v"(lrow), "+v"(lcol));
        const int row0 = u.pm * BM + lrow, col0 = u.pn * BM + lcol + (HN ? u.hf * HALF : 0);
        if (!HN && u.sp) {
            bf16_t* P = (bf16_t*)PART + ((size_t)(u.sp - 1) * 1024 + (row0 - prow0)) * ldc + col0;
#pragma unroll
            for (int ai = 0; ai < 2; ++ai)
#pragma unroll
                for (int m = 0; m < 4; ++m) { bf16_t* rowp = P + (size_t)(ai * HALF + m * 16) * ldc;
#pragma unroll
                    for (int bj = 0; bj < 2; ++bj) { const f32x4 a0 = acc[ai][bj][m][0] * scale, a1 = acc[ai][bj][m][1] * scale;
                        u32x4 w; w.x = cvtpk(a0[0], a0[1]); w.y = cvtpk(a0[2], a0[3]); w.z = cvtpk(a1[0], a1[1]); w.w = cvtpk(a1[2], a1[3]); st16(rowp + bj * HALF, w); } }
            return;
        }
#pragma unroll
        for (int ai = 0; ai < 2; ++ai)
#pragma unroll
            for (int m = 0; m < 4; ++m) { bf16_t* rowp = O + (size_t)(row0 + ai * HALF + m * 16) * ldc + col0;
#pragma unroll
                for (int bj = 0; bj < (HN ? 1 : 2); ++bj) { const f32x4 v0 = acc[ai][bj][m][0] * scale, v1 = acc[ai][bj][m][1] * scale;
                    u32x4 w; w.x = cvtpk(v0[0], v0[1]); w.y = cvtpk(v0[2], v0[3]); w.z = cvtpk(v1[0], v1[1]); w.w = cvtpk(v1[2], v1[3]);
                    st16(rowp + bj * HALF, w); } }
    }
};
struct EpiSwiGLU {
    static constexpr bool PERM = true, AFTER_DRAIN = false;
    bf16_t* O; int ldc;
    template <bool HN> __device__ __forceinline__ void run(const f32x4 (&acc)[2][2][4][2], const Unit& u, int wr, int wc, int fr_, int fq_) const {
        int ln_ = lane_id(); asm volatile("" : "+v"(ln_)); const int fr = ln_ & 15, fq = ln_ >> 4; (void)fr_; (void)fq_;
        static_assert(!HN, "SwiGLU tiles pair the two column halves");
        int lrow = wr * 64 + fr, lcol = wc * 32 + 8 * fq; asm volatile("" : "+v"(lrow), "+v"(lcol));
        const int row0 = u.pm * BM + lrow, col0 = u.pn * HALF + lcol;
#pragma unroll
        for (int ai = 0; ai < 2; ++ai)
#pragma unroll
            for (int m = 0; m < 4; ++m) { bf16_t* rowp = O + (size_t)(row0 + ai * HALF + m * 16) * ldc + col0;
                float h[8];
#pragma unroll
                for (int n = 0; n < 2; ++n)
#pragma unroll
                    for (int j = 0; j < 4; ++j) h[4 * n + j] = silu_f(acc[ai][0][m][n][j]) * acc[ai][1][m][n][j];
                u32x4 w; w.x = cvtpk(h[0], h[1]); w.y = cvtpk(h[2], h[3]); w.z = cvtpk(h[4], h[5]); w.w = cvtpk(h[6], h[7]);
                st16(rowp, w); }
    }
};
struct EpiSwiGLU8 {
    static constexpr bool PERM = true, AFTER_DRAIN = false;
    unsigned char* O8; int ldc;
    template <bool HN> __device__ __forceinline__ void run(const f32x4 (&acc)[2][2][4][2], const Unit& u, int wr, int wc, int fr_, int fq_) const {
        int ln_ = lane_id(); asm volatile("" : "+v"(ln_)); const int fr = ln_ & 15, fq = ln_ >> 4; (void)fr_; (void)fq_;
        static_assert(!HN, "SwiGLU tiles pair the two column halves");
        int lrow = wr * 64 + fr, lcol = wc * 32 + 8 * fq; asm volatile("" : "+v"(lrow), "+v"(lcol));
        const int row0 = u.pm * BM + lrow, col0 = u.pn * HALF + lcol;
        const unsigned off0 = (unsigned)row0 * (unsigned)FF + (unsigned)col0;
        constexpr float si = 1.f / (F8_SU * F8_SW13);
        constexpr float KINV = (F8_SU * F8_SW13) * (F8_SU * F8_SW13) / F8_SH, KL2 = 21.f;
        static_assert(F8_SU * F8_SW13 == 2048.f && F8_SH == 2.f, "K = 2^-21");
#pragma unroll
        for (int ai = 0; ai < 2; ++ai)
#pragma unroll
            for (int m = 0; m < 4; ++m) { unsigned char* rowp = O8 + (off0 + (unsigned)((ai * HALF + m * 16) * FF));
                float h[8];
#pragma unroll
                for (int n = 0; n < 2; ++n)
#pragma unroll
                    for (int j = 0; j < 4; ++j) {
                        const float a0 = acc[ai][0][m][n][j], a1 = acc[ai][1][m][n][j];
                        h[4 * n + j] = (a0 * a1) * fast_rcp(KINV + fast_exp2(__builtin_fmaf(a0, -LOG2E * si, KL2))); }
                u32x2 w; w.x = cvt4_fp8(h[0], h[1], h[2], h[3]); w.y = cvt4_fp8(h[4], h[5], h[6], h[7]);
                *(GAS u32x2*)rowp = w; }
    }
};
struct EpiIn {
    static constexpr bool PERM = true, AFTER_DRAIN = false;
    bf16_t *LRUX, *GATE, *QS, *KS, *VS, *QD, *KD, *VD; const float *c64, *s64, *c32, *s32;
    template <bool HN> __device__ __forceinline__ void run(const f32x4 (&acc)[2][2][4][2], const Unit& u, int wr, int wc, int fr_, int fq_) const {
        int ln_ = lane_id(); asm volatile("" : "+v"(ln_)); const int fr = ln_ & 15, fq = ln_ >> 4; (void)fr_; (void)fq_;
        const int pm = u.pm, pn = u.pn;
        const bool lat = pm < 64;
        const int b = lat ? (pm >> 4) : (pm - 64);
        const int kr0 = lat ? CTX + (pm & 15) * 256 : 0;
        const int s0 = (pm & 15) * 256;
        const int lr0 = wr * 64 + fr;
        int cw = wc * 32 + 8 * fq;
        asm volatile("" : "+v"(cw));
#pragma unroll
        for (int bjl = 0; bjl < (HN ? 1 : 2); ++bjl) {
            const int bj = HN ? u.hf : bjl;
            const int ct = bj * HALF + cw;
            bf16_t* base; int stride; int mode = 0; float scale = 1.f; int pidx = 0; bool gel = false;
            if (pn == 0) { base = LRUX + (size_t)pm * 256 * 256 + ct; stride = 256; }
            else if (pn == 1) { base = GATE + (size_t)pm * 256 * 256 + ct; stride = 256; gel = true; }
            else if (pn == 2 || pn == 3) { const int col = (pn - 2) * 256 + ct; base = QS + (size_t)pm * 256 * 512 + col; stride = 512; mode = 1; pidx = (col & 63) >> 1; scale = 0.125f * LOG2E; }
            else if (pn == 4) { const int hk = (ct & 127) >> 6; bf16_t* kv = bj == 0 ? KS : VS; base = kv + ((size_t)(b * 2 + hk) * KEYS + kr0) * 64 + (ct & 63); stride = 64; mode = bj == 0 ? 1 : 0; pidx = (ct & 63) >> 1; }
            else if (pn == 5) { base = QD + (size_t)pm * 256 * 256 + ct; stride = 256; mode = 2; pidx = (ct & 31) >> 1; scale = 0.17677669529663687f * LOG2E; }
            else { const int h = ct >> 6; bf16_t* kv = pn == 6 ? KD : VD; base = kv + ((size_t)(b * 4 + h) * KEYS + kr0) * 64 + (ct & 63); stride = 64; mode = pn == 6 ? 2 : 0; pidx = (ct & 31) >> 1; }
            if (!lat) mode = 0;
            const bool colb = mode == 1 ? (pidx >= 16) : (pidx >= 8);
            f32x4 ce[4], se[4];
            if (mode != 0) {
#pragma unroll
                for (int k = 0; k < 4; ++k) { const int sk = s0 + lr0 + (colb ? 16 * k : 128 * (k & 1));
                    const float* ct_ = mode == 1 ? c64 + (size_t)sk * 32 + pidx : c32 + (size_t)sk * 16 + pidx;
                    const float* st_ = mode == 1 ? s64 + (size_t)sk * 32 + pidx : s32 + (size_t)sk * 16 + pidx;
                    ce[k] = *(const GAS f32x4*)ct_; se[k] = *(const GAS f32x4*)st_; }
            }
#pragma unroll
            for (int ai = 0; ai < 2; ++ai)
#pragma unroll
                for (int m = 0; m < 4; ++m) {
                    const int lr = lr0 + ai * HALF + m * 16;
                    f32x4 v0 = acc[ai][bjl][m][0], v1 = acc[ai][bjl][m][1];
                    if (mode != 0) {
                        f32x4 cs, sn;
#pragma unroll
                        for (int j = 0; j < 4; ++j) { cs[j] = colb ? ce[m][j] : ce[ai][j]; sn[j] = colb ? se[m][j] : se[ai][j]; }
                        f32x4 r0, r1;
                        r0[0] = v0[0] * cs[0] - v0[1] * sn[0]; r0[1] = v0[1] * cs[0] + v0[0] * sn[0];
                        r0[2] = v0[2] * cs[1] - v0[3] * sn[1]; r0[3] = v0[3] * cs[1] + v0[2] * sn[1];
                        r1[0] = v1[0] * cs[2] - v1[1] * sn[2]; r1[1] = v1[1] * cs[2] + v1[0] * sn[2];
                        r1[2] = v1[2] * cs[3] - v1[3] * sn[3]; r1[3] = v1[3] * cs[3] + v1[2] * sn[3];
                        v0 = r0; v1 = r1;
                    }
                    if (gel) {
#pragma unroll
                        for (int j = 0; j < 4; ++j) { v0[j] = gelu_tanh_f(v0[j]); v1[j] = gelu_tanh_f(v1[j]); }
                    }
                    v0 = v0 * scale; v1 = v1 * scale;
                    u32x4 w; w.x = cvtpk(v0[0], v0[1]); w.y = cvtpk(v0[2], v0[3]); w.z = cvtpk(v1[0], v1[1]); w.w = cvtpk(v1[2], v1[3]);
                    st16(base + (size_t)lr * stride, w);
                }
            asm volatile("" ::: "memory");
        }
    }
};

template <class Epi, class Sched, bool ALIGN_EPI = false, bool SP2 = false, bool HN = false, bool F8 = false>
__device__ __forceinline__ void gemm_phase(PG8_LAS unsigned char* lds, const int wv, const Gemm g, const Sched& S, const Epi& E) {
    const int tid = opaque_tid(wv), wid = __builtin_amdgcn_readfirstlane(tid >> 6), lane = tid & 63, wr = wid >> 2, wc = wid & 3, fr = lane & 15, fq = lane >> 4;
    constexpr int ESZ = F8 ? 1 : 2;
    const int K = g.ld;
    unsigned voffA[2], voffB[2];
#pragma unroll
    for (int i = 0; i < 2; ++i) { int R, C; stage_rc(tid * 16 + i * 8192, R, C); const int Rb = Epi::PERM ? ((R & ~31) + perm32(R & 31)) : R;
        voffA[i] = (unsigned)(R * K * ESZ + C * 2); voffB[i] = (unsigned)(Rb * K * ESZ + C * 2); }
    const size_t kstep = (size_t)(BK * 2);
    const size_t hstep = (size_t)HALF * K * ESZ;
    const size_t tstep = 2 * hstep;
    const unsigned ldsbase = (unsigned)(uintptr_t)lds + (unsigned)wid * 1024u;
    const unsigned ldsw = (unsigned)wid * 1024u;
    const int aoff = lds_byte(wr * 64 + fr, fq * 8), boff = lds_byte(wc * 32 + fr, fq * 8);
#define PG8_SA(b, h) (((b) * 2 + (h)) * HTB)
#define PG8_SB(b, h) ((4 + (b) * 2 + (h)) * HTB)
#define PG8_STAGE(bufoff, gbase, voff) do { _Pragma("unroll") for (int _i = 0; _i < 2; ++_i) { unsigned keep_; \
        asm volatile("s_mov_b32 %0, m0\n\ts_mov_b32 m0, %3\n\ts_nop 0\n\tglobal_load_lds_dwordx4 %1, %2\n\ts_mov_b32 m0, %0" \
                     : "=&s"(keep_) : "v"((voff)[_i]), "s"((const char*)(gbase)), "s"(ldsbase + (unsigned)((bufoff) + _i * 8192)) : "memory"); } } while (0)
#define PG8_LDA(dst, b, h) do { _Pragma("unroll") for (int m = 0; m < 4; ++m) { if constexpr (F8) { dst##8[m].lo = *(const PG8_LAS v4i_t*)(lds + PG8_SA(b, h) + aoff + m * 2048); dst##8[m].hi = *(const PG8_LAS v4i_t*)(lds + PG8_SA(b, h) + aoff + m * 2048 + 1024); } \
        else { _Pragma("unroll") for (int k = 0; k < 2; ++k) dst[m][k] = *(const PG8_LAS bf16x8*)(lds + PG8_SA(b, h) + aoff + m * 2048 + k * 1024); } } } while (0)
#define PG8_LDB(dst, b, h) do { _Pragma("unroll") for (int n = 0; n < 2; ++n) { if constexpr (F8) { dst##8[n].lo = *(const PG8_LAS v4i_t*)(lds + PG8_SB(b, h) + boff + n * 2048); dst##8[n].hi = *(const PG8_LAS v4i_t*)(lds + PG8_SB(b, h) + boff + n * 2048 + 1024); } \
        else { _Pragma("unroll") for (int k = 0; k < 2; ++k) dst[n][k] = *(const PG8_LAS bf16x8*)(lds + PG8_SB(b, h) + boff + n * 2048 + k * 1024); } } } while (0)
#define PG8_MMA(ai, bj, At, Bt) do { __builtin_amdgcn_s_setprio(1); _Pragma("unroll") for (int m = 0; m < 4; ++m) _Pragma("unroll") for (int n = 0; n < 2; ++n) { \
        if constexpr (F8) acc[ai][bj][m][n] = __builtin_amdgcn_mfma_scale_f32_16x16x128_f8f6f4(Bt##8[n], At##8[m], acc[ai][bj][m][n], 0, 0, 0, f8one, 0, f8one); \
        else { _Pragma("unroll") for (int k = 0; k < 2; ++k) acc[ai][bj][m][n] = __builtin_amdgcn_mfma_f32_16x16x32_bf16(Bt[n][k], At[m][k], acc[ai][bj][m][n], 0, 0, 0); } } \
        __builtin_amdgcn_s_setprio(0); } while (0)
#define PG8_MMAZ(ai, bj, At, Bt) do { __builtin_amdgcn_s_setprio(1); _Pragma("unroll") for (int m = 0; m < 4; ++m) _Pragma("unroll") for (int n = 0; n < 2; ++n) { \
        if constexpr (F8) acc[ai][bj][m][n] = __builtin_amdgcn_mfma_scale_f32_16x16x128_f8f6f4(Bt##8[n], At##8[m], (f32x4){0.f, 0.f, 0.f, 0.f}, 0, 0, 0, f8one, 0, f8one); \
        else { acc[ai][bj][m][n] = __builtin_amdgcn_mfma_f32_16x16x32_bf16(Bt[n][0], At[m][0], (f32x4){0.f, 0.f, 0.f, 0.f}, 0, 0, 0); acc[ai][bj][m][n] = __builtin_amdgcn_mfma_f32_16x16x32_bf16(Bt[n][1], At[m][1], acc[ai][bj][m][n], 0, 0, 0); } } \
        __builtin_amdgcn_s_setprio(0); } while (0)
#define PG8_MMAF(ai, bj, At, Bt) do { if constexpr (F8) PG8_MMA(ai, bj, At, Bt); else { if (t == 0) PG8_MMAZ(ai, bj, At, Bt); else PG8_MMA(ai, bj, At, Bt); } } while (0)
#define PG8_WAIT_V(n) asm volatile("s_waitcnt vmcnt(" #n ")" ::: "memory")
#define PG8_WAIT_L(n) asm volatile("s_waitcnt lgkmcnt(" #n ")" ::: "memory")
#define PG8_BAR __builtin_amdgcn_s_barrier()
#define PG8_SCHED __builtin_amdgcn_sched_barrier(0)
    typedef unsigned long long pg8_u64x2 __attribute__((ext_vector_type(2)));
#define PG8_ZERO4(x_) do { unsigned long long lo_, hi_; asm volatile("v_mov_b64 %0, 0" : "=v"(lo_)); asm volatile("v_mov_b64 %0, 0" : "=v"(hi_)); x_ = __builtin_bit_cast(f32x4, (pg8_u64x2){lo_, hi_}); } while (0)
    Unit cur, nxt; int ui = 0;
    if (!S.next(0, cur)) return;
    f32x4 acc[2][2][4][2];
    if constexpr (!SP2 || F8) {
#pragma unroll
    for (int a = 0; a < 2; ++a)
#pragma unroll
        for (int b = 0; b < 2; ++b)
#pragma unroll
            for (int m = 0; m < 4; ++m)
#pragma unroll
                for (int n = 0; n < 2; ++n) PG8_ZERO4(acc[a][b][m][n]);
    }
    int f8one; asm volatile("s_mov_b32 %0, 0x7f7f7f7f" : "=s"(f8one));
    typedef int v4i_t __attribute__((ext_vector_type(4))); typedef int v8i_t __attribute__((ext_vector_type(8)));
    bf16x8 At[4][2], B0[2][2], B1[2][2]; v8i_t At8[4], B08[2], B18[2];
    const char* cA = (const char*)g.A + (size_t)cur.pa * tstep + (size_t)cur.kofs; const char* cB = (const char*)g.Bt + (size_t)cur.pb * tstep + (size_t)cur.hf * hstep + (size_t)cur.kofs;
    int nt = cur.nk;
    S.a_ready(cur);
    if constexpr (SP2 && HN) {
        static_assert(!HN || SP2, "HN needs SP2");
        PG8_STAGE(PG8_SB(0, 0), cB, voffB); PG8_STAGE(PG8_SA(0, 0), cA, voffA); PG8_STAGE(PG8_SA(0, 1), cA + hstep, voffA);
        if (wr == 1) PG8_BAR;
        PG8_WAIT_V(2); PG8_BAR;
        PG8_STAGE(PG8_SB(1, 0), cB + kstep, voffB); PG8_STAGE(PG8_SA(1, 0), cA + kstep, voffA);
        PG8_WAIT_V(4); PG8_BAR;
    } else if constexpr (SP2) {
        PG8_STAGE(PG8_SB(0, 0), cB, voffB); PG8_STAGE(PG8_SB(0, 1), cB + hstep, voffB); PG8_STAGE(PG8_SA(0, 0), cA, voffA); PG8_STAGE(PG8_SA(0, 1), cA + hstep, voffA);
        if (wr == 1) PG8_BAR;
        PG8_WAIT_V(2); PG8_BAR;
        PG8_STAGE(PG8_SB(1, 0), cB + kstep, voffB); PG8_STAGE(PG8_SA(1, 0), cA + kstep, voffA); PG8_STAGE(PG8_SB(1, 1), cB + hstep + kstep, voffB);
        PG8_WAIT_V(6); PG8_BAR;
    } else {
        PG8_STAGE(PG8_SB(0, 0), cB, voffB); PG8_STAGE(PG8_SA(0, 0), cA, voffA); PG8_STAGE(PG8_SB(0, 1), cB + hstep, voffB); PG8_STAGE(PG8_SA(0, 1), cA + hstep, voffA);
        if (wr == 1) PG8_BAR;
        PG8_WAIT_V(4); PG8_BAR;
        PG8_STAGE(PG8_SB(1, 0), cB + kstep, voffB); PG8_STAGE(PG8_SA(1, 0), cA + kstep, voffA); PG8_STAGE(PG8_SB(1, 1), cB + hstep + kstep, voffB);
        PG8_WAIT_V(6); PG8_BAR;
    }
    for (;;) {
        const bool has_next = S.next(ui + 1, nxt);
        const char* nA = has_next ? (const char*)g.A + (size_t)nxt.pa * tstep + (size_t)nxt.kofs : cA; const char* nB = has_next ? (const char*)g.Bt + (size_t)nxt.pb * tstep + (size_t)nxt.hf * hstep + (size_t)nxt.kofs : cB;
        for (int t = 0; t < nt; t += 2) {
            const bool last = (t == nt - 2);
            const char* a1 = cA + (size_t)(t + 1) * kstep;
            const char* a2 = last ? nA : cA + (size_t)(t + 2) * kstep; const char* b2 = last ? nB : cB + (size_t)(t + 2) * kstep;
            const char* a3 = a2 + kstep; const char* b3 = b2 + kstep;
            if (last && has_next) S.a_ready(nxt);
            if constexpr (SP2 && HN) {
            PG8_LDB(B0, 0, 0); PG8_SCHED; PG8_LDA(At, 0, 0); PG8_STAGE(PG8_SA(1, 1), a1 + hstep, voffA);
            PG8_WAIT_V(6); PG8_WAIT_L(0); PG8_BAR; PG8_MMAF(0, 0, At, B0); PG8_BAR; PG8_SCHED;
            PG8_LDA(At, 0, 1); PG8_STAGE(PG8_SB(0, 0), b2, voffB); PG8_STAGE(PG8_SA(0, 0), a2, voffA);
            PG8_WAIT_V(6); PG8_WAIT_L(0); PG8_BAR; PG8_MMAF(1, 0, At, B0); PG8_BAR; PG8_SCHED;
            PG8_LDB(B0, 1, 0); PG8_SCHED; PG8_LDA(At, 1, 0); PG8_STAGE(PG8_SA(0, 1), a2 + hstep, voffA);
            PG8_WAIT_V(6); PG8_WAIT_L(0); PG8_BAR; PG8_MMA(0, 0, At, B0); PG8_BAR; PG8_SCHED;
            PG8_LDA(At, 1, 1); PG8_STAGE(PG8_SB(1, 0), b3, voffB); PG8_STAGE(PG8_SA(1, 0), a3, voffA);
            PG8_WAIT_V(6); PG8_WAIT_L(0); PG8_BAR; PG8_MMA(1, 0, At, B0); PG8_BAR; PG8_SCHED;
            } else if constexpr (SP2) {
            PG8_LDB(B0, 0, 0); PG8_LDB(B1, 0, 1); PG8_SCHED; PG8_LDA(At, 0, 0); PG8_STAGE(PG8_SA(1, 1), a1 + hstep, voffA);
            PG8_WAIT_V(8); PG8_WAIT_L(0); PG8_BAR; PG8_MMAF(0, 0, At, B0); PG8_MMAF(0, 1, At, B1); PG8_BAR; PG8_SCHED;
            PG8_LDA(At, 0, 1); PG8_STAGE(PG8_SB(0, 0), b2, voffB); PG8_STAGE(PG8_SB(0, 1), b2 + hstep, voffB); PG8_STAGE(PG8_SA(0, 0), a2, voffA);
            PG8_WAIT_V(8); PG8_WAIT_L(0); PG8_BAR; PG8_MMAF(1, 0, At, B0); PG8_MMAF(1, 1, At, B1); PG8_BAR; PG8_SCHED;
            PG8_LDB(B0, 1, 0); PG8_LDB(B1, 1, 1); PG8_SCHED; PG8_LDA(At, 1, 0); PG8_STAGE(PG8_SA(0, 1), a2 + hstep, voffA);
            PG8_WAIT_V(8); PG8_WAIT_L(0); PG8_BAR; PG8_MMA(0, 0, At, B0); PG8_MMA(0, 1, At, B1); PG8_BAR; PG8_SCHED;
            PG8_LDA(At, 1, 1); PG8_STAGE(PG8_SB(1, 0), b3, voffB); PG8_STAGE(PG8_SB(1, 1), b3 + hstep, voffB); PG8_STAGE(PG8_SA(1, 0), a3, voffA);
            PG8_WAIT_V(8); PG8_WAIT_L(0); PG8_BAR; PG8_MMA(1, 0, At, B0); PG8_MMA(1, 1, At, B1); PG8_BAR; PG8_SCHED;
            } else {
            PG8_LDB(B0, 0, 0); PG8_SCHED; PG8_LDA(At, 0, 0); PG8_STAGE(PG8_SA(1, 1), a1 + hstep, voffA);
            PG8_WAIT_L(8); PG8_BAR; PG8_WAIT_L(0); PG8_MMA(0, 0, At, B0); PG8_BAR; PG8_SCHED;
            PG8_LDB(B1, 0, 1); PG8_STAGE(PG8_SB(0, 0), b2, voffB);
            PG8_BAR; PG8_WAIT_L(0); PG8_MMA(0, 1, At, B1); PG8_BAR;
            PG8_LDA(At, 0, 1); PG8_STAGE(PG8_SA(0, 0), a2, voffA);
            PG8_BAR; PG8_WAIT_L(0); PG8_MMA(1, 0, At, B0); PG8_BAR; PG8_SCHED;
            PG8_STAGE(PG8_SB(0, 1), b2 + hstep, voffB);
            PG8_WAIT_V(6); PG8_BAR; PG8_MMA(1, 1, At, B1); PG8_BAR;
            PG8_LDB(B0, 1, 0); PG8_SCHED; PG8_LDA(At, 1, 0); PG8_STAGE(PG8_SA(0, 1), a2 + hstep, voffA);
            PG8_WAIT_L(8); PG8_BAR; PG8_WAIT_L(0); PG8_MMA(0, 0, At, B0); PG8_BAR; PG8_SCHED;
            PG8_LDB(B1, 1, 1); PG8_STAGE(PG8_SB(1, 0), b3, voffB);
            PG8_BAR; PG8_WAIT_L(0); PG8_MMA(0, 1, At, B1); PG8_BAR;
            PG8_LDA(At, 1, 1); PG8_STAGE(PG8_SA(1, 0), a3, voffA);
            PG8_BAR; PG8_WAIT_L(0); PG8_MMA(1, 0, At, B0); PG8_BAR; PG8_SCHED;
            PG8_STAGE(PG8_SB(1, 1), b3 + hstep, voffB);
            PG8_WAIT_V(6); PG8_BAR; PG8_MMA(1, 1, At, B1); PG8_BAR;
            }
        }
        if constexpr (ALIGN_EPI) { if (wr == 0) PG8_BAR; }
        if constexpr (!Epi::AFTER_DRAIN) { E.template run<HN>(acc, cur, wr, wc, fr, fq); S.done(cur); }
        if (!has_next) break;
        if constexpr (!SP2 || F8) {
#pragma unroll
        for (int a = 0; a < 2; ++a)
#pragma unroll
            for (int b = 0; b < 2; ++b)
#pragma unroll
                for (int m = 0; m < 4; ++m)
#pragma unroll
                    for (int n = 0; n < 2; ++n) PG8_ZERO4(acc[a][b][m][n]);
        }
        cur = nxt; cA = nA; cB = nB; ++ui; nt = cur.nk;
        if constexpr (ALIGN_EPI) { if (wr == 1) PG8_BAR; }
    }
    PG8_WAIT_V(0);
    if constexpr (!ALIGN_EPI) { if (wr == 0) PG8_BAR; }
    PG8_BAR;
    if constexpr (Epi::AFTER_DRAIN) { E.fused(acc, cur, wr, wc, fr, fq, lds, wid, lane); S.done(cur); }
#undef PG8_SA
#undef PG8_SB
#undef PG8_STAGE
#undef PG8_LDA
#undef PG8_LDB
#undef PG8_MMA
#undef PG8_ZERO4
#undef PG8_MMAZ
#undef PG8_MMAF
#undef PG8_WAIT_V
#undef PG8_WAIT_L
#undef PG8_BAR
#undef PG8_SCHED
}
}

#define XB_TMO      128
#define XB_XCNT(j)  (256  + 64 * (j))
#define XB_XSUB(j)  (1280 + 64 * (j))
#define XB_XGEN(j)  (2304 + 64 * (j))
#define XB_TOP      3328
#define XB_TOPGEN   3392
#define XCD_BAR_WORDS 3456
#define XB_SPIN_CAP (1u << 18)
#ifndef XB_EARLY_WB
#define XB_EARLY_WB 0
#endif

__device__ __forceinline__ unsigned xb_ld(unsigned* p)              { return __hip_atomic_load(p, __ATOMIC_RELAXED, __HIP_MEMORY_SCOPE_AGENT); }
__device__ __forceinline__ unsigned xb_add(unsigned* p, unsigned v) { return __hip_atomic_fetch_add(p, v, __ATOMIC_RELAXED, __HIP_MEMORY_SCOPE_AGENT); }
__device__ __forceinline__ unsigned xb_xcc_id() { return (unsigned)__builtin_amdgcn_s_getreg((3 << 11) | 20) & 0xFu; }
#define XB_SPIN(cond, bar) do { unsigned _sp = 0; while (cond) { __builtin_amdgcn_s_sleep(1); \
    if ((++_sp & 255u) == 0u) { if (xb_ld(&(bar)[XB_TMO])) break; if (_sp > XB_SPIN_CAP) { atomicAdd(&(bar)[XB_TMO], 1u); break; } } } } while (0)

struct XcdBarrier {
    unsigned* bar; unsigned x; int wv;
    volatile LAS unsigned* st;
};

__device__ __forceinline__ XcdBarrier xcd_barrier_post(unsigned* bar, volatile LAS unsigned* st, int wv) {
    XcdBarrier b; b.bar = bar; b.x = xb_xcc_id(); b.st = st; b.wv = wv;
    if (wv == 0 && lane_id() == 0) (void)xb_add(&bar[XB_XCNT(b.x)], 1u);
    return b;
}
__device__ __forceinline__ void xcd_barrier_complete(unsigned* bar, unsigned x, unsigned& nloc, unsigned& nx) {
    const unsigned G = gridDim.x * gridDim.y * gridDim.z;
    unsigned sum, cnt, mine, sp = 0u;
    for (;;) {
        sum = 0u; cnt = 0u; mine = 0u;
#pragma unroll
        for (unsigned j = 0; j < 16; ++j) { const unsigned c = xb_ld(&bar[XB_XCNT(j)]); sum += c; cnt += (c > 0u) ? 1u : 0u; mine = (j == x) ? c : mine; }
        if (sum == G) break;
        __builtin_amdgcn_s_sleep(1);
        if ((++sp & 255u) == 0u) { if (xb_ld(&bar[XB_TMO])) break; if (sp > XB_SPIN_CAP) { atomicAdd(&bar[XB_TMO], 1u); break; } }
    }
    nloc = mine > 0u ? mine : 1u; nx = cnt > 0u ? cnt : 1u;
}

__device__ __forceinline__ void xcd_barrier(const XcdBarrier& b) {
    asm volatile("s_waitcnt vmcnt(0)" ::: "memory");
    __syncthreads();
    if (b.wv == 0 && lane_id() == 0) {
        unsigned* bar = b.bar;
        __builtin_amdgcn_s_waitcnt(0);
        unsigned nloc = b.st[0], nx = b.st[1];
        if (nloc == 0u) { xcd_barrier_complete(bar, b.x, nloc, nx); b.st[0] = nloc; b.st[1] = nx; }
#if XB_EARLY_WB
        __builtin_amdgcn_fence(__ATOMIC_RELEASE, "agent");
#endif
        const unsigned old = xb_add(&bar[XB_XSUB(b.x)], 1u);
        const unsigned gen = old / nloc;
        if (old + 1u == (gen + 1u) * nloc) {
            __builtin_amdgcn_fence(__ATOMIC_RELEASE, "agent");
            asm volatile("s_waitcnt vmcnt(0)" ::: "memory");
            const unsigned og = xb_add(&bar[XB_TOP], 1u);
            const unsigned tg = og / nx;
            if (og + 1u == (tg + 1u) * nx) xb_add(&bar[XB_TOPGEN], 1u);
            else XB_SPIN(xb_ld(&bar[XB_TOPGEN]) == tg, bar);
            __builtin_amdgcn_fence(__ATOMIC_ACQUIRE, "agent");
            xb_add(&bar[XB_XGEN(b.x)], 1u);
            asm volatile("s_waitcnt vmcnt(0)" ::: "memory");
        } else {
            XB_SPIN(xb_ld(&bar[XB_XGEN(b.x)]) == gen, bar);
            __builtin_amdgcn_fence(__ATOMIC_ACQUIRE, "agent");
            asm volatile("s_waitcnt vmcnt(0)" ::: "memory");
        }
    }
    __syncthreads();
}

#ifndef SWA_FIXM
#define SWA_FIXM 1
#endif
#ifndef FD_SPREAD
#define FD_SPREAD 1
#endif
#ifndef DIFF_GRPB
#define DIFF_GRPB 1
#endif
#ifndef DIFF_STAG
#define DIFF_STAG 1
#endif
__device__ __forceinline__ int crow(int e, int h) { return (e & 3) + 8 * (e >> 2) + 4 * h; }
__device__ __forceinline__ float xhalf_max(float m) { auto rr = __builtin_amdgcn_permlane32_swap(__float_as_uint(m), __float_as_uint(m), false, false); return fmaxf(__uint_as_float(rr[0]), __uint_as_float(rr[1])); }
__device__ __forceinline__ float xhalf_sum(float m) { auto rr = __builtin_amdgcn_permlane32_swap(__float_as_uint(m), __float_as_uint(m), false, false); return __uint_as_float(rr[0]) + __uint_as_float(rr[1]); }
typedef short v4i16_t __attribute__((ext_vector_type(4)));
__device__ __forceinline__ void glds16(const void* gsrc, unsigned lds_dst) { unsigned keep;
    asm volatile("s_mov_b32 %0, m0\n\ts_mov_b32 m0, %2\n\ts_nop 0\n\tglobal_load_lds_dwordx4 %1, off\n\ts_mov_b32 m0, %0" : "=&s"(keep) : "v"(gsrc), "s"(lds_dst) : "memory"); }
__device__ __forceinline__ s16x4 vtr(LAS unsigned char* p) { return __builtin_bit_cast(s16x4, __builtin_amdgcn_ds_read_tr16_b64_v4i16((LAS v4i16_t*)p)); }

__device__ __forceinline__ f32x16 mfma_from_c(bf16x8 a, bf16x8 b, const f32x16& c) {
    f32x16 d; asm("s_nop 1\n\tv_mfma_f32_32x32x16_bf16 %0, %1, %2, %3" : "=&v"(d) : "v"(a), "v"(b), "v"(c)); return d;
}

struct TrJob { const float* W; unsigned char* WT; int N, K, kind, k0, n0; float f8s; };
struct NoJobs { __device__ __forceinline__ bool operator()(int, TrJob&) const { return false; } };
__device__ __forceinline__ int rowmap(int kind, int n);
__device__ __forceinline__ void tr_issue(const TrJob& J, int lane, f32x4 (&v)[8]) {
    const float* wp = J.W + (size_t)(J.k0 + (lane >> 3)) * J.N + J.n0 + 4 * (lane & 7);
#pragma unroll
    for (int i = 0; i < 8; ++i) v[i] = *(const GAS f32x4*)(wp + (size_t)(8 * i) * J.N);
}
__device__ __forceinline__ void tr_finish(const TrJob& J, LAS float* scr, int lane, const f32x4 (&v)[8]) {
#pragma unroll
    for (int i = 0; i < 8; ++i) { LAS float* d = scr + (8 * i + (lane >> 3)) * 33 + 4 * (lane & 7); d[0] = v[i][0]; d[1] = v[i][1]; d[2] = v[i][2]; d[3] = v[i][3]; }
    asm volatile("s_waitcnt lgkmcnt(0)" ::: "memory");
    const int c = lane & 7; const float f8s = J.f8s;
#pragma unroll
    for (int j = 0; j < 4; ++j) { const int n = (lane >> 3) + 8 * j; const LAS float* s = scr + (8 * c) * 33 + n;
        u32x2 o; o.x = cvt4_fp8(s[0 * 33] * f8s, s[1 * 33] * f8s, s[2 * 33] * f8s, s[3 * 33] * f8s); o.y = cvt4_fp8(s[4 * 33] * f8s, s[5 * 33] * f8s, s[6 * 33] * f8s, s[7 * 33] * f8s);
        *(GAS u32x2*)(J.WT + (size_t)rowmap(J.kind, J.n0 + n) * J.K + J.k0 + 8 * c) = o; }
    asm volatile("s_waitcnt lgkmcnt(0)" ::: "memory");
}
template <int NCOMP, int KSTEPS, bool MASK, bool FIXM, class JF = NoJobs>
__device__ __forceinline__ void flash_unit(LAS unsigned char* lds, const int wv, const bf16_t* qrow, const bf16_t* Kb, const bf16_t* Vb, int ntiles, int kb0, int qabs,
                                           float m0, float l0, const float* kmax, f32x16 (&o)[NCOMP][2], float (&lsum)[NCOMP], JF jf = JF(), int kord = 0) {
    const int tid = opaque_tid(wv), lane = tid & 63, r = lane & 31, h = lane >> 5;
    constexpr bool JOBS = !__is_same(JF, NoJobs);
    f32x4 tv[8]; TrJob TJ; TJ.W = nullptr; TJ.WT = nullptr; TJ.N = 0; TJ.K = 0; TJ.kind = 0; TJ.k0 = 0; TJ.n0 = 0; TJ.f8s = 0.f; bool tpend = false;
#pragma unroll
    for (int i = 0; i < 8; ++i) tv[i] = f32x4{0.f, 0.f, 0.f, 0.f};
    bf16x8 q[NCOMP][KSTEPS];
#pragma unroll
    for (int m = 0; m < NCOMP; ++m)
#pragma unroll
        for (int s = 0; s < KSTEPS; ++s) q[m][s] = *(const GAS bf16x8*)(qrow + m * 32 + 16 * s + 8 * h);
    float mrun[NCOMP], lrun[NCOMP];
    f32x16 negm;
    if (FIXM) {
        float bmax = 0.f;
#pragma unroll
        for (int m = 0; m < NCOMP; ++m) { float qq = 0.f;
#pragma unroll
            for (int s = 0; s < KSTEPS; ++s)
#pragma unroll
                for (int j = 0; j < 8; ++j) { const float x = bf2f((unsigned short)q[m][s][j]); qq += x * x; }
            qq = xhalf_sum(qq);
            bmax = fmaxf(bmax, __builtin_amdgcn_sqrtf(qq) * kmax[m]); }
        const float ref = fmaxf(bmax * 1.001f + 1e-3f, m0);
        l0 = l0 * fast_exp2(m0 - ref);
#pragma unroll
        for (int e = 0; e < 16; ++e) negm[e] = -ref;
    }
#pragma unroll
    for (int m = 0; m < NCOMP; ++m) { mrun[m] = m0; lrun[m] = (h == 0) ? l0 : 0.f; o[m][0] = f32x16{}; o[m][1] = f32x16{}; }
    bf16x8 onesA; f32x4 lacc[NCOMP];
    { const int g_ = lane >> 4, mr_ = lane & 15; const short v_ = ((mr_ == 0 && !(g_ & 1)) || (mr_ == 1 && (g_ & 1))) ? (short)0x3F80 : (short)0;
      onesA = (bf16x8){v_, v_, v_, v_, v_, v_, v_, v_}; }
#pragma unroll
    for (int m = 0; m < NCOMP; ++m) lacc[m] = f32x4{0.f, 0.f, 0.f, 0.f};
    const int wid_u = __builtin_amdgcn_readfirstlane(tid >> 6);
    const int srow = tid >> 3, scl = tid & 7;
    const size_t ksoff = (size_t)srow * 64 + ((scl ^ ((srow >> 1) & 7)) << 3);
    const size_t vsoff = (size_t)srow * 64 + ((scl ^ (((srow >> 1) & 1) << 2)) << 3);
    const unsigned lds0 = (unsigned)(uintptr_t)lds + (unsigned)wid_u * 1024u;
#define FA_STAGE(bufsel, krow_) do { const size_t g0_ = (size_t)(krow_) * 64; const unsigned d_ = (unsigned)__builtin_amdgcn_readfirstlane((int)(lds0 + (unsigned)(bufsel) * 16384u)); \
        glds16(Kb + g0_ + ksoff, d_); glds16(Vb + g0_ + vsoff, d_ + 8192u); } while (0)
    const int kswz = (r >> 1) & 7, kro = r * 128;
    const int q4 = (lane & 15) >> 2, p4 = lane & 3, grp = (lane >> 4) & 1;
    const int vro = 8192 + (4 * h + q4) * 128, vcol = grp * 32 + p4 * 8, vswz = ((q4 >> 1) & 1) << 6;
    FA_STAGE(0, 0);
    asm volatile("s_waitcnt vmcnt(0)" ::: "memory"); __syncthreads();
#pragma nounroll
    for (int it = 0; it < ntiles; ++it) {
        LAS unsigned char* buf = lds + (it & 1) * 16384;
        const bool more = it + 1 < ntiles;
        if (more) { const int kn = (it + 1 < 4) ? 64 * (it + 1) : kb0 + 64 * (it + 1 - 4); FA_STAGE((it + 1) & 1, kn); }
        bool tnew = false;
        if (JOBS && (it == 0 || it == 3)) { tnew = jf(kord + (it == 3 ? 2 : 0), TJ); if (tnew) tr_issue(TJ, lane, tv); }
        const int ktile = (it < 4) ? 64 * it : kb0 + 64 * (it - 4);
        bf16x8 pk[NCOMP][4];
        bf16x8 ka[NCOMP][KSTEPS][2];
#pragma unroll
        for (int m = 0; m < NCOMP; ++m)
#pragma unroll
            for (int s = 0; s < KSTEPS; ++s) { const int c = m * 4 + 2 * s + h;
                ka[m][s][0] = *(LAS bf16x8*)(buf + kro + ((c ^ kswz) << 4)); ka[m][s][1] = *(LAS bf16x8*)(buf + 4096 + kro + ((c ^ kswz) << 4)); }
        f32x16 sc[NCOMP][2];
#pragma unroll
        for (int m = 0; m < NCOMP; ++m) {
            if (FIXM) { sc[m][0] = mfma_from_c(ka[m][0][0], q[m][0], negm); sc[m][1] = mfma_from_c(ka[m][0][1], q[m][0], negm); }
            else { sc[m][0] = __builtin_amdgcn_mfma_f32_32x32x16_bf16(ka[m][0][0], q[m][0], f32x16{}, 0, 0, 0); sc[m][1] = __builtin_amdgcn_mfma_f32_32x32x16_bf16(ka[m][0][1], q[m][0], f32x16{}, 0, 0, 0); }
#pragma unroll
            for (int s = 1; s < KSTEPS; ++s) {
                sc[m][0] = __builtin_amdgcn_mfma_f32_32x32x16_bf16(ka[m][s][0], q[m][s], sc[m][0], 0, 0, 0);
                sc[m][1] = __builtin_amdgcn_mfma_f32_32x32x16_bf16(ka[m][s][1], q[m][s], sc[m][1], 0, 0, 0);
            }
        }
        bf16x8 vf[2][4];
#pragma unroll
        for (int db = 0; db < 2; ++db)
#pragma unroll
            for (int ks = 0; ks < 4; ++ks) { LAS unsigned char* vp = buf + vro + ks * 2048 + ((db * 64 + vcol) ^ vswz);
                const s16x4 lo = vtr(vp), hi = vtr(vp + 1024);
                vf[db][ks] = (bf16x8){lo[0], lo[1], lo[2], lo[3], hi[0], hi[1], hi[2], hi[3]}; }
#pragma unroll
        for (int m = 0; m < NCOMP; ++m) {
            f32x16 s0 = sc[m][0], s1 = sc[m][1];
            if (MASK && (it == 4 || it == ntiles - 1)) {
                const int kt0 = ktile - CTX - qabs + 4 * h;
#pragma unroll
                for (int e = 0; e < 16; ++e) { const int d0 = kt0 + (e & 3) + 8 * (e >> 2), d1 = d0 + 32;
                    if (d0 > 128 || d0 < -128) s0[e] = -1e30f;
                    if (d1 > 128 || d1 < -128) s1[e] = -1e30f; }
            }
            if (FIXM) {
#pragma unroll
                for (int e = 0; e < 16; ++e) { s0[e] = fast_exp2(s0[e]); s1[e] = fast_exp2(s1[e]); }
            } else {
            float mx = fmaxf(s0[0], s1[0]);
#pragma unroll
            for (int e = 1; e < 16; ++e) mx = fmaxf(mx, fmaxf(s0[e], s1[e]));
            mx = xhalf_max(mx);
            const float mn = fmaxf(mrun[m], mx), alpha = fast_exp2(mrun[m] - mn); mrun[m] = mn;
            float ps = 0.f;
#pragma unroll
            for (int e = 0; e < 16; ++e) { s0[e] = fast_exp2(s0[e] - mn); s1[e] = fast_exp2(s1[e] - mn); ps += s0[e] + s1[e]; }
            lrun[m] = lrun[m] * alpha + ps;
            if (__any(alpha != 1.f)) { o[m][0] = o[m][0] * alpha; o[m][1] = o[m][1] * alpha; }
            }
            u32x4 w;
            w.x = cvtpk(s0[0], s0[1]); w.y = cvtpk(s0[2], s0[3]); w.z = cvtpk(s0[4], s0[5]); w.w = cvtpk(s0[6], s0[7]); pk[m][0] = __builtin_bit_cast(bf16x8, w);
            w.x = cvtpk(s0[8], s0[9]); w.y = cvtpk(s0[10], s0[11]); w.z = cvtpk(s0[12], s0[13]); w.w = cvtpk(s0[14], s0[15]); pk[m][1] = __builtin_bit_cast(bf16x8, w);
            w.x = cvtpk(s1[0], s1[1]); w.y = cvtpk(s1[2], s1[3]); w.z = cvtpk(s1[4], s1[5]); w.w = cvtpk(s1[6], s1[7]); pk[m][2] = __builtin_bit_cast(bf16x8, w);
            w.x = cvtpk(s1[8], s1[9]); w.y = cvtpk(s1[10], s1[11]); w.z = cvtpk(s1[12], s1[13]); w.w = cvtpk(s1[14], s1[15]); pk[m][3] = __builtin_bit_cast(bf16x8, w);
#pragma unroll
            for (int db = 0; db < 2; ++db)
#pragma unroll
                for (int ks = 0; ks < 4; ++ks) o[m][db] = __builtin_amdgcn_mfma_f32_32x32x16_bf16(vf[db][ks], pk[m][ks], o[m][db], 0, 0, 0);
            if (FIXM) {
#pragma unroll
                for (int ks = 0; ks < 4; ++ks) lacc[m] = __builtin_amdgcn_mfma_f32_16x16x32_bf16(onesA, pk[m][ks], lacc[m], 0, 0, 0);
            }
        }
        if (JOBS && tpend && (it == 2 || it == 5)) { tr_finish(TJ, (LAS float*)(lds + 32768 + wid_u * 8448), lane, tv); tpend = false; }
        if (tnew) tpend = true;
        if (JOBS && tnew) asm volatile("s_waitcnt vmcnt(8)" ::: "memory"); else asm volatile("s_waitcnt vmcnt(0)" ::: "memory");
        __syncthreads();
    }
#pragma unroll
    for (int m = 0; m < NCOMP; ++m) {
        if (FIXM) { const float a0 = __shfl(lacc[m][0], r & 15), a1 = __shfl(lacc[m][1], r & 15); lsum[m] = ((r >> 4) ? a1 : a0) + l0; }
        else lsum[m] = xhalf_sum(lrun[m]);
    }
#undef FA_STAGE
}

#define FD_SB() __builtin_amdgcn_sched_barrier(0)
#ifndef FD_DUM3
#define FD_DUM3 0
#endif
#ifndef FD_DUM4
#define FD_DUM4 0
#endif
#ifndef FD_DUMOP
#define FD_DUMOP "v_exp_f32 %0, %1"
#endif
#define FD_DUMMY(n_) do { _Pragma("unroll") for (int d_ = 0; d_ < (n_); ++d_) { float dd_; asm volatile(FD_DUMOP : "=v"(dd_) : "v"(negm[0])); } } while (0)
template <bool GRPB>
__device__ __forceinline__ void flash_diff(LAS unsigned char* lds, const int wv, const bf16_t* qrow, const bf16_t* Kb, const bf16_t* Vb, int ntiles, int kb0, const float* kmax,
                                           f32x16 (&o)[2][2], float (&lsum)[2]) {
    const int tid = opaque_tid(wv), lane = tid & 63, r = lane & 31, h = lane >> 5;
    bf16x8 q[2][2];
#pragma unroll
    for (int m = 0; m < 2; ++m)
#pragma unroll
        for (int s = 0; s < 2; ++s) q[m][s] = *(const GAS bf16x8*)(qrow + m * 32 + 16 * s + 8 * h);
    f32x16 negm;
    { float bmax = 0.f;
#pragma unroll
      for (int m = 0; m < 2; ++m) { float qq = 0.f;
#pragma unroll
          for (int s = 0; s < 2; ++s)
#pragma unroll
              for (int j = 0; j < 8; ++j) { const float x = bf2f((unsigned short)q[m][s][j]); qq += x * x; }
          qq = xhalf_sum(qq);
          bmax = fmaxf(bmax, __builtin_amdgcn_sqrtf(qq) * kmax[m]); }
      const float ref = bmax * 1.001f + 1e-3f;
#pragma unroll
      for (int e = 0; e < 16; ++e) negm[e] = -ref; }
    bf16x8 onesA; f32x4 lacc[2];
    { const int g_ = lane >> 4, mr_ = lane & 15; const short v_ = ((mr_ == 0 && !(g_ & 1)) || (mr_ == 1 && (g_ & 1))) ? (short)0x3F80 : (short)0;
      onesA = (bf16x8){v_, v_, v_, v_, v_, v_, v_, v_}; }
#pragma unroll
    for (int m = 0; m < 2; ++m) { lacc[m] = f32x4{0.f, 0.f, 0.f, 0.f}; o[m][0] = f32x16{}; o[m][1] = f32x16{}; }
    const int wid_u = __builtin_amdgcn_readfirstlane(tid >> 6);
    const int srow = tid >> 3, scl = tid & 7;
    const size_t ksoff = (size_t)srow * 64 + ((scl ^ ((srow >> 1) & 7)) << 3);
    const size_t vsoff = (size_t)srow * 64 + ((scl ^ (((srow >> 1) & 1) << 2)) << 3);
    const unsigned lds0 = (unsigned)(uintptr_t)lds + (unsigned)wid_u * 1024u;
#define FD_STAGE(bufsel, krow_) do { const size_t g0_ = (size_t)(krow_) * 64; const unsigned d_ = (unsigned)__builtin_amdgcn_readfirstlane((int)(lds0 + (unsigned)(bufsel) * 16384u)); \
        glds16(Kb + g0_ + ksoff, d_); glds16(Vb + g0_ + vsoff, d_ + 8192u); } while (0)
#define FD_KROW(t_) (((t_) < 4) ? 64 * (t_) : kb0 + 64 * ((t_) - 4))
#define FD_SYNC(it_) do { asm volatile("s_waitcnt vmcnt(0)" ::: "memory"); __syncthreads(); const int tn_ = ((it_) + 2 < ntiles) ? (it_) + 2 : ntiles - 1; FD_STAGE((it_) & 1, FD_KROW(tn_)); } while (0)
#define FD_EXP4(v_, e0_) do { _Pragma("unroll") for (int e_ = (e0_); e_ < (e0_) + 4; ++e_) v_[e_] = fast_exp2(v_[e_]); } while (0)
#define FD_PACK(dst_, v_, e0_) do { u32x4 w_; w_.x = cvtpk(v_[(e0_)], v_[(e0_) + 1]); w_.y = cvtpk(v_[(e0_) + 2], v_[(e0_) + 3]); w_.z = cvtpk(v_[(e0_) + 4], v_[(e0_) + 5]); w_.w = cvtpk(v_[(e0_) + 6], v_[(e0_) + 7]); \
        dst_ = __builtin_bit_cast(bf16x8, w_); } while (0)
#define FD_MFMA(a_, b_, c_) __builtin_amdgcn_mfma_f32_32x32x16_bf16(a_, b_, c_, 0, 0, 0)
#define FD_SUM(m_, b_) lacc[m_] = __builtin_amdgcn_mfma_f32_16x16x32_bf16(onesA, b_, lacc[m_], 0, 0, 0)
    const int kswz = (r >> 1) & 7, kro = r * 128;
    const int q4 = (lane & 15) >> 2, p4 = lane & 3, grp = (lane >> 4) & 1;
    const int vro = 8192 + (4 * h + q4) * 128, vcol = grp * 32 + p4 * 8, vswz = ((q4 >> 1) & 1) << 6;
    FD_STAGE(0, 0);
    asm volatile("s_waitcnt vmcnt(0)" ::: "memory"); __syncthreads();
    FD_STAGE(1, FD_KROW(1));
#pragma nounroll
    for (int it = 0; it < ntiles; ++it) {
        LAS unsigned char* buf = lds + (it & 1) * 16384;
        bf16x8 ka[2][2][2];
#pragma unroll
        for (int m = 0; m < 2; ++m)
#pragma unroll
            for (int s = 0; s < 2; ++s) { const int c = m * 4 + 2 * s + h;
                ka[m][s][0] = *(LAS bf16x8*)(buf + kro + ((c ^ kswz) << 4)); ka[m][s][1] = *(LAS bf16x8*)(buf + 4096 + kro + ((c ^ kswz) << 4)); }
#if FD_SPREAD == 3
        f32x16 s00 = mfma_from_c(ka[0][0][0], q[0][0], negm); s00 = FD_MFMA(ka[0][1][0], q[0][1], s00);
        bf16x8 vf[2][4];
#pragma unroll
        for (int db = 0; db < 2; ++db)
#pragma unroll
            for (int ks = 0; ks < 4; ++ks) { LAS unsigned char* vp = buf + vro + ks * 2048 + ((db * 64 + vcol) ^ vswz);
                const s16x4 lo = vtr(vp), hi = vtr(vp + 1024);
                vf[db][ks] = (bf16x8){lo[0], lo[1], lo[2], lo[3], hi[0], hi[1], hi[2], hi[3]}; }
        FD_SB();
        f32x16 s01 = mfma_from_c(ka[0][0][1], q[0][0], negm); FD_EXP4(s00, 0); FD_SB();
        s01 = FD_MFMA(ka[0][1][1], q[0][1], s01); FD_EXP4(s00, 4); FD_SB();
        f32x16 s10 = mfma_from_c(ka[1][0][0], q[1][0], negm); FD_EXP4(s00, 8); FD_SB();
        f32x16 s11 = mfma_from_c(ka[1][0][1], q[1][0], negm); FD_EXP4(s00, 12); FD_SB();
        bf16x8 pk0[4], pk1[4];
        s10 = FD_MFMA(ka[1][1][0], q[1][1], s10); FD_PACK(pk0[0], s00, 0); FD_EXP4(s01, 0); FD_SB();
        s11 = FD_MFMA(ka[1][1][1], q[1][1], s11); FD_PACK(pk0[1], s00, 8); FD_EXP4(s01, 4); FD_SB();
        o[0][0] = FD_MFMA(vf[0][0], pk0[0], o[0][0]); FD_EXP4(s01, 8); FD_PACK(pk0[2], s01, 0); FD_SB();
        o[0][1] = FD_MFMA(vf[1][0], pk0[0], o[0][1]); FD_EXP4(s01, 12); FD_SB();
        o[0][0] = FD_MFMA(vf[0][1], pk0[1], o[0][0]); FD_PACK(pk0[3], s01, 8); FD_EXP4(s10, 0); FD_SB();
        o[0][1] = FD_MFMA(vf[1][1], pk0[1], o[0][1]); FD_EXP4(s10, 4); FD_SUM(0, pk0[0]); FD_SB();
        o[0][0] = FD_MFMA(vf[0][2], pk0[2], o[0][0]); FD_EXP4(s10, 8); FD_PACK(pk1[0], s10, 0); FD_SB();
        o[0][1] = FD_MFMA(vf[1][2], pk0[2], o[0][1]); FD_EXP4(s10, 12); FD_SUM(0, pk0[1]); FD_SB();
        o[0][0] = FD_MFMA(vf[0][3], pk0[3], o[0][0]); FD_PACK(pk1[1], s10, 8); FD_EXP4(s11, 0); FD_SUM(0, pk0[2]); FD_SB();
        o[0][1] = FD_MFMA(vf[1][3], pk0[3], o[0][1]); FD_EXP4(s11, 4); FD_SUM(0, pk0[3]); FD_SB();
        o[1][0] = FD_MFMA(vf[0][0], pk1[0], o[1][0]); FD_EXP4(s11, 8); FD_PACK(pk1[2], s11, 0); FD_SB();
        o[1][1] = FD_MFMA(vf[1][0], pk1[0], o[1][1]); FD_EXP4(s11, 12); FD_SUM(1, pk1[0]); FD_SB();
        o[1][0] = FD_MFMA(vf[0][1], pk1[1], o[1][0]); FD_PACK(pk1[3], s11, 8); FD_SB();
        o[1][1] = FD_MFMA(vf[1][1], pk1[1], o[1][1]); FD_SUM(1, pk1[1]); FD_SB();
        o[1][0] = FD_MFMA(vf[0][2], pk1[2], o[1][0]); FD_SB(); o[1][1] = FD_MFMA(vf[1][2], pk1[2], o[1][1]); FD_SUM(1, pk1[2]); FD_SB();
        o[1][0] = FD_MFMA(vf[0][3], pk1[3], o[1][0]); FD_SB(); o[1][1] = FD_MFMA(vf[1][3], pk1[3], o[1][1]); FD_SUM(1, pk1[3]); FD_SB();
#else
        f32x16 s00 = mfma_from_c(ka[0][0][0], q[0][0], negm), s01 = mfma_from_c(ka[0][0][1], q[0][0], negm);
        s00 = FD_MFMA(ka[0][1][0], q[0][1], s00); s01 = FD_MFMA(ka[0][1][1], q[0][1], s01);
        bf16x8 vf[2][4];
#pragma unroll
        for (int db = 0; db < 2; ++db)
#pragma unroll
            for (int ks = 0; ks < 4; ++ks) { LAS unsigned char* vp = buf + vro + ks * 2048 + ((db * 64 + vcol) ^ vswz);
                const s16x4 lo = vtr(vp), hi = vtr(vp + 1024);
                vf[db][ks] = (bf16x8){lo[0], lo[1], lo[2], lo[3], hi[0], hi[1], hi[2], hi[3]}; }
        FD_SB();
        f32x16 s10 = mfma_from_c(ka[1][0][0], q[1][0], negm); FD_EXP4(s00, 0); FD_SB();
        f32x16 s11 = mfma_from_c(ka[1][0][1], q[1][0], negm); FD_EXP4(s00, 4); FD_SB();
        s10 = FD_MFMA(ka[1][1][0], q[1][1], s10); FD_EXP4(s00, 8); FD_SB();
        s11 = FD_MFMA(ka[1][1][1], q[1][1], s11); FD_EXP4(s00, 12); FD_SB();
#if FD_SPREAD
        bf16x8 pk0[4], pk1[4];
        FD_PACK(pk0[0], s00, 0); FD_PACK(pk0[1], s00, 8);
        FD_SB();
        if (GRPB) { FD_SYNC(it); FD_SB(); }
        o[0][0] = FD_MFMA(vf[0][0], pk0[0], o[0][0]); FD_EXP4(s01, 0); FD_SB();
        o[0][1] = FD_MFMA(vf[1][0], pk0[0], o[0][1]); FD_EXP4(s01, 4); FD_PACK(pk0[2], s01, 0); FD_SB();
        o[0][0] = FD_MFMA(vf[0][1], pk0[1], o[0][0]); FD_EXP4(s01, 8); FD_SB();
        o[0][1] = FD_MFMA(vf[1][1], pk0[1], o[0][1]); FD_EXP4(s01, 12); FD_PACK(pk0[3], s01, 8); FD_SUM(0, pk0[0]); FD_SB();
        o[0][0] = FD_MFMA(vf[0][2], pk0[2], o[0][0]); FD_EXP4(s10, 0); FD_SB();
        o[0][1] = FD_MFMA(vf[1][2], pk0[2], o[0][1]); FD_EXP4(s10, 4); FD_PACK(pk1[0], s10, 0); FD_SUM(0, pk0[1]); FD_SB();
        o[0][0] = FD_MFMA(vf[0][3], pk0[3], o[0][0]); FD_EXP4(s10, 8); FD_SUM(0, pk0[2]); FD_SB();
        o[0][1] = FD_MFMA(vf[1][3], pk0[3], o[0][1]); FD_EXP4(s10, 12); FD_PACK(pk1[1], s10, 8); FD_SUM(0, pk0[3]); FD_SB();
        o[1][0] = FD_MFMA(vf[0][0], pk1[0], o[1][0]); FD_EXP4(s11, 0); FD_SB();
        o[1][1] = FD_MFMA(vf[1][0], pk1[0], o[1][1]); FD_EXP4(s11, 4); FD_PACK(pk1[2], s11, 0); FD_SUM(1, pk1[0]); FD_SB();
        o[1][0] = FD_MFMA(vf[0][1], pk1[1], o[1][0]); FD_EXP4(s11, 8); FD_SB();
        o[1][1] = FD_MFMA(vf[1][1], pk1[1], o[1][1]); FD_EXP4(s11, 12); FD_PACK(pk1[3], s11, 8); FD_SUM(1, pk1[1]); FD_SB();
        o[1][0] = FD_MFMA(vf[0][2], pk1[2], o[1][0]); FD_SB(); o[1][1] = FD_MFMA(vf[1][2], pk1[2], o[1][1]); FD_SUM(1, pk1[2]); FD_SB();
        o[1][0] = FD_MFMA(vf[0][3], pk1[3], o[1][0]); FD_SB(); o[1][1] = FD_MFMA(vf[1][3], pk1[3], o[1][1]); FD_SUM(1, pk1[3]); FD_SB();
#else
        bf16x8 pk0[4], pk1[4];
        FD_PACK(pk0[0], s00, 0); FD_PACK(pk0[1], s00, 8);
        FD_EXP4(s01, 0); FD_EXP4(s01, 4); FD_EXP4(s01, 8); FD_EXP4(s01, 12);
        FD_PACK(pk0[2], s01, 0); FD_PACK(pk0[3], s01, 8);
        FD_SB();
        if (GRPB) { FD_SYNC(it); FD_SB(); }
        o[0][0] = FD_MFMA(vf[0][0], pk0[0], o[0][0]); FD_EXP4(s10, 0); FD_DUMMY(FD_DUM3); FD_SB();
        o[0][1] = FD_MFMA(vf[1][0], pk0[0], o[0][1]); FD_EXP4(s10, 4); FD_DUMMY(FD_DUM3); FD_SB();
        o[0][0] = FD_MFMA(vf[0][1], pk0[1], o[0][0]); FD_EXP4(s10, 8); FD_PACK(pk1[0], s10, 0); FD_DUMMY(FD_DUM3); FD_SB();
        o[0][1] = FD_MFMA(vf[1][1], pk0[1], o[0][1]); FD_EXP4(s10, 12); FD_SUM(0, pk0[0]); FD_DUMMY(FD_DUM3); FD_SB();
        o[0][0] = FD_MFMA(vf[0][2], pk0[2], o[0][0]); FD_EXP4(s11, 0); FD_PACK(pk1[1], s10, 8); FD_DUMMY(FD_DUM3); FD_SB();
        o[0][1] = FD_MFMA(vf[1][2], pk0[2], o[0][1]); FD_EXP4(s11, 4); FD_SUM(0, pk0[1]); FD_DUMMY(FD_DUM3); FD_SB();
        o[0][0] = FD_MFMA(vf[0][3], pk0[3], o[0][0]); FD_EXP4(s11, 8); FD_PACK(pk1[2], s11, 0); FD_SUM(0, pk0[2]); FD_DUMMY(FD_DUM3); FD_SB();
        o[0][1] = FD_MFMA(vf[1][3], pk0[3], o[0][1]); FD_EXP4(s11, 12); FD_PACK(pk1[3], s11, 8); FD_SUM(0, pk0[3]); FD_DUMMY(FD_DUM3); FD_SB();
#pragma unroll
        for (int ks = 0; ks < 4; ++ks) { o[1][0] = FD_MFMA(vf[0][ks], pk1[ks], o[1][0]); FD_DUMMY(FD_DUM4); FD_SB(); o[1][1] = FD_MFMA(vf[1][ks], pk1[ks], o[1][1]); FD_DUMMY(FD_DUM4); FD_SUM(1, pk1[ks]); FD_SB(); }
#endif
#endif
        FD_SB();
        if (!GRPB) FD_SYNC(it);
    }
    asm volatile("s_waitcnt vmcnt(0)" ::: "memory"); __syncthreads();
#pragma unroll
    for (int m = 0; m < 2; ++m) { const float a0 = __shfl(lacc[m][0], r & 15), a1 = __shfl(lacc[m][1], r & 15); lsum[m] = (r >> 4) ? a1 : a0; }
#undef FD_STAGE
#undef FD_KROW
#undef FD_SYNC
#undef FD_EXP4
#undef FD_PACK
#undef FD_MFMA
#undef FD_SUM
}

__device__ __forceinline__ void store_ot(bf16_t* dst, const f32x16 (&v)[2], int h) {
#pragma unroll
    for (int db = 0; db < 2; ++db)
#pragma unroll
        for (int e4 = 0; e4 < 4; ++e4) { u32x2 w; w.x = cvtpk(v[db][4 * e4], v[db][4 * e4 + 1]); w.y = cvtpk(v[db][4 * e4 + 2], v[db][4 * e4 + 3]);
            *(GAS u32x2*)(dst + 32 * db + 8 * e4 + 4 * h) = w; }
}

struct AttnArgs { const bf16_t *QS, *KS, *VS, *QD, *KD, *VD; bf16_t* MIX; const float *sink, *dlam, *dng; float lam_init; const float* kmax; };

template <class JF = NoJobs>
__device__ __forceinline__ void swa_unit(LAS unsigned char* lds, const int wv, const AttnArgs& A, int b, int hk, int jq, bool ctxq, JF jf = JF(), int kord = 0) {
    const int tid = opaque_tid(wv), lane = tid & 63, wid = tid >> 6, r = lane & 31, h = lane >> 5;
    const int head = hk * 4 + (wid >> 1), qpos = 64 * jq + 32 * (wid & 1) + r;
    const int row = ctxq ? TL + b * CTX + qpos : b * SEQ + qpos;
    const bf16_t* qrow = A.QS + (size_t)row * 512 + head * 64;
    const bf16_t* Kb = A.KS + (size_t)(b * 2 + hk) * KEYS * 64; const bf16_t* Vb = A.VS + (size_t)(b * 2 + hk) * KEYS * 64;
    int ntiles = 4, kb0 = CTX;
    if (!ctxq) { const int q0 = 64 * jq; int lo = q0 - 128; if (lo < 0) lo = 0; int hi = q0 + 64 + 128; if (hi > SEQ) hi = SEQ; kb0 = CTX + lo; ntiles = 4 + (hi - lo) / 64; }
    f32x16 o[1][2]; float ls[1];
    const float m0 = A.sink[head] * LOG2E;
    float km[1];
#if SWA_FIXM
    { const float* kp = A.kmax + 128 + (size_t)(b * 2 + hk) * 8;
      km[0] = sqrtf(fmaxf(fmaxf(ld_sc1(kp + 0), ld_sc1(kp + 2)), fmaxf(ld_sc1(kp + 4), ld_sc1(kp + 6))) + fmaxf(fmaxf(ld_sc1(kp + 1), ld_sc1(kp + 3)), fmaxf(ld_sc1(kp + 5), ld_sc1(kp + 7)))); }
    if (ctxq) flash_unit<1, 4, false, true>(lds, wv, qrow, Kb, Vb, ntiles, kb0, 0, m0, 1.f, km, o, ls);
    else flash_unit<1, 4, true, true, JF>(lds, wv, qrow, Kb, Vb, ntiles, kb0, qpos, m0, 1.f, km, o, ls, jf, kord);
#else
    km[0] = 0.f;
    if (ctxq) flash_unit<1, 4, false, false>(lds, wv, qrow, Kb, Vb, ntiles, kb0, 0, m0, 1.f, km, o, ls);
    else flash_unit<1, 4, true, false>(lds, wv, qrow, Kb, Vb, ntiles, kb0, qpos, m0, 1.f, km, o, ls);
#endif
    const float inv = 1.f / ls[0];
    o[0][0] = o[0][0] * inv; o[0][1] = o[0][1] * inv;
    store_ot(A.MIX + (size_t)row * 1024 + 256 + head * 64, o[0], h);
}

__device__ __forceinline__ void kmax_unit(LAS unsigned char* lds, const int wv, const bf16_t* KD, float* KMAXP, int b, int hd, int qt, int nh = 4) {
    const int tid = opaque_tid(wv), lane = tid & 63, wid = tid >> 6;
    const bf16_t* Kb = KD + (size_t)(b * nh + hd) * KEYS * 64;
    float m1 = 0.f, m2 = 0.f;
    for (int key = qt * (KEYS / 4) + tid; key < (qt + 1) * (KEYS / 4); key += 512) {
        float n1 = 0.f, n2 = 0.f;
#pragma unroll
        for (int c = 0; c < 8; ++c) { const u32x4 w = *(const GAS u32x4*)(Kb + (size_t)key * 64 + c * 8);
            const float s = bflo(w.x) * bflo(w.x) + bfhi(w.x) * bfhi(w.x) + bflo(w.y) * bflo(w.y) + bfhi(w.y) * bfhi(w.y) + bflo(w.z) * bflo(w.z) + bfhi(w.z) * bfhi(w.z) + bflo(w.w) * bflo(w.w) + bfhi(w.w) * bfhi(w.w);
            if (c < 4) n1 += s; else n2 += s; }
        m1 = fmaxf(m1, n1); m2 = fmaxf(m2, n2);
    }
#pragma unroll
    for (int o = 1; o < 64; o <<= 1) { m1 = fmaxf(m1, __shfl_xor(m1, o)); m2 = fmaxf(m2, __shfl_xor(m2, o)); }
    LAS float* R = (LAS float*)lds;
    if (lane == 0) { R[wid * 2] = m1; R[wid * 2 + 1] = m2; }
    __syncthreads();
    if (tid < 2) { float m = 0.f;
#pragma unroll
        for (int w = 0; w < 8; ++w) m = fmaxf(m, R[w * 2 + tid]);
        st_sc1(KMAXP + ((b * nh + hd) * 4 + qt) * 2 + tid, m); }
    __syncthreads();
}

__device__ __forceinline__ void diff_unit(LAS unsigned char* lds, const int wv, const AttnArgs& A, int b, int hd, int jq, bool ctxq, float lam) {
    const int tid = opaque_tid(wv), lane = tid & 63, wid = tid >> 6, r = lane & 31, h = lane >> 5;
    const int qpos = 256 * jq + 32 * wid + r;
    const int row = ctxq ? TL + b * CTX + qpos : b * SEQ + qpos;
    const bf16_t* qrow = A.QD + (size_t)row * 256 + hd * 64;
    const bf16_t* Kb = A.KD + (size_t)(b * 4 + hd) * KEYS * 64; const bf16_t* Vb = A.VD + (size_t)(b * 4 + hd) * KEYS * 64;
    const int ntiles = ctxq ? 4 : KEYS / 64;
    f32x16 o[2][2]; float ls[2];
    float km[2];
    { const float* kp = A.kmax + (size_t)(b * 4 + hd) * 8; km[0] = sqrtf(fmaxf(fmaxf(ld_sc1(kp + 0), ld_sc1(kp + 2)), fmaxf(ld_sc1(kp + 4), ld_sc1(kp + 6)))); km[1] = sqrtf(fmaxf(fmaxf(ld_sc1(kp + 1), ld_sc1(kp + 3)), fmaxf(ld_sc1(kp + 5), ld_sc1(kp + 7)))); }
#if DIFF_STAG
    if (DIFF_GRPB && __builtin_amdgcn_readfirstlane(wid) >= 4) flash_diff<true>(lds, wv, qrow, Kb, Vb, ntiles, CTX, km, o, ls);
    else flash_diff<false>(lds, wv, qrow, Kb, Vb, ntiles, CTX, km, o, ls);
#else
    flash_unit<2, 2, false, true>(lds, wv, qrow, Kb, Vb, ntiles, CTX, 0, -1e30f, 0.f, km, o, ls);
#endif
    const float i1 = 1.f / ls[0], i2 = lam / ls[1];
    f32x16 v[2]; float ss = 0.f;
#pragma unroll
    for (int db = 0; db < 2; ++db)
#pragma unroll
        for (int e = 0; e < 16; ++e) { const float x = o[0][db][e] * i1 - o[1][db][e] * i2; v[db][e] = x; ss += x * x; }
    ss = xhalf_sum(ss);
    const float rn = rsqrtf(ss * (1.f / 64.f) + LN_EPS) * (1.f - A.lam_init);
#pragma unroll
    for (int db = 0; db < 2; ++db)
#pragma unroll
        for (int e4 = 0; e4 < 4; ++e4) { const f32x4 g = *(const GAS f32x4*)(A.dng + 32 * db + 8 * e4 + 4 * h);
#pragma unroll
            for (int j = 0; j < 4; ++j) v[db][4 * e4 + j] *= rn * g[j]; }
    store_ot(A.MIX + (size_t)row * 1024 + 768 + hd * 64, v, h);
}
__device__ __forceinline__ unsigned cvtpk_h(float lo, float hi) { unsigned r; asm("v_cvt_pk_f16_f32 %0, %1, %2" : "=v"(r) : "v"(lo), "v"(hi)); return r; }
__device__ __forceinline__ float h_lo(unsigned w) { float r; asm("v_cvt_f32_f16 %0, %1" : "=v"(r) : "v"(w)); return r; }
__device__ __forceinline__ float h_hi(unsigned w) { float r; const unsigned s = w >> 16; asm("v_cvt_f32_f16 %0, %1" : "=v"(r) : "v"(s)); return r; }
__device__ __forceinline__ f32x4 h4_to_f4(u32x2 w) { return (f32x4){h_lo(w.x), h_hi(w.x), h_lo(w.y), h_hi(w.y)}; }

struct LruArgs { const bf16_t* LRUX; const bf16_t* GATE; bf16_t* MIX; const bf16_t* GWT; const float *conv_w, *conv_b, *gate_b, *lam; float* CM; float* CARRY; float* AB; };
constexpr int LRU_AA = 0, LRU_BX = 32768, LRU_UF = 65536, LRU_UB = 81920, LRU_UBP = 272, LRU_C8 = LRU_UB + 32 * LRU_UBP, LRU_CAR = LRU_C8 + 1024, LRU_END = LRU_CAR + 1024;
static_assert(LRU_END <= RING_BYTES, "LRU LDS map");

template <int PASS>
__device__ __forceinline__ void lru_phase(LAS unsigned char* lds, const int wv, const LruArgs& A, int bx, int G, int reps) {
    const int tid = opaque_tid(wv), lane = tid & 63, wid = __builtin_amdgcn_readfirstlane(tid >> 6), r = lane & 31, h = lane >> 5;
    LAS float* AA = (LAS float*)(lds + LRU_AA); LAS float* BX = (LAS float*)(lds + LRU_BX); LAS float* UF = (LAS float*)(lds + LRU_UF);
    LAS unsigned char* UB = lds + LRU_UB; LAS unsigned char* XS = lds + LRU_AA;
    LAS float* C8 = (LAS float*)(lds + LRU_C8); LAS float* CAR = (LAS float*)(lds + LRU_CAR);
    const int chh = bx & 1, ch0 = 128 * chh;
    const int k2 = wid & 1, nb = (wid >> 1) & 1, wd = wid >> 2;
    bf16x8 gw0[4], gw1[4];
    {   const bf16_t* g0 = A.GWT + ((size_t)((wd * 2 + 0) * 4 + 2 * chh + k2) * 64 + 32 * nb + r) * 64 + 8 * h;
        const bf16_t* g1 = A.GWT + ((size_t)((wd * 2 + 1) * 4 + 2 * chh + k2) * 64 + 32 * nb + r) * 64 + 8 * h;
#pragma unroll
        for (int s = 0; s < 4; ++s) { gw0[s] = *(const GAS bf16x8*)(g0 + 16 * s); gw1[s] = *(const GAS bf16x8*)(g1 + 16 * s); } }
    if (tid < 256) {
        const int d = tid >> 7, ch = ch0 + (tid & 127);
        {
            const float e = fast_exp2(-LOG2E * A.lam[d * 256 + ch]);
            const float sp = e < 0.0625f ? e * (1.f + e * (-0.5f + e * (0.33333334f + e * (-0.25f + e * 0.2f)))) : 0.6931471805599453f * __builtin_amdgcn_logf(1.f + e);
            C8[tid] = -8.f * sp; }
    }
    const float cw0_ = A.conv_w[ch0 + (tid & 127)], cw1_ = A.conv_w[256 + ch0 + (tid & 127)], cw2_ = A.conv_w[512 + ch0 + (tid & 127)], cw3_ = A.conv_w[768 + ch0 + (tid & 127)], ccb_ = A.conv_b[ch0 + (tid & 127)];
    const float gba_ = A.gate_b[(wd * 2 + 0) * 256 + ch0 + 64 * k2 + 32 * nb + r], gbi_ = A.gate_b[(wd * 2 + 1) * 256 + ch0 + 64 * k2 + 32 * nb + r];
    for (int rep_ = 0; rep_ < reps; ++rep_) {
    u32x4 xr0 = {0u, 0u, 0u, 0u}, xr1 = {0u, 0u, 0u, 0u}; float cnx = 0.f;
#define LRU_FETCH(P) do { const int pb_ = (P) / LRU_NCH, pc_ = (P) % LRU_NCH; const bool ic_ = pc_ < 8; \
        const int sg_ = ic_ ? TL + pb_ * CTX : pb_ * SEQ, sl_ = ic_ ? CTX : SEQ, tt_ = ic_ ? 32 * pc_ : 32 * (pc_ - 8); \
        { const int rr = tid >> 4, c16 = tid & 15, t = tt_ - 1 + rr; xr0 = (u32x4){0u, 0u, 0u, 0u}; if (t >= 0 && t < sl_) xr0 = *(const GAS u32x4*)(A.LRUX + (size_t)(sg_ + t) * 256 + ch0 + c16 * 8); } \
        if (tid < 48) { const int rr = (tid + 512) >> 4, c16 = tid & 15, t = tt_ - 1 + rr; xr1 = (u32x4){0u, 0u, 0u, 0u}; if (t >= 0 && t < sl_) xr1 = *(const GAS u32x4*)(A.LRUX + (size_t)(sg_ + t) * 256 + ch0 + c16 * 8); } \
        if (PASS == 2 && tid < 256) { const int d = tid >> 7, ch = ch0 + (tid & 127); cnx = ld_sc1(A.CARRY + ((size_t)(pb_ * LRU_NCH + pc_) * 2 + d) * 256 + ch); } } while (0)
    const bool active = bx < 2 * (G >> 1);
    if (active && (bx >> 1) < NB * LRU_NCH) LRU_FETCH(bx >> 1);
    for (int p = (bx >> 1); p < NB * LRU_NCH && active; p += (G >> 1)) {
    const int b = p / LRU_NCH, ci = p % LRU_NCH;
    const bool isctx = ci < 8;
    const int seg0 = isctx ? TL + b * CTX : b * SEQ, t0 = isctx ? 32 * ci : 32 * (ci - 8);
    if (PASS == 2 && tid < 256) CAR[tid] = cnx;
    *(LAS u32x4*)(XS + (tid >> 4) * 256 + (tid & 15) * 16) = xr0;
    if (tid < 48) *(LAS u32x4*)(XS + ((tid + 512) >> 4) * 256 + (tid & 15) * 16) = xr1;
    __syncthreads();
    if (p + (G >> 1) < NB * LRU_NCH) LRU_FETCH(p + (G >> 1));
    {
        const int cl = tid & 127, tq = tid >> 7, ch = ch0 + cl;
        const float w0 = cw0_, w1 = cw1_, w2 = cw2_, w3 = cw3_, cb = ccb_; (void)ch;
        const LAS unsigned short* xs = (const LAS unsigned short*)XS + (tq * 8) * 128 + cl;
        float x0 = bf2f(xs[0]), x1 = bf2f(xs[128]), x2 = bf2f(xs[256]);
#pragma unroll
        for (int t = 0; t < 8; ++t) { const float x3 = bf2f(xs[(t + 3) * 128]); const float u = cb + w0 * x0 + w1 * x1 + w2 * x2 + w3 * x3; x0 = x1; x1 = x2; x2 = x3;
            const int tok = tq * 8 + t; UF[tok * 128 + cl] = u; *(LAS unsigned short*)(UB + tok * LRU_UBP + cl * 2) = (unsigned short)(cvtpk(u, 0.f) & 0xffffu); }
    }
    __syncthreads();
    {
        f32x16 acc0 = f32x16{}, acc1 = f32x16{};
#pragma unroll
        for (int s = 0; s < 4; ++s) {
            const bf16x8 a = *(LAS bf16x8*)(UB + r * LRU_UBP + (64 * k2 + 16 * s + 8 * h) * 2);
            acc0 = __builtin_amdgcn_mfma_f32_32x32x16_bf16(a, gw0[s], acc0, 0, 0, 0);
            acc1 = __builtin_amdgcn_mfma_f32_32x32x16_bf16(a, gw1[s], acc1, 0, 0, 0);
        }
        const int cl = 64 * k2 + 32 * nb + r, ch = ch0 + cl;
        const float ba = gba_, bi = gbi_, c8 = C8[wd * 128 + cl]; (void)ch;
        LAS float* aa = AA + wd * 4096; LAS float* bx = BX + wd * 4096;
#pragma unroll
        for (int e = 0; e < 16; ++e) { const int tok = crow(e, h);
            const float rr = sigmoid_f(acc0[e] + ba), ii = sigmoid_f(acc1[e] + bi), la = c8 * rr;
            const float av = fast_exp2(LOG2E * la), x2 = 2.f * la;
            const float ser = -x2 * (1.f + x2 * (0.5f + x2 * (0.16666667f + x2 * (0.041666668f + x2 * 0.0083333338f))));
            const float om = x2 > -0.125f ? ser : 1.f - av * av;
            const float bxv = __builtin_amdgcn_sqrtf(om) * ii * UF[tok * 128 + cl];
            aa[tok * 128 + cl] = av; bx[tok * 128 + cl] = bxv;
            if (PASS == 1) { GAS unsigned* ab = (GAS unsigned*)A.AB + ((size_t)(b * LRU_NCH + ci) * 2 + chh) * 8192 + wd * 4096 + tok * 128 + cl; ab[0] = cvtpk_h(om * fast_rcp(1.f + av), bxv); } }
    }
    __syncthreads();
    if (tid < 256) {
        const int d = tid >> 7, cl = tid & 127;
        LAS float* aa = AA + d * 4096 + cl; LAS float* bx = BX + d * 4096 + cl;
        if (PASS == 1) {
            float ap = 1.f, hh = 0.f;
            if (d == 0) {
#pragma unroll
                for (int t = 0; t < 32; ++t) { const float av = aa[t * 128]; hh = av * hh + bx[t * 128]; ap *= av; }
            } else {
#pragma unroll
                for (int t = 31; t >= 0; --t) { const float av = aa[t * 128]; hh = av * hh + bx[t * 128]; ap *= av; }
            }
            float* cm = A.CM + ((size_t)(b * LRU_NCH + ci) * 2 + d) * 512 + ch0 + cl; st_sc1(cm, ap); st_sc1(cm + 256, hh);
        } else {
            float hh = CAR[tid];
            float av[32], bv[32];
#pragma unroll
            for (int t = 0; t < 32; ++t) { av[t] = aa[t * 128]; bv[t] = bx[t * 128]; }
            if (d == 0) {
#pragma unroll
                for (int t = 0; t < 32; ++t) { hh = av[t] * hh + bv[t]; bv[t] = hh; }
            } else {
#pragma unroll
                for (int t = 31; t >= 0; --t) { hh = av[t] * hh + bv[t]; bv[t] = hh; }
            }
#pragma unroll
            for (int t = 0; t < 32; ++t) bx[t * 128] = bv[t];
        }
    }
    if (PASS == 2) {
        __syncthreads();
        const int t = tid >> 4, cg = tid & 15;
        const size_t row = (size_t)(seg0 + t0 + t);
        const u32x4 gv = *(const GAS u32x4*)(A.GATE + row * 256 + ch0 + cg * 8);
        const f32x4 f0 = *(LAS f32x4*)(BX + t * 128 + cg * 8), f1 = *(LAS f32x4*)(BX + t * 128 + cg * 8 + 4);
        const f32x4 r0 = *(LAS f32x4*)(BX + 4096 + t * 128 + cg * 8), r1 = *(LAS f32x4*)(BX + 4096 + t * 128 + cg * 8 + 4);
        u32x4 w;
        w.x = cvtpk((f0[0] + r0[0]) * bflo(gv.x), (f0[1] + r0[1]) * bfhi(gv.x)); w.y = cvtpk((f0[2] + r0[2]) * bflo(gv.y), (f0[3] + r0[3]) * bfhi(gv.y));
        w.z = cvtpk((f1[0] + r1[0]) * bflo(gv.z), (f1[1] + r1[1]) * bfhi(gv.z)); w.w = cvtpk((f1[2] + r1[2]) * bflo(gv.w), (f1[3] + r1[3]) * bfhi(gv.w));
        *(GAS u32x4*)(A.MIX + row * 1024 + ch0 + cg * 8) = w;
    }
    __syncthreads();
    }
    }
#undef LRU_FETCH
}

__device__ __forceinline__ void lru_phase2c(LAS unsigned char* lds, const int wv, const LruArgs& A, int bx, int G) {
    const int tid = opaque_tid(wv);
    LAS float* BX = (LAS float*)(lds + LRU_BX);
    const int chh = bx & 1, ch0 = 128 * chh;
    const bool active = bx < 2 * (G >> 1);
    unsigned rw[32]; float cn = 0.f; u32x4 gvn = {0u, 0u, 0u, 0u};
#pragma unroll
    for (int t = 0; t < 32; ++t) rw[t] = 0u;
#define LRU2_FETCH(P) do { const int pb_ = (P) / LRU_NCH, pc_ = (P) % LRU_NCH; const bool ic_ = pc_ < 8; const int sg_ = ic_ ? TL + pb_ * CTX : pb_ * SEQ, tt_ = ic_ ? 32 * pc_ : 32 * (pc_ - 8); \
        if (tid < 256) { const int d_ = tid >> 7, cl_ = tid & 127; const float* ab_ = A.AB + ((size_t)(pb_ * LRU_NCH + pc_) * 2 + chh) * 8192 + d_ * 4096 + cl_; \
            cn = ld_sc1(A.CARRY + ((size_t)(pb_ * LRU_NCH + pc_) * 2 + d_) * 256 + ch0 + cl_); \
            _Pragma("unroll") for (int t = 0; t < 32; ++t) rw[t] = __float_as_uint(ld_sc1(ab_ + t * 128)); } \
        gvn = *(const GAS u32x4*)(A.GATE + (size_t)(sg_ + tt_ + (tid >> 4)) * 256 + ch0 + (tid & 15) * 8); } while (0)
    if (active && (bx >> 1) < NB * LRU_NCH) LRU2_FETCH(bx >> 1);
    for (int p = (bx >> 1); p < NB * LRU_NCH && active; p += (G >> 1)) {
        const int b = p / LRU_NCH, ci = p % LRU_NCH;
        const bool isctx = ci < 8;
        const int seg0 = isctx ? TL + b * CTX : b * SEQ, t0 = isctx ? 32 * ci : 32 * (ci - 8);
        float av[32], bv[32]; float hh = cn;
#pragma unroll
        for (int t = 0; t < 32; ++t) { av[t] = 1.f - h_lo(rw[t]); bv[t] = h_hi(rw[t]); }
        const u32x4 gv = gvn;
        if (p + (G >> 1) < NB * LRU_NCH) LRU2_FETCH(p + (G >> 1));
        if (tid < 256) {
            const int d = tid >> 7, cl = tid & 127;
            LAS float* bxl = BX + d * 4096 + cl;
            if (d == 0) {
#pragma unroll
                for (int t = 0; t < 32; ++t) { hh = av[t] * hh + bv[t]; bxl[t * 128] = hh; }
            } else {
#pragma unroll
                for (int t = 31; t >= 0; --t) { hh = av[t] * hh + bv[t]; bxl[t * 128] = hh; }
            }
        }
        __syncthreads();
        {
            const int t = tid >> 4, cg = tid & 15;
            const size_t row = (size_t)(seg0 + t0 + t);
            const f32x4 f0 = *(LAS f32x4*)(BX + t * 128 + cg * 8), f1 = *(LAS f32x4*)(BX + t * 128 + cg * 8 + 4);
            const f32x4 r0 = *(LAS f32x4*)(BX + 4096 + t * 128 + cg * 8), r1 = *(LAS f32x4*)(BX + 4096 + t * 128 + cg * 8 + 4);
            u32x4 w;
            w.x = cvtpk((f0[0] + r0[0]) * bflo(gv.x), (f0[1] + r0[1]) * bfhi(gv.x)); w.y = cvtpk((f0[2] + r0[2]) * bflo(gv.y), (f0[3] + r0[3]) * bfhi(gv.y));
            w.z = cvtpk((f1[0] + r1[0]) * bflo(gv.z), (f1[1] + r1[1]) * bfhi(gv.z)); w.w = cvtpk((f1[2] + r1[2]) * bflo(gv.w), (f1[3] + r1[3]) * bfhi(gv.w));
            *(GAS u32x4*)(A.MIX + row * 1024 + ch0 + cg * 8) = w;
        }
        __syncthreads();
    }
#undef LRU2_FETCH
}

__device__ __forceinline__ void lru_scan_unit(LAS unsigned char* lds, const int wv, const float* CMp, float* CARRY, int b, int d, int cg) {
    const int tid = opaque_tid(wv), c = tid & 31, part = tid >> 5;
    LAS float* PT = (LAS float*)lds;
    float a[9], bb[9];
#pragma unroll
    for (int j = 0; j < 9; ++j) { const int p = part * 9 + j; const int ci = d == 0 ? p : (p < 8 ? 7 - p : 143 - p);
        if (p < LRU_NCH) { const float* cm = CMp + ((size_t)(b * LRU_NCH + ci) * 2 + d) * 512 + cg * 32 + c; a[j] = ld_sc1(cm); bb[j] = ld_sc1(cm + 256); } else { a[j] = 1.f; bb[j] = 0.f; } }
    float ap = 1.f, hp = 0.f;
#pragma unroll
    for (int j = 0; j < 9; ++j) { hp = a[j] * hp + bb[j]; ap *= a[j]; }
    PT[(part * 2 + 0) * 32 + c] = ap; PT[(part * 2 + 1) * 32 + c] = hp;
    __syncthreads();
    float h = 0.f;
    for (int q = 0; q < part; ++q) h = PT[(q * 2 + 0) * 32 + c] * h + PT[(q * 2 + 1) * 32 + c];
#pragma unroll
    for (int j = 0; j < 9; ++j) { const int p = part * 9 + j; const int ci = d == 0 ? p : (p < 8 ? 7 - p : 143 - p);
        if (p < LRU_NCH) st_sc1(CARRY + ((size_t)(b * LRU_NCH + ci) * 2 + d) * 256 + cg * 32 + c, h);
        h = a[j] * h + bb[j]; }
    __syncthreads();
}

struct LnArgs {
    const float *hl, *hc; float *ol, *oc;
    const bf16_t* BR; const int* slot; const float* gts;
    const float* mod; int gate_idx;
    const float* modn; int sh_idx, sc_idx;
    const float *lng, *lnb; bf16_t* U; int nrows;
    const float *rw, *rb; int* toke; float* tokg; int* tokr; unsigned* cnt;
    int u8;
    const float* part; int nsplit;
    unsigned char* ybx;
    int ts[8];
};
constexpr int LN_STASH = 36864;
constexpr int ROWS_PER_WAVE = 9;
__device__ __forceinline__ int wave_row(int gw, int ri, int nrows) { return ri < 8 ? gw * 8 + ri : ((nrows > TL && gw < TC) ? TL + gw : -1); }

template <bool MOE_BR, bool ROUTER, bool HIN16 = false, bool HOUT16 = false, int NSPLIT = 11>
__device__ __forceinline__ void ln_pass(LAS unsigned char* lds, const int wv, const LnArgs& A, int gw) {
    const int tid = opaque_tid(wv), lane = tid & 63, wid = __builtin_amdgcn_readfirstlane(tid >> 6);
    LAS float* RWT = (LAS float*)lds;
    LAS int* WC = (LAS int*)(lds + 32768);
    if (ROUTER) { for (int i = tid; i < 8192; i += 512) { const int k = i >> 3, e = i & 7; RWT[e * 1024 + k] = A.rw[i]; } __syncthreads(); }
    f32x4 g4[4], b4[4];
#pragma unroll
    for (int j = 0; j < 4; ++j) { g4[j] = *(const GAS f32x4*)(A.lng + 4 * lane + 256 * j); b4[j] = *(const GAS f32x4*)(A.lnb + 4 * lane + 256 * j); }
    f32x4 gt[4], sc[4], sh[4]; int curcb = -1;
    int cw0 = 0, cw1 = 0, cw2 = 0, cw3 = 0, cw4 = 0, cw5 = 0, cw6 = 0, cw7 = 0; unsigned long long packed = 0ull;
    const int rbeg = gw * ROWS_PER_WAVE;
    f32x4 nh[4]; u32x2 nh16[4]; u32x2 nb0[4], nb1[4]; float nq0 = 0.f, nq1 = 0.f;
#define LN_LOADROW(R) do { const int r_ = (R); \
        if (HIN16) { const unsigned short* hin_ = r_ < TL ? (const unsigned short*)A.hl + (size_t)r_ * 1024 : (const unsigned short*)A.hc + (size_t)(r_ - TL) * 1024; \
            _Pragma("unroll") for (int j = 0; j < 4; ++j) nh16[j] = *(const GAS u32x2*)(hin_ + 4 * lane + 256 * j); } \
        else { const float* hin_ = r_ < TL ? A.hl + (size_t)r_ * 1024 : A.hc + (size_t)(r_ - TL) * 1024; \
            _Pragma("unroll") for (int j = 0; j < 4; ++j) nh[j] = *(const GAS f32x4*)(hin_ + 4 * lane + 256 * j); } \
        if (MOE_BR) { const int e0_ = ((const GAS int*)A.toke)[r_ * 2], e1_ = ((const GAS int*)A.toke)[r_ * 2 + 1]; int b0_ = 0, b1_ = 0; _Pragma("unroll") for (int e_ = 1; e_ < 8; ++e_) { b0_ = (e0_ == e_) ? A.ts[e_] : b0_; b1_ = (e1_ == e_) ? A.ts[e_] : b1_; } \
            const int s0_ = b0_ * 256 + ((const GAS int*)A.tokr)[r_ * 2], s1_ = b1_ * 256 + ((const GAS int*)A.tokr)[r_ * 2 + 1]; nq0 = ((const GAS float*)A.gts)[r_ * 2]; nq1 = ((const GAS float*)A.gts)[r_ * 2 + 1]; \
            _Pragma("unroll") for (int j = 0; j < 4; ++j) { nb0[j] = *(const GAS u32x2*)(A.BR + (size_t)s0_ * 1024 + 4 * lane + 256 * j); nb1[j] = *(const GAS u32x2*)(A.BR + (size_t)s1_ * 1024 + 4 * lane + 256 * j); } } \
        else { _Pragma("unroll") for (int j = 0; j < 4; ++j) nb0[j] = *(const GAS u32x2*)(A.BR + (size_t)r_ * 1024 + 4 * lane + 256 * j); } } while (0)
    if (wave_row(gw, 0, A.nrows) >= 0 && wave_row(gw, 0, A.nrows) < A.nrows) LN_LOADROW(wave_row(gw, 0, A.nrows));
    for (int ri = 0; ri < ROWS_PER_WAVE; ++ri) {
        const int row = wave_row(gw, ri, A.nrows); if (row < 0 || row >= A.nrows) break;
        const bool lat = row < TL; const int cb = lat ? (row >> 12) : 4;
        if (cb != curcb) { curcb = cb;
#pragma unroll
            for (int j = 0; j < 4; ++j) { gt[j] = *(const GAS f32x4*)(A.mod + (size_t)(cb * 6 + A.gate_idx) * 1024 + 4 * lane + 256 * j);
                if (A.modn) { sc[j] = *(const GAS f32x4*)(A.modn + (size_t)(cb * 6 + A.sc_idx) * 1024 + 4 * lane + 256 * j); sh[j] = *(const GAS f32x4*)(A.modn + (size_t)(cb * 6 + A.sh_idx) * 1024 + 4 * lane + 256 * j); } } }
        unsigned char* hout = lat ? (unsigned char*)A.ol + (size_t)row * (HOUT16 ? 2048 : 4096) : (unsigned char*)A.oc + (size_t)(row - TL) * (HOUT16 ? 2048 : 4096);
        f32x4 v[4];
        if (HIN16) {
#pragma unroll
            for (int j = 0; j < 4; ++j) nh[j] = h4_to_f4(nh16[j]);
        }
        if (MOE_BR) {
#pragma unroll
            for (int j = 0; j < 4; ++j) { const u32x2 w0 = nb0[j], w1 = nb1[j]; const float q0 = nq0, q1 = nq1;
                f32x4 f; f[0] = q0 * bflo(w0.x) + q1 * bflo(w1.x); f[1] = q0 * bfhi(w0.x) + q1 * bfhi(w1.x); f[2] = q0 * bflo(w0.y) + q1 * bflo(w1.y); f[3] = q0 * bfhi(w0.y) + q1 * bfhi(w1.y);
                v[j] = nh[j] * ALPHA + gt[j] * f; }
        } else if (A.part != nullptr && !lat) {
#pragma unroll
            for (int j = 0; j < 4; ++j) { u32x2 pv[NSPLIT];
#pragma unroll
                for (int s = 0; s < NSPLIT; ++s) pv[s] = *(const GAS u32x2*)((const bf16_t*)A.part + ((size_t)s * 1024 + (row - TL)) * 1024 + 4 * lane + 256 * j);
                f32x4 f = (f32x4){bflo(pv[0].x), bfhi(pv[0].x), bflo(pv[0].y), bfhi(pv[0].y)};
#pragma unroll
                for (int s = 1; s < NSPLIT; ++s) f = f + (f32x4){bflo(pv[s].x), bfhi(pv[s].x), bflo(pv[s].y), bfhi(pv[s].y)};
                v[j] = nh[j] * ALPHA + gt[j] * f; }
        } else {
#pragma unroll
            for (int j = 0; j < 4; ++j) { const u32x2 w0 = nb0[j];
                f32x4 f; f[0] = bflo(w0.x); f[1] = bfhi(w0.x); f[2] = bflo(w0.y); f[3] = bfhi(w0.y);
                v[j] = nh[j] * ALPHA + gt[j] * f; }
        }
        { const int nr_ = ri + 1 < ROWS_PER_WAVE ? wave_row(gw, ri + 1, A.nrows) : -1; if (nr_ >= 0 && nr_ < A.nrows) LN_LOADROW(nr_); }
        float s = 0.f;
#pragma unroll
        for (int j = 0; j < 4; ++j) s += (v[j][0] + v[j][1]) + (v[j][2] + v[j][3]);
        const float mean = wave_sum(s) * (1.f / 1024.f); float s2 = 0.f;
#pragma unroll
        for (int j = 0; j < 4; ++j) { v[j] = v[j] - mean; s2 += (v[j][0] * v[j][0] + v[j][1] * v[j][1]) + (v[j][2] * v[j][2] + v[j][3] * v[j][3]); }
        const float rstd = rsqrtf(wave_sum(s2) * (1.f / 1024.f) + LN_EPS);
#pragma unroll
        for (int j = 0; j < 4; ++j) { v[j] = v[j] * rstd * g4[j] + b4[j];
            if (HOUT16) { u32x2 w; w.x = cvtpk_h(v[j][0], v[j][1]); w.y = cvtpk_h(v[j][2], v[j][3]); *(GAS u32x2*)(hout + 8 * lane + 512 * j) = w; }
            else st16f(hout + 16 * lane + 1024 * j, v[j]); }
        if (A.modn) {
#pragma unroll
            for (int j = 0; j < 4; ++j) { v[j] = v[j] * (sc[j] + 1.f) + sh[j];
                if (ROUTER) *(LAS unsigned*)(lds + LN_STASH + (wid * ROWS_PER_WAVE + ri) * 1024 + 4 * lane + 256 * j) = cvt4_fp8(v[j][0] * F8_SU, v[j][1] * F8_SU, v[j][2] * F8_SU, v[j][3] * F8_SU);
                else if (A.u8) *(GAS unsigned*)((unsigned char*)A.U + (size_t)row * 1024 + 4 * lane + 256 * j) = cvt4_fp8(v[j][0] * F8_SU, v[j][1] * F8_SU, v[j][2] * F8_SU, v[j][3] * F8_SU);
                else { u32x2 w; w.x = cvtpk(v[j][0], v[j][1]); w.y = cvtpk(v[j][2], v[j][3]); *(GAS u32x2*)(A.U + (size_t)row * 1024 + 4 * lane + 256 * j) = w; } }
        }
        if (ROUTER) {
            float lg[8];
#pragma unroll
            for (int e = 0; e < 8; ++e) { float p = 0.f;
#pragma unroll
                for (int j = 0; j < 4; ++j) { const f32x4 w = *(LAS f32x4*)(RWT + e * 1024 + 4 * lane + 256 * j); p += (v[j][0] * w[0] + v[j][1] * w[1]) + (v[j][2] * w[2] + v[j][3] * w[3]); }
                lg[e] = wave_sum(p) + A.rb[e]; }
            float v1 = lg[0]; int i1 = 0;
#pragma unroll
            for (int e = 1; e < 8; ++e) if (lg[e] > v1) { v1 = lg[e]; i1 = e; }
            float v2 = -3.0e38f; int i2 = 0;
#pragma unroll
            for (int e = 0; e < 8; ++e) if (e != i1 && lg[e] > v2) { v2 = lg[e]; i2 = e; }
            const float q1 = fast_rcp(1.f + fast_exp2(LOG2E * (v2 - v1))), q2 = 1.f - q1;
            if (lane == 0) { ((GAS int*)A.toke)[row * 2] = i1; ((GAS int*)A.toke)[row * 2 + 1] = i2; ((GAS float*)A.tokg)[row * 2] = q1; ((GAS float*)A.tokg)[row * 2 + 1] = q2; }
            i1 = __builtin_amdgcn_readfirstlane(i1); i2 = __builtin_amdgcn_readfirstlane(i2);
            cw0 += (i1 == 0) + (i2 == 0); cw1 += (i1 == 1) + (i2 == 1); cw2 += (i1 == 2) + (i2 == 2); cw3 += (i1 == 3) + (i2 == 3);
            cw4 += (i1 == 4) + (i2 == 4); cw5 += (i1 == 5) + (i2 == 5); cw6 += (i1 == 6) + (i2 == 6); cw7 += (i1 == 7) + (i2 == 7);
            packed |= (unsigned long long)(i1 | (i2 << 3)) << (6 * ri);
        }
    }
    if (ROUTER) {
        if (lane < 8) { const int c = lane == 0 ? cw0 : lane == 1 ? cw1 : lane == 2 ? cw2 : lane == 3 ? cw3 : lane == 4 ? cw4 : lane == 5 ? cw5 : lane == 6 ? cw6 : cw7; WC[wid * 8 + lane] = c; }
        __syncthreads();
        if (tid < 8) { int tot = 0;
#pragma unroll
            for (int w = 0; w < 8; ++w) tot += WC[w * 8 + tid];
            WC[64 + tid] = tot ? (int)atomicAdd(A.cnt + tid, (unsigned)tot) : 0; }
        __syncthreads();
        int off[8];
#pragma unroll
        for (int e = 0; e < 8; ++e) { int o = WC[64 + e];
#pragma unroll
            for (int w = 0; w < 8; ++w) o += (w < wid) ? WC[w * 8 + e] : 0;
            off[e] = __builtin_amdgcn_readfirstlane(o); }
        for (int ri = 0; ri < ROWS_PER_WAVE; ++ri) {
            const int row = wave_row(gw, ri, A.nrows); if (row < 0 || row >= A.nrows) break;
            const int pr = (int)((packed >> (6 * ri)) & 63ull), i1 = pr & 7, i2 = pr >> 3; int r1 = 0, r2 = 0;
#pragma unroll
            for (int e = 0; e < 8; ++e) { if (i1 == e) { r1 = off[e]; off[e] += 1; } }
#pragma unroll
            for (int e = 0; e < 8; ++e) { if (i2 == e) { r2 = off[e]; off[e] += 1; } }
            if (lane == 0) { ((GAS int*)A.tokr)[row * 2] = r1; ((GAS int*)A.tokr)[row * 2 + 1] = r2; }
            const u32x4 sr = *(LAS u32x4*)(lds + LN_STASH + (wid * ROWS_PER_WAVE + ri) * 1024 + 16 * lane);
            *(GAS u32x4*)(A.ybx + ((size_t)i1 * T + r1) * 1024 + 16 * lane) = sr; *(GAS u32x4*)(A.ybx + ((size_t)i2 * T + r2) * 1024 + 16 * lane) = sr;
        }
    }
}

struct ExpTab { int ts[9]; };
__device__ __forceinline__ void exp_table(const unsigned* cnt, int (&ts)[9]) {
    int acc = 0;
#pragma unroll
    for (int e = 0; e < 8; ++e) { ts[e] = acc; const int c = __builtin_amdgcn_readfirstlane((int)__hip_atomic_load(cnt + e, __ATOMIC_RELAXED, __HIP_MEMORY_SCOPE_AGENT)); acc += (c + 255) >> 8; }
    ts[8] = acc;
}
__device__ __forceinline__ void route_gather(const int wv, const unsigned* cnt, const int* toke, const int* tokr, int* toks, const bf16_t* U, bf16_t* YB, int nrows, int gw) {
    const int lane = opaque_tid(wv) & 63;
    int ts[9]; exp_table(cnt, ts);
    const int rbeg = gw * ROWS_PER_WAVE;
#pragma unroll 3
    for (int ri = 0; ri < ROWS_PER_WAVE; ++ri) {
        const int row = wave_row(gw, ri, nrows); if (row < 0 || row >= nrows) break;
        const int e0 = toke[row * 2], e1 = toke[row * 2 + 1]; int b0 = 0, b1 = 0;
#pragma unroll
        for (int e = 0; e < 8; ++e) { if (e0 == e) b0 = ts[e]; if (e1 == e) b1 = ts[e]; }
        const int s0 = b0 * 256 + tokr[row * 2], s1 = b1 * 256 + tokr[row * 2 + 1];
        if (lane == 0) { toks[row * 2] = s0; toks[row * 2 + 1] = s1; }
        const u32x4 a = *(const GAS u32x4*)(U + (size_t)row * 1024 + lane * 8), c = *(const GAS u32x4*)(U + (size_t)row * 1024 + 512 + lane * 8);
        u32x2 a8, c8;
        a8.x = cvt4_fp8(bflo(a.x) * F8_SU, bfhi(a.x) * F8_SU, bflo(a.y) * F8_SU, bfhi(a.y) * F8_SU); a8.y = cvt4_fp8(bflo(a.z) * F8_SU, bfhi(a.z) * F8_SU, bflo(a.w) * F8_SU, bfhi(a.w) * F8_SU);
        c8.x = cvt4_fp8(bflo(c.x) * F8_SU, bfhi(c.x) * F8_SU, bflo(c.y) * F8_SU, bfhi(c.y) * F8_SU); c8.y = cvt4_fp8(bflo(c.z) * F8_SU, bfhi(c.z) * F8_SU, bflo(c.w) * F8_SU, bfhi(c.w) * F8_SU);
        unsigned char* Y8 = (unsigned char*)YB;
        *(GAS u32x2*)(Y8 + (size_t)s0 * 1024 + lane * 8) = a8; *(GAS u32x2*)(Y8 + (size_t)s0 * 1024 + 512 + lane * 8) = c8;
        *(GAS u32x2*)(Y8 + (size_t)s1 * 1024 + lane * 8) = a8; *(GAS u32x2*)(Y8 + (size_t)s1 * 1024 + 512 + lane * 8) = c8;
    }
}

__device__ __forceinline__ int rowmap(int kind, int n) {
    if (kind == 0) return n;
    if (kind == 2) return ((n >> 7) << 8) + (n & 127);
    if (kind == 3) return ((n >> 7) << 8) + 128 + (n & 127);
    if (n < 512) return n;
    if (n < 1152) { const int d = n & 63; return (n & ~63) + (d < 32 ? 2 * d : 2 * (d - 32) + 1); }
    if (n < 1280) return n;
    if (n < 1792) { const int d = n & 31; return (n & ~31) + (d < 16 ? 2 * d : 2 * (d - 16) + 1); }
    return n;
}
__device__ __forceinline__ void transpose_item(const float* W, int K, int N, bf16_t* WT, int kind, LAS float* scr, int item, int lane, float f8s = 0.f) {
    const int nblk = N / 32, kb = item / nblk, nb = item % nblk, k0 = 64 * kb, n0 = 32 * nb;
    {
        f32x4 v[8]; const float* wp = W + (size_t)(k0 + (lane >> 3)) * N + n0 + 4 * (lane & 7);
#pragma unroll
        for (int i = 0; i < 8; ++i) v[i] = *(const GAS f32x4*)(wp + (size_t)(8 * i) * N);
#pragma unroll
        for (int i = 0; i < 8; ++i) { LAS float* d = scr + (8 * i + (lane >> 3)) * 33 + 4 * (lane & 7); d[0] = v[i][0]; d[1] = v[i][1]; d[2] = v[i][2]; d[3] = v[i][3]; }
    }
    asm volatile("s_waitcnt lgkmcnt(0)" ::: "memory");
    const int c = lane & 7;
#pragma unroll
    for (int j = 0; j < 4; ++j) { const int n = (lane >> 3) + 8 * j; const LAS float* s = scr + (8 * c) * 33 + n;
        if (f8s != 0.f) { u32x2 o; o.x = cvt4_fp8(s[0 * 33] * f8s, s[1 * 33] * f8s, s[2 * 33] * f8s, s[3 * 33] * f8s); o.y = cvt4_fp8(s[4 * 33] * f8s, s[5 * 33] * f8s, s[6 * 33] * f8s, s[7 * 33] * f8s);
            *(GAS u32x2*)((unsigned char*)WT + (size_t)rowmap(kind, n0 + n) * K + k0 + 8 * c) = o; }
        else {
        u32x4 o; o.x = cvtpk(s[0 * 33], s[1 * 33]); o.y = cvtpk(s[2 * 33], s[3 * 33]); o.z = cvtpk(s[4 * 33], s[5 * 33]); o.w = cvtpk(s[6 * 33], s[7 * 33]);
        *(GAS u32x4*)(WT + (size_t)rowmap(kind, n0 + n) * K + k0 + 8 * c) = o; } }
    asm volatile("s_waitcnt lgkmcnt(0)" ::: "memory");
}

#ifndef PHMASK
#define PHMASK 0xFFFFF
#endif
#define PHON(n) (((PHMASK) >> (n)) & 1)
#ifndef REP_G
#define REP_G 1
#endif
#ifndef REP_DIFF
#define REP_DIFF 1
#endif
#ifndef REP_SWA
#define REP_SWA 1
#endif
#ifndef REP_LRU
#define REP_LRU 1
#endif
#ifndef REP_P0
#define REP_P0 1
#endif
#ifndef REP_G1
#define REP_G1 REP_G
#endif
#ifndef REP_G2
#define REP_G2 REP_G
#endif
#ifndef REP_G3
#define REP_G3 REP_G
#endif
#ifndef REP_G4
#define REP_G4 REP_G
#endif
#ifndef G3_ALIGN
#define G3_ALIGN true
#endif
#ifndef REP_MISC
#define REP_MISC 1
#endif
#ifndef REP_N1L0
#define REP_N1L0 1
#endif
struct Args { const float* in[26]; float* out; unsigned char* ws; int ph_lo, ph_hi; };
constexpr int PH_P0 = 0, PH_P0B = 1, PH_LAYER0 = 2, PH_PER_LAYER = 8, N_PHASES = PH_LAYER0 + DEPTH * PH_PER_LAYER;
enum { LP_G1 = 0, LP_AT, LP_G2, LP_N1, LP_R1, LP_G3, LP_G4, LP_N2 };
enum { I_X = 0, I_C, I_CTX, I_CCTX, I_ADAW, I_ADAB, I_WIN, I_WOUT, I_CONVW, I_CONVB, I_GATEW, I_GATEB, I_LAM, I_SINK, I_DLAM, I_DNG, I_LNG, I_LNB, I_F1, I_F3, I_F2, I_RW, I_RB, I_M1, I_M3, I_M2 };

#define MOD ((float*)(wsp + WS_MOD))
#define COS64 ((float*)(wsp + WS_COS64))
#define SIN64 ((float*)(wsp + WS_SIN64))
#define COS32 ((float*)(wsp + WS_COS32))
#define SIN32 ((float*)(wsp + WS_SIN32))
#define GWT ((bf16_t*)(wsp + WS_GWT))
#define CM ((float*)(wsp + WS_CM))
#define CARRY ((float*)(wsp + WS_CARRY))
#define LRUAB ((float*)(wsp + WS_AB))
#define KMAX ((float*)(wsp + WS_KMAX))
#define TOKE ((int*)(wsp + WS_TOKE))
#define TOKG ((float*)(wsp + WS_TOKG))
#define TOKR ((int*)(wsp + WS_TOKR))
#define TOKS ((int*)(wsp + WS_TOKS))
#define WIN ((bf16_t*)(wsp + WS_WIN))
#define WOUT ((bf16_t*)(wsp + WS_WOUT))
#define F13 ((bf16_t*)(wsp + WS_F13))
#define F2 ((bf16_t*)(wsp + WS_F2))
#define M13 ((bf16_t*)(wsp + WS_M13))
#define M2 ((bf16_t*)(wsp + WS_M2))
#define H ((float*)(wsp + WS_H))
#ifndef RES16
#define RES16 1
#endif
#define H16C ((float*)(wsp + WS_H + (size_t)TL * 1024 * (RES16 == 1 ? 2 : 4)))
#define HX ((float*)(wsp + ((size_t)740 << 20)))
#define HXC ((float*)(wsp + ((size_t)740 << 20) + (size_t)TL * 2048))
#define U ((bf16_t*)(wsp + WS_U))
#define LRUX ((bf16_t*)(wsp + WS_LRUX))
#define GATE ((bf16_t*)(wsp + WS_GATE))
#define QS ((bf16_t*)(wsp + WS_QS))
#define KS ((bf16_t*)(wsp + WS_KS))
#define VS ((bf16_t*)(wsp + WS_VS))
#define QD ((bf16_t*)(wsp + WS_QD))
#define KD ((bf16_t*)(wsp + WS_KD))
#define VD ((bf16_t*)(wsp + WS_VD))
#define MIX ((bf16_t*)(wsp + WS_MIX))
#define MB ((bf16_t*)(wsp + WS_MB))
#define YB ((bf16_t*)(wsp + WS_YB))
#define YBX ((unsigned char*)(wsp + WS_YBX))
#define HID ((bf16_t*)(wsp + WS_HID))
#define PART2 ((float*)(wsp + WS_PART2))
#define PART4 ((float*)(wsp + WS_PART4))
#define CTLW ((unsigned*)(wsp + WS_CTL))
#define LAUNDER_WS() unsigned char* wsp = ws; asm volatile("" : "+s"(wsp))
#define IN(k) (lo <= (k) && (k) < hi)
#ifndef REP_BAR
#define REP_BAR 1
#endif
#define SEAM(k) do { if (IN(k) && IN((k) + 1)) for (int rb_ = 0; rb_ < REP_BAR; ++rb_) xcd_barrier(bar); } while (0)
#ifndef DEFER_W
#define DEFER_W 1
#endif
#ifndef DEFER_M
#define DEFER_M 6
#endif
__device__ __forceinline__ void ffn_item(const Args& args, unsigned char* wsp, int mi, int item, LAS float* scr, int lane) {
    const int grp = mi / 3, which = mi % 3;
    const float* src; unsigned char* dst;
    if (grp < 2) { src = args.in[which == 0 ? I_F1 : which == 1 ? I_F3 : I_F2] + (size_t)grp * 1024 * FF; dst = (unsigned char*)(which == 2 ? F2 : F13) + (size_t)grp * (which == 2 ? 1 : 2) * FF * 1024; }
    else { const int je = grp - 2; src = args.in[which == 0 ? I_M1 : which == 1 ? I_M3 : I_M2] + (size_t)je * 1024 * FF; dst = (unsigned char*)(which == 2 ? M2 : M13) + (size_t)je * (which == 2 ? 1 : 2) * FF * 1024; }
    const float f8s = which == 2 ? F8_SW2 : F8_SW13;
    if (which == 2) transpose_item(src, FF, 1024, (bf16_t*)dst, 0, scr, item, lane, f8s);
    else transpose_item(src, 1024, FF, (bf16_t*)dst, which == 0 ? 2 : 3, scr, item, lane, f8s);
}
constexpr int I_FFI = 16 * 88;
template <int layer>
__device__ __forceinline__ void layer_body(LAS unsigned char* lds, const int wv, const Args& args, unsigned char* ws, const int G, const int bx, const int gw, const int lo, const int hi, const XcdBarrier& bar) {
        const int pb = PH_LAYER0 + layer * PH_PER_LAYER;
        if (hi <= pb || lo >= pb + PH_PER_LAYER) return;
        const bool last = layer == DEPTH - 1, moe = (layer & 1) != 0; const int j2 = layer >> 1;
        const int nrows = last ? TL : T, nMt = nrows / 256;
#define modl (MOD + (size_t)layer * 5 * 6144)
#define cnt (CTLW + CW_CNT + j2 * 64)
#define hl_in (layer == 0 ? args.in[I_X] : H)
#define hc_in (layer == 0 ? args.in[I_CTX] : H16C)

        if (PHON(2) && IN(pb + LP_G1)) { LAUNDER_WS();
            pg8::Gemm g{U, WIN + (size_t)layer * INC * 1024, 1024}; int tsd[9] = {0, 0x7fffffff, 0x7fffffff, 0x7fffffff, 0x7fffffff, 0x7fffffff, 0x7fffffff, 0x7fffffff, 0}; pg8::TileSched S; S.build(lds, wv, T / 256, INC / 256, G, bx, INC / 256, tsd, 16, 0, 1, 0, true);
            pg8::EpiIn E{LRUX, GATE, QS, KS, VS, QD, KD, VD, COS64, SIN64, COS32, SIN32};
            for (int rep_ = 0; rep_ < REP_G1; ++rep_) { pg8::gemm_phase<pg8::EpiIn, pg8::TileSched, true, true>(lds, wv, g, S, E);
                const pg8::TileSched SH = S.listB(); pg8::gemm_phase<pg8::EpiIn, pg8::TileSched, true, true, true>(lds, wv, g, SH, E); }
#if DEFER_W
            {
                const int nb = (G == 256) ? 64 : 0;
                if (bx >= nb) { __syncthreads(); LAS float* scr = (LAS float*)(lds + wv * 16384); const int ln = opaque_tid(wv) & 63;
                    const int mi0 = (layer < 2 ? 6 : 30) + (layer & 1) * DEFER_M;
                    for (int it = (bx - nb) * 8 + wv; it < DEFER_M * I_FFI; it += (G - nb) * 8) ffn_item(args, wsp, mi0 + it / I_FFI, it % I_FFI, scr, ln); }
            }
#endif
        }
        SEAM(pb + LP_G1);
#define LRU_BX(b_) (b_)
#define LRU_ARGS LruArgs LA{LRUX, GATE, MIX, GWT + (size_t)layer * 16 * 4096, args.in[I_CONVW] + layer * 1024, args.in[I_CONVB] + layer * 256, args.in[I_GATEB] + layer * 1024, args.in[I_LAM] + layer * 512, CM, CARRY, LRUAB}
        if (IN(pb + LP_AT)) { LAUNDER_WS(); LRU_ARGS;
            unsigned* ho = CTLW + CW_HO + layer * 3 * 64;
            { bool did = false; for (int u = G - 1 - bx; u < 64 + 32 * SWA_FIXM; u += G) { if (u < 64) kmax_unit(lds, wv, KD, KMAX, u >> 4, (u >> 2) & 3, u & 3); else kmax_unit(lds, wv, KS, KMAX + 128, (u - 64) >> 3, ((u - 64) >> 2) & 1, u & 3, 2); did = true; }
              if (did) ho_signal(ho + 0, wv); }
            if (PHON(3)) lru_phase<1>(lds, wv, LA, LRU_BX(bx), G, REP_LRU);
            ho_signal(ho + 64, wv);
            const float lam_init = layer == 0 ? 0.2f : layer == 1 ? 0.35550906759096926f : layer == 2 ? 0.47071301834358416f : 0.5560582041556405f;
            AttnArgs AA{QS, KS, VS, QD, KD, VD, MIX, args.in[I_SINK] + layer * 8, args.in[I_DLAM] + layer * 128, args.in[I_DNG] + layer * 64, lam_init, KMAX};
            float lam;
            { const int ln = opaque_tid(wv) & 63; const float* dl = AA.dlam; float p = 0.f, q = 0.f; if (ln < 32) { p = dl[ln] * dl[32 + ln]; q = dl[64 + ln] * dl[96 + ln]; }
              p = wave_sum(p); q = wave_sum(q); lam = __uint_as_float(__builtin_amdgcn_readfirstlane(__float_as_uint(fast_exp2(LOG2E * p) - fast_exp2(LOG2E * q) + lam_init))); }
            ho_wait(ho + 0, (unsigned)(G >= 64 + 32 * SWA_FIXM ? 64 + 32 * SWA_FIXM : G), wv);
            if (PHON(5)) for (int rep_ = 0; rep_ < REP_DIFF; ++rep_) for (int u = bx; u < 256; u += G) { const int x8 = u & 7, idx = u >> 3, bh = 2 * x8 + (idx >> 4), jq = idx & 15; diff_unit(lds, wv, AA, bh >> 2, bh & 3, jq, false, lam); }
            { bool did = false; for (int u = bx; u < NB * 2 * 8; u += G) { if (!did) ho_wait(ho + 64, (unsigned)G, wv); lru_scan_unit(lds, wv, CM, CARRY, u >> 4, (u >> 3) & 1, u & 7); did = true; }
              if (did) ho_signal(ho + 128, wv); }
#if DEFER_W
            auto swajob = [&](int slot, TrJob& J) -> bool {
                constexpr int NMAT = (layer == 3) ? 3 : 5;
                const int j = slot * 2048 + bx * 8 + wv; if (G != 256 || j >= NMAT * I_FFI) return false;
                const int q_ = j / I_FFI, item = j - q_ * I_FFI;
                const int mi = layer == 0 ? 18 + q_ : layer == 1 ? 24 + q_ : layer == 2 ? (q_ < 3 ? 3 + q_ : 45 + q_) : 51 + q_;
                const int grp = mi / 3, which = mi - grp * 3;
                if (grp < 2) { J.W = args.in[which == 0 ? I_F1 : which == 1 ? I_F3 : I_F2] + (size_t)grp * 1024 * FF; J.WT = (unsigned char*)(which == 2 ? F2 : F13) + (size_t)grp * (which == 2 ? 1 : 2) * FF * 1024; }
                else { const int je = grp - 2; J.W = args.in[which == 0 ? I_M1 : which == 1 ? I_M3 : I_M2] + (size_t)je * 1024 * FF; J.WT = (unsigned char*)(which == 2 ? M2 : M13) + (size_t)je * (which == 2 ? 1 : 2) * FF * 1024; }
                if (which == 2) { J.K = FF; J.N = 1024; J.kind = 0; J.f8s = F8_SW2; const int kb = item >> 5, nb = item & 31; J.k0 = 64 * kb; J.n0 = 32 * nb; }
                else { J.K = 1024; J.N = FF; J.kind = which == 0 ? 2 : 3; J.f8s = F8_SW13; const int kb = item / 88, nb = item - kb * 88; J.k0 = 64 * kb; J.n0 = 32 * nb; }
                return true; };
            if (PHON(6)) for (int u = bx; u < 512; u += G) { const int bhk = u & 7, jq = u >> 3; swa_unit(lds, wv, AA, bhk >> 1, bhk & 1, jq, false, swajob, (u - bx) / G); }
            if (G != 256) {
                __syncthreads(); LAS float* scr_ = (LAS float*)(lds + wv * 16384); const int ln_ = opaque_tid(wv) & 63; constexpr int NMAT = (layer == 3) ? 3 : 5;
                for (int it = bx * 8 + wv; it < NMAT * I_FFI; it += G * 8) { const int q_ = it / I_FFI; const int mi = layer == 0 ? 18 + q_ : layer == 1 ? 24 + q_ : layer == 2 ? (q_ < 3 ? 3 + q_ : 45 + q_) : 51 + q_; ffn_item(args, wsp, mi, it - q_ * I_FFI, scr_, ln_); }
                __syncthreads(); }
#else
            if (PHON(6)) for (int rep_ = 0; rep_ < REP_SWA; ++rep_) for (int u = bx; u < 512; u += G) { const int bhk = u & 7, jq = u >> 3; swa_unit(lds, wv, AA, bhk >> 1, bhk & 1, jq, false); }
#endif
            if (!last) {
                if (PHON(6)) for (int u = G - 1 - bx; u < 32; u += G) { const int bhk = u & 7, jq = u >> 3; swa_unit(lds, wv, AA, bhk >> 1, bhk & 1, jq, true); }
                if (PHON(5)) for (int u = G - 33 - bx; u < 16; u += G) { if (u >= 0) diff_unit(lds, wv, AA, u >> 2, u & 3, 0, true, lam); }
            }
            ho_wait(ho + 128, 64u, wv);
            if (PHON(4)) lru_phase2c(lds, wv, LA, LRU_BX(bx), G);
        }
        SEAM(pb + LP_AT);
        if (PHON(7) && IN(pb + LP_G2)) { LAUNDER_WS();
            pg8::Gemm g{MIX, WOUT + (size_t)layer * 1024 * 1024, 1024}; int tsd[9] = {0, 0x7fffffff, 0x7fffffff, 0x7fffffff, 0x7fffffff, 0x7fffffff, 0x7fffffff, 0x7fffffff, 0}; pg8::TileSched S; S.build(lds, wv, TL / 256, 4, G, bx, 4, tsd, 16, nMt - TL / 256, 8, 2);
            pg8::EpiPlain E{MB, 1024, PART2, TL, 1.f};
            for (int rep_ = 0; rep_ < REP_G2; ++rep_) pg8::gemm_phase<pg8::EpiPlain, pg8::TileSched, true, true>(lds, wv, g, S, E);
        }
        SEAM(pb + LP_G2);
        if (PHON(8) && IN(pb + LP_N1)) { LAUNDER_WS();
            LnArgs N{hl_in, hc_in, (RES16 == 2 && layer == 0) ? HX : H, (RES16 == 2 && layer == 0) ? HXC : H16C, MB, nullptr, nullptr, modl, 2, modl, 3, 4,
                     args.in[I_LNG] + (layer * 2 + 0) * 1024, args.in[I_LNB] + (layer * 2 + 0) * 1024, U, nrows,
                     args.in[I_RW] + (size_t)j2 * 8192, args.in[I_RB] + j2 * 8, TOKE, TOKG, TOKR, cnt, moe ? 0 : 1, PART2, 8, YBX, {0, 0, 0, 0, 0, 0, 0, 0}};
            if (moe) ln_pass<false, true, (RES16 == 1 && layer != 0), (RES16 == 1), 8>(lds, wv, N, gw); else ln_pass<false, false, (RES16 == 1 && layer != 0), (RES16 == 1 || (RES16 == 2 && layer == 0)), 8>(lds, wv, N, gw);
        }
        SEAM(pb + LP_N1);
#define MAKE_TS() int ts[9]; if (moe) exp_table(cnt, ts); else { ts[0] = 0; _Pragma("unroll") for (int e = 1; e < 9; ++e) ts[e] = 0x7fffffff; ts[8] = nMt; } const int nT = ts[8]
        if (PHON(10) && IN(pb + LP_G3)) { LAUNDER_WS(); MAKE_TS();
            pg8::TileSched S;
            if (moe) {
                pg8::Gemm g{(const unsigned char*)YBX, (const unsigned char*)M13 + (size_t)j2 * 8 * 2 * FF * 1024, 1024}; S.build(lds, wv, nT, 22, G, bx, 22, ts, 8, 0, 1, 0, false, T / 256);
                pg8::EpiSwiGLU8 E{(unsigned char*)HID, FF};
                for (int rep_ = 0; rep_ < REP_G3; ++rep_) pg8::gemm_phase<pg8::EpiSwiGLU8, pg8::TileSched, G3_ALIGN, true, false, true>(lds, wv, g, S, E);
            }
            else {
                pg8::Gemm g{(const unsigned char*)U, (const unsigned char*)F13 + (size_t)j2 * 2 * FF * 1024, 1024}; S.build(lds, wv, nT, 22, G, bx, 22, ts, 8);
                pg8::EpiSwiGLU8 E{(unsigned char*)HID, FF};
                for (int rep_ = 0; rep_ < REP_G3; ++rep_) pg8::gemm_phase<pg8::EpiSwiGLU8, pg8::TileSched, G3_ALIGN, true, false, true>(lds, wv, g, S, E);
            }
        }
        SEAM(pb + LP_G3);
        if (PHON(11) && IN(pb + LP_G4)) { LAUNDER_WS(); MAKE_TS();
            pg8::TileSched S;
            if (moe) {
                pg8::Gemm g{(const unsigned char*)HID, (const unsigned char*)M2 + (size_t)j2 * 8 * 1024 * FF, FF}; S.build(lds, wv, nT, 4, G, bx, 4, ts, 22, 0, 1, 0, true);
                pg8::EpiPlain E{YB, 1024, PART4, TL, 1.f / (F8_SH * F8_SW2)};
                for (int rep_ = 0; rep_ < REP_G4; ++rep_) { pg8::gemm_phase<pg8::EpiPlain, pg8::TileSched, true, true, false, true>(lds, wv, g, S, E);
                    const pg8::TileSched SH = S.listB(); pg8::gemm_phase<pg8::EpiPlain, pg8::TileSched, true, true, true, true>(lds, wv, g, SH, E); }
#if DEFER_W
                if (layer == 1) {
                    const int nwg_ = nT * 4, rem_ = nwg_ - (nwg_ / G) * G, busy_ = (2 * rem_ <= G) ? 2 * rem_ : rem_; const int nb = (G - busy_ >= 64) ? busy_ : 0;
                    if (bx >= nb) { __syncthreads(); LAS float* scr = (LAS float*)(lds + wv * 16384); const int ln = opaque_tid(wv) & 63;
                        for (int it = (bx - nb) * 8 + wv; it < 6 * I_FFI; it += (G - nb) * 8) ffn_item(args, wsp, 30 + 2 * DEFER_M + it / I_FFI, it % I_FFI, scr, ln); }
                }
#endif
            } else {
                pg8::Gemm g{(const unsigned char*)HID, (const unsigned char*)F2 + (size_t)j2 * 1024 * FF, FF}; S.build(lds, wv, TL / 256, 4, G, bx, 4, ts, 22, nT - TL / 256, 11, 2);
                pg8::EpiPlain E{YB, 1024, PART4, TL, 1.f / (F8_SH * F8_SW2)};
                for (int rep_ = 0; rep_ < REP_G4; ++rep_) pg8::gemm_phase<pg8::EpiPlain, pg8::TileSched, true, true, false, true>(lds, wv, g, S, E);
            }
        }
        SEAM(pb + LP_G4);
        if (PHON(12) && IN(pb + LP_N2)) { LAUNDER_WS();
            const float* modn = last ? nullptr : MOD + (size_t)(layer + 1) * 5 * 6144;
            LnArgs N{(RES16 == 2 && layer == 0) ? HX : H, (RES16 == 2 && layer == 0) ? HXC : H16C, last ? args.out : H, H16C, YB, nullptr, TOKG, modl, 5, modn, 0, 1,
                     args.in[I_LNG] + (layer * 2 + 1) * 1024, args.in[I_LNB] + (layer * 2 + 1) * 1024, U, nrows,
                     nullptr, nullptr, TOKE, nullptr, TOKR, nullptr, 0, moe ? nullptr : PART4, 11, nullptr, {0, 0, 0, 0, 0, 0, 0, 0}};
            if (moe) { int tsn[9]; exp_table(cnt, tsn); _Pragma("unroll") for (int e = 0; e < 8; ++e) N.ts[e] = tsn[e]; }
            if (moe) ln_pass<true, false, (RES16 == 1), (RES16 == 1 && !last)>(lds, wv, N, gw); else ln_pass<false, false, (RES16 == 1 || (RES16 == 2 && layer == 0)), (RES16 == 1 && !last)>(lds, wv, N, gw);
        }
        SEAM(pb + LP_N2);
}

__global__ void __launch_bounds__(512, 2) hymba_fwd(Args args) {
    extern __shared__ __attribute__((aligned(16))) unsigned char lds_raw[];
    LAS unsigned char* lds = (LAS unsigned char*)lds_raw;
    volatile LAS unsigned* MISC = (volatile LAS unsigned*)(lds + MISC_OFF);
    const int wv = __builtin_amdgcn_readfirstlane((int)(threadIdx.x >> 6));
    const int wid = wv, tid = opaque_tid(wv), lane = tid & 63;
    const int G = gridDim.x, bx = blockIdx.x;
    const int gw = bx * 8 + wid, NGW = G * 8;
    unsigned char* ws = args.ws;
    unsigned* ctl = (unsigned*)(ws + WS_CTL);
    for (int u = tid; u < (LDS_BYTES - LDSCTL_OFF) / 4; u += 512) ((LAS unsigned*)(lds + LDSCTL_OFF))[u] = 0u;
    __syncthreads();
    const int lo = args.ph_lo, hi = args.ph_hi;
    XcdBarrier bar; bar.bar = ctl + CW_BAR; bar.x = 0; bar.st = nullptr; bar.wv = wv;
    if (hi - lo > 1) bar = xcd_barrier_post(ctl + CW_BAR, MISC + 8, wv);

    unsigned char* wsp = ws;

    if (PHON(0) && IN(PH_P0)) for (int rep_ = 0; rep_ < REP_P0; ++rep_) {
        if (rep_) __syncthreads();
        {
            LAS float* SC = (LAS float*)lds;
            LAS float* RED = (LAS float*)(lds + 20480);
            for (int i = tid; i < 5 * 1024; i += 512) { const int cb = i >> 10, k = i & 1023; const float x = cb < 4 ? args.in[I_C][cb * 1024 + k] : args.in[I_CCTX][k]; SC[i] = x / (1.f + expf(-x)); }
            __syncthreads();
            for (int it = bx; it < DEPTH * 48; it += G) {
                const int layer = it / 48, cg = it % 48;
                const float* w = args.in[I_ADAW] + (size_t)layer * 1024 * 6144 + cg * 128 + 2 * lane;
                float a[5][2];
#pragma unroll
                for (int cb = 0; cb < 5; ++cb) { a[cb][0] = 0.f; a[cb][1] = 0.f; }
#pragma unroll 32
                for (int kk = 0; kk < 128; ++kk) { const int k = wid * 128 + kk; const f32x2 wv = *(const GAS f32x2*)(w + (size_t)k * 6144);
#pragma unroll
                    for (int cb = 0; cb < 5; ++cb) { const float s = SC[cb * 1024 + k]; a[cb][0] += s * wv[0]; a[cb][1] += s * wv[1]; } }
#pragma unroll
                for (int cb = 0; cb < 5; ++cb) { RED[(wid * 5 + cb) * 128 + 2 * lane] = a[cb][0]; RED[(wid * 5 + cb) * 128 + 2 * lane + 1] = a[cb][1]; }
                __syncthreads();
                for (int i = tid; i < 5 * 128; i += 512) { const int cb = i >> 7, c = i & 127; float s = 0.f;
#pragma unroll
                    for (int w8 = 0; w8 < 8; ++w8) s += RED[(w8 * 5 + cb) * 128 + c];
                    st_sc1(MOD + ((size_t)layer * 5 + cb) * 6144 + cg * 128 + c, s + args.in[I_ADAB][layer * 6144 + cg * 128 + c]); }
                __syncthreads();
            }
            ho_signal(ctl + CW_HOP, wv);
        }
        {
            for (int i = bx * 512 + tid; i < 4096 * 32; i += G * 512) { const int s = i >> 5, j = i & 31; const float inv = powf(10000.f, -(float)(j & 15) / 16.f);
                const float ang = (j < 16 ? (float)(s >> 6) : (float)(s & 63)) * inv; COS64[i] = cosf(ang); SIN64[i] = sinf(ang); }
            for (int i = bx * 512 + tid; i < 4096 * 16; i += G * 512) { const int s = i >> 4, j = i & 15; const float inv = powf(10000.f, -(float)(j & 7) / 8.f);
                const float ang = (j < 8 ? (float)(s >> 6) : (float)(s & 63)) * inv; COS32[i] = cosf(ang); SIN32[i] = sinf(ang); }
        }
        {
            LAS float* scr = (LAS float*)(lds + wid * 16384);
            constexpr int I_WINI = 16 * 64, I_WOUTI = 16 * 32, I_FF = 16 * 88  , I_GW = 2;
            constexpr int NFFM = DEFER_W ? 6 : 54;
            constexpr int N0 = DEPTH * I_WINI, N1 = N0 + DEPTH * I_WOUTI, N2 = N1 + NFFM * I_FF, N3 = N2 + 64 * I_GW;
            for (int it = gw; it < N3; it += NGW) {
                if (it < N0) { const int l = it / I_WINI; transpose_item(args.in[I_WIN] + (size_t)l * 1024 * INC, 1024, INC, WIN + (size_t)l * INC * 1024, 1, scr, it % I_WINI, lane); }
                else if (it < N1) { const int r = it - N0, l = r / I_WOUTI; transpose_item(args.in[I_WOUT] + (size_t)l * 1024 * 1024, 1024, 1024, WOUT + (size_t)l * 1024 * 1024, 0, scr, r % I_WOUTI, lane); }
                else if (it < N2) { const int r = it - N1, k = r / I_FF, item = r % I_FF;
                    const int mi = !DEFER_W ? k : (k < 3 ? k : k == 3 ? 23 : k == 4 ? 29 : 50);
                    ffn_item(args, wsp, mi, item, scr, lane); }
                else { const int r = it - N2, mi = r / I_GW; transpose_item(args.in[I_GATEW] + (size_t)mi * 4096, 64, 64, GWT + (size_t)mi * 4096, 0, scr, r % I_GW, lane); }
            }
        }
        {
            ho_wait(ctl + CW_HOP, (unsigned)G, wv);
        int curcb = -1; f32x4 sc[4], sh[4];
        for (int ri = 0; ri < ROWS_PER_WAVE; ++ri) {
            const int row = wave_row(gw, ri, T); if (row < 0) break;
            const bool lat = row < TL; const int cb = lat ? (row >> 12) : 4;
            if (cb != curcb) { curcb = cb;
#pragma unroll
                for (int j = 0; j < 4; ++j) { const float* ps = MOD + (size_t)(cb * 6 + 0) * 1024 + 4 * lane + 256 * j; const float* pc = MOD + (size_t)(cb * 6 + 1) * 1024 + 4 * lane + 256 * j;
                    sh[j] = (f32x4){ld_sc1(ps), ld_sc1(ps + 1), ld_sc1(ps + 2), ld_sc1(ps + 3)}; sc[j] = (f32x4){ld_sc1(pc), ld_sc1(pc + 1), ld_sc1(pc + 2), ld_sc1(pc + 3)}; } }
            const float* hin = lat ? args.in[I_X] + (size_t)row * 1024 : args.in[I_CTX] + (size_t)(row - TL) * 1024;
#pragma unroll
            for (int j = 0; j < 4; ++j) { f32x4 v = *(const GAS f32x4*)(hin + 4 * lane + 256 * j); v = v * (sc[j] + 1.f) + sh[j];
                u32x2 w; w.x = cvtpk(v[0], v[1]); w.y = cvtpk(v[2], v[3]); *(GAS u32x2*)(U + (size_t)row * 1024 + 4 * lane + 256 * j) = w; }
        }
        }
    }
    SEAM(PH_P0B);

    layer_body<0>(lds, wv, args, ws, G, bx, gw, lo, hi, bar);
    layer_body<1>(lds, wv, args, ws, G, bx, gw, lo, hi, bar);
    layer_body<2>(lds, wv, args, ws, G, bx, gw, lo, hi, bar);
    layer_body<3>(lds, wv, args, ws, G, bx, gw, lo, hi, bar);
#undef IN
#undef SEAM
}

extern "C" void kernel_launch(void* const* d_in, const int* in_sizes, int n_in, void* d_out, int out_size, void* d_ws, size_t ws_size, hipStream_t stream) {
    static int grid = 0;
    if (grid == 0) {
        if (n_in != 26 || out_size != TL * D || ws_size < WS_END) { fprintf(stderr, "kernel_launch: unexpected shapes (n_in %d, out %d, ws %zu < %zu)\n", n_in, out_size, ws_size, (size_t)WS_END); grid = -1; return; }
        int dev = 0, cus = 0, per_cu = 0;
        if (hipGetDevice(&dev) != hipSuccess || hipDeviceGetAttribute(&cus, hipDeviceAttributeMultiprocessorCount, dev) != hipSuccess) { grid = -1; return; }
        if (hipFuncSetAttribute((const void*)hymba_fwd, hipFuncAttributeMaxDynamicSharedMemorySize, LDS_BYTES) != hipSuccess) { fprintf(stderr, "kernel_launch: hipFuncSetAttribute failed\n"); grid = -1; return; }
        if (hipOccupancyMaxActiveBlocksPerMultiprocessor(&per_cu, (const void*)hymba_fwd, 512, LDS_BYTES) != hipSuccess || per_cu < 1) { fprintf(stderr, "kernel_launch: occupancy query reports %d\n", per_cu); }
        (void)hipGetLastError();
        grid = cus;
        if (per_cu < 1) grid = -1;
    }
    if (grid < 0) return;
    if (hipMemsetAsync((char*)d_ws + WS_CTL, 0, CTL_ZERO_BYTES, stream) != hipSuccess) return;
    Args a{};
    for (int i = 0; i < 26; ++i) a.in[i] = (const float*)d_in[i];
    a.out = (float*)d_out; a.ws = (unsigned char*)d_ws;
#if MK_N_LAUNCHES == 1
    a.ph_lo = 0; a.ph_hi = N_PHASES;
    hipLaunchKernelGGL(hymba_fwd, dim3(grid), dim3(512), LDS_BYTES, stream, a);
#else
    for (int p = 0; p < N_PHASES; ++p) {
        const int lp = p - PH_LAYER0;
        if (lp >= 0 && (lp % PH_PER_LAYER) == LP_R1 && (((lp / PH_PER_LAYER) & 1) == 0)) continue;
        a.ph_lo = p; a.ph_hi = p + 1;
        hipLaunchKernelGGL(hymba_fwd, dim3(grid), dim3(512), LDS_BYTES, stream, a);
    }
#endif
}
```
